# Optimizing an MI355X kernel written in HIP

```python
import jax, jax.numpy as jnp
from jax import lax
import numpy as np

D_MODEL = 2048
BATCH = 2
SEQ = 4096
DEPTH = 2

N_MIX_HEADS = 12
HEAD_DIM = 128
MIX_WIDTH = N_MIX_HEADS * HEAD_DIM
MEM_HEADS = 4
MEM_HEAD_DIM = 128
MEM_WIDTH = MEM_HEADS * MEM_HEAD_DIM
N_MEM = 256
CONV_WIDTH = 3
Q_LORA = 512
KV_LORA = 256
QK_NOPE = 128
QK_ROPE = 64
QK_HEAD = QK_NOPE + QK_ROPE
V_HEAD = 128
ROPE_THETA = 10000.0
Q_BLOCK = 128
D_FF = 7168
N_EXPERTS = 8
TOP_K = 2
EPS = 1e-6
N_A = DEPTH // 2
N_B = DEPTH - N_A
N_DENSE = (DEPTH + 1) // 2
N_MOE = DEPTH // 2

kernel_name = "yoco_shortconv_mla_memxattn_moe"


def rms_norm(x, g):
    xf = x.astype(jnp.float32)
    y = xf * lax.rsqrt(jnp.mean(xf * xf, axis=-1, keepdims=True) + EPS)
    return (y * g.astype(jnp.float32)).astype(x.dtype)


def rope_tables(positions):
    inv_freq = 1.0 / (ROPE_THETA ** (jnp.arange(0, QK_ROPE, 2, dtype=jnp.float32) / QK_ROPE))
    ang = positions.astype(jnp.float32)[..., None] * inv_freq
    return jnp.cos(ang)[:, :, None, :], jnp.sin(ang)[:, :, None, :]


def apply_rope(x, cos, sin):
    x1, x2 = jnp.split(x.astype(jnp.float32), 2, axis=-1)
    out = jnp.concatenate([x1 * cos - x2 * sin, x2 * cos + x1 * sin], axis=-1)
    return out.astype(x.dtype)


def swiglu(h, w_gate, w_up, w_down):
    return (jax.nn.silu(h @ w_gate) * (h @ w_up)) @ w_down


def short_conv_mixer(u_a, conv_w):
    xin, gate_b, gate_c = jnp.split(u_a, 3, axis=-1)
    z = gate_c * xin
    y = lax.conv_general_dilated(
        z, conv_w[:, None, :].astype(z.dtype), window_strides=(1,),
        padding=[(CONV_WIDTH - 1, 0)],
        dimension_numbers=('NWC', 'WIO', 'NWC'),
        feature_group_count=MIX_WIDTH)
    return gate_b * y


def memory_attention(u_m, mem, g_mem, w_mem_kv, g_mq, g_mk):
    b, s, _ = u_m.shape
    m = mem.shape[1]
    q = rms_norm(u_m.reshape(b, s, MEM_HEADS, MEM_HEAD_DIM), g_mq)
    kv = rms_norm(mem, g_mem) @ w_mem_kv
    k, v = jnp.split(kv, 2, axis=-1)
    k = rms_norm(k.reshape(b, m, MEM_HEADS, MEM_HEAD_DIM), g_mk)
    v = v.reshape(b, m, MEM_HEADS, MEM_HEAD_DIM)
    sc = jnp.einsum('bshd,bmhd->bhsm', q, k).astype(jnp.float32) * (MEM_HEAD_DIM ** -0.5)
    p = jax.nn.softmax(sc, axis=-1).astype(v.dtype)
    return jnp.einsum('bhsm,bmhd->bshd', p, v).reshape(b, s, MEM_WIDTH)


def shared_mla_kv(x, g_kv, w_kv_a, g_kv_a, w_kv_b, g_kn, cos, sin):
    b, s, _ = x.shape
    kv_a = rms_norm(x, g_kv) @ w_kv_a
    c_kv = rms_norm(kv_a[..., :KV_LORA], g_kv_a)
    k_pe = kv_a[..., KV_LORA:]
    kv = (c_kv @ w_kv_b).reshape(b, s, N_MIX_HEADS, QK_NOPE + V_HEAD)
    k_nope, v = kv[..., :QK_NOPE], kv[..., QK_NOPE:]
    k_pe = jnp.broadcast_to(k_pe[:, :, None, :], (b, s, N_MIX_HEADS, QK_ROPE))
    k = rms_norm(jnp.concatenate([k_nope, k_pe], axis=-1), g_kn)
    k = jnp.concatenate([k[..., :QK_NOPE], apply_rope(k[..., QK_NOPE:], cos, sin)], axis=-1)
    return k, v


def mla_query(u_q, g_q_a, w_q_b, g_qn, cos, sin):
    b, s, _ = u_q.shape
    c_q = rms_norm(u_q, g_q_a)
    q = (c_q @ w_q_b).reshape(b, s, N_MIX_HEADS, QK_HEAD)
    q = rms_norm(q, g_qn)
    return jnp.concatenate([q[..., :QK_NOPE], apply_rope(q[..., QK_NOPE:], cos, sin)], axis=-1)


def causal_block_attention(q, k, v):
    b, s, h, dq = q.shape
    nb = s // Q_BLOCK
    qb = q.reshape(b, nb, Q_BLOCK, h, dq).transpose(1, 0, 2, 3, 4)
    k_idx = jnp.arange(s)
    scale = QK_HEAD ** -0.5

    def one_block(args):
        q_blk, i = args
        sc = jnp.einsum('bqhd,bkhd->bhqk', q_blk, k).astype(jnp.float32) * scale
        q_idx = i * Q_BLOCK + jnp.arange(Q_BLOCK)
        sc = jnp.where(k_idx[None, :] <= q_idx[:, None], sc, -jnp.inf)
        p = jax.nn.softmax(sc, axis=-1).astype(v.dtype)
        return jnp.einsum('bhqk,bkhd->bqhd', p, v)

    out = lax.map(one_block, (qb, jnp.arange(nb)))
    return out.transpose(1, 0, 2, 3, 4).reshape(b, s, h * v.shape[-1])


def moe_swiglu(h, w_router, w_gate, w_up, w_down):
    b, s, d = h.shape
    t = h.reshape(b * s, d)
    logits = t.astype(jnp.float32) @ w_router.astype(jnp.float32)
    top_val, top_idx = lax.top_k(logits, TOP_K)
    top_w = jax.nn.softmax(top_val, axis=-1)
    gates = jnp.sum(jax.nn.one_hot(top_idx, N_EXPERTS, dtype=jnp.float32) * top_w[..., None], axis=1)
    gates = gates.astype(t.dtype)
    out = jnp.zeros_like(t)
    for e in range(N_EXPERTS):
        out = out + gates[:, e:e + 1] * swiglu(t, w_gate[e], w_up[e], w_down[e])
    return out.reshape(b, s, d)


def setup_inputs(seed: int = 0) -> dict:
    key = jax.random.key(seed)
    ks = iter(jax.random.split(key, 40))
    f32 = jnp.float32

    def w(shape, fan_in):
        return jax.random.normal(next(ks), shape, f32) * (fan_in ** -0.5)

    def gain(shape):
        return 1.0 + 0.02 * jax.random.normal(next(ks), shape, f32)

    x = jax.random.normal(next(ks), (BATCH, SEQ, D_MODEL), f32)
    mem = jax.random.normal(next(ks), (BATCH, N_MEM, D_MODEL), f32)
    positions = (jnp.arange(SEQ, dtype=jnp.int32)[None, :]
                 + jax.random.randint(next(ks), (BATCH, 1), 0, 1024, dtype=jnp.int32))
    return {
        "x": x,
        "mem": mem,
        "positions": positions,
        "g_mix": gain((DEPTH, D_MODEL)),
        "g_ffn": gain((DEPTH, D_MODEL)),
        "g_mem": gain((DEPTH, D_MODEL)),
        "w_mem_kv": w((DEPTH, D_MODEL, 2 * MEM_WIDTH), D_MODEL),
        "g_mq": gain((DEPTH, MEM_HEAD_DIM)),
        "g_mk": gain((DEPTH, MEM_HEAD_DIM)),
        "w_out": w((DEPTH, MIX_WIDTH + MEM_WIDTH, D_MODEL), MIX_WIDTH + MEM_WIDTH),
        "a_w_in": w((N_A, D_MODEL, 3 * MIX_WIDTH + MEM_WIDTH), D_MODEL),
        "a_conv_w": w((N_A, CONV_WIDTH, MIX_WIDTH), CONV_WIDTH),
        "b_w_in": w((N_B, D_MODEL, Q_LORA + MEM_WIDTH), D_MODEL),
        "b_g_q_a": gain((N_B, Q_LORA)),
        "b_w_q_b": w((N_B, Q_LORA, N_MIX_HEADS * QK_HEAD), Q_LORA),
        "b_g_qn": gain((N_B, QK_HEAD)),
        "g_kv": gain((D_MODEL,)),
        "w_kv_a": w((D_MODEL, KV_LORA + QK_ROPE), D_MODEL),
        "g_kv_a": gain((KV_LORA,)),
        "w_kv_b": w((KV_LORA, N_MIX_HEADS * (QK_NOPE + V_HEAD)), KV_LORA),
        "g_kn": gain((QK_HEAD,)),
        "ffn_w_gate": w((N_DENSE, D_MODEL, D_FF), D_MODEL),
        "ffn_w_up": w((N_DENSE, D_MODEL, D_FF), D_MODEL),
        "ffn_w_down": w((N_DENSE, D_FF, D_MODEL), D_FF),
        "moe_w_router": w((N_MOE, D_MODEL, N_EXPERTS), D_MODEL),
        "moe_w_gate": w((N_MOE, N_EXPERTS, D_MODEL, D_FF), D_MODEL),
        "moe_w_up": w((N_MOE, N_EXPERTS, D_MODEL, D_FF), D_MODEL),
        "moe_w_down": w((N_MOE, N_EXPERTS, D_FF, D_MODEL), D_FF),
    }


def reference(x, mem, positions, g_mix, g_ffn, g_mem, w_mem_kv, g_mq, g_mk, w_out,
              a_w_in, a_conv_w, b_w_in, b_g_q_a, b_w_q_b, b_g_qn,
              g_kv, w_kv_a, g_kv_a, w_kv_b, g_kn,
              ffn_w_gate, ffn_w_up, ffn_w_down,
              moe_w_router, moe_w_gate, moe_w_up, moe_w_down):
    cos, sin = rope_tables(positions)
    k_shared = None
    v_shared = None
    for l in range(DEPTH):
        h = rms_norm(x, g_mix[l])
        if l < N_A:
            u = h @ a_w_in[l]
            mix = short_conv_mixer(u[..., :3 * MIX_WIDTH], a_conv_w[l])
            u_m = u[..., 3 * MIX_WIDTH:]
        else:
            if l == N_A:
                k_shared, v_shared = shared_mla_kv(x, g_kv, w_kv_a, g_kv_a, w_kv_b, g_kn, cos, sin)
            j = l - N_A
            u = h @ b_w_in[j]
            q = mla_query(u[..., :Q_LORA], b_g_q_a[j], b_w_q_b[j], b_g_qn[j], cos, sin)
            mix = causal_block_attention(q, k_shared, v_shared)
            u_m = u[..., Q_LORA:]
        mem_out = memory_attention(u_m, mem, g_mem[l], w_mem_kv[l], g_mq[l], g_mk[l])
        x = x + jnp.concatenate([mix, mem_out], axis=-1) @ w_out[l]
        h = rms_norm(x, g_ffn[l])
        if l % 2 == 0:
            i = l // 2
            x = x + swiglu(h, ffn_w_gate[i], ffn_w_up[i], ffn_w_down[i])
        else:
            i = l // 2
            x = x + moe_swiglu(h, moe_w_router[i], moe_w_gate[i], moe_w_up[i], moe_w_down[i])
    return x
```

```cpp
#include <hip/hip_runtime.h>
#include <cstdio>
#include <cstdint>

#ifndef REPMASK
#define REPMASK 0
#endif
#ifndef MK_SPLIT
#define MK_SPLIT 0
#endif

#define GAS __attribute__((address_space(1)))
#define LAS __attribute__((address_space(3)))
typedef unsigned short bf16_t;
typedef short bf16x8 __attribute__((ext_vector_type(8)));
typedef float f32x4 __attribute__((ext_vector_type(4)));
typedef float f32x16 __attribute__((ext_vector_type(16)));
typedef unsigned u32x4 __attribute__((ext_vector_type(4)));
typedef unsigned u32x2 __attribute__((ext_vector_type(2)));
typedef int v4i_t __attribute__((ext_vector_type(4)));
typedef int v8i_t __attribute__((ext_vector_type(8)));

constexpr int NTOK = 8192, DM = 2048, SEQ = 4096;
constexpr int DFF = 7168, NEXP = 8;
constexpr int NIN0 = 5120;
constexpr int N1 = 1536;
constexpr int MAXPAIR = 18432;
constexpr float EPS = 1e-6f;
constexpr float LOG2E = 1.4426950408889634f;
constexpr float QX1 = 127.0f / 6.5f;
constexpr float QWGU = 127.0f / 0.12f;
constexpr float QHID = 127.0f / 8.0f;
constexpr float QWD = 127.0f / 0.064f;
constexpr float QH = 127.0f / 5.5f;

constexpr size_t MiB = 1u << 20;
constexpr size_t WS_CTL = 0, CTL_ZERO_BYTES = 64 * 1024;
constexpr size_t WS_META = 1 * MiB;
constexpr size_t WS_SSQ = 2 * MiB;
constexpr size_t WS_WR = 3 * MiB;
constexpr size_t WS_MEMN = 4 * MiB;
constexpr size_t WS_MEMKR = 6 * MiB;
constexpr size_t WS_MEMKF = 7 * MiB;
constexpr size_t WS_MEMVT = 8 * MiB;
constexpr size_t WS_QM = 10 * MiB;
constexpr size_t WS_W_IN0 = 20 * MiB, WS_W_OUT0 = 40 * MiB, WS_W_OUT1 = 48 * MiB, WS_W_GU0 = 56 * MiB, WS_W_D0 = 112 * MiB, WS_W_1 = 140 * MiB;
constexpr size_t WS_W_KN = 146 * MiB, WS_W_V = 147 * MiB, WS_W_QB = 148 * MiB, WS_W_MK = 151 * MiB, WS_W_MV = 155 * MiB;
constexpr size_t WS_W_MGU = 160 * MiB, WS_W_MD = 608 * MiB;
constexpr size_t WS_XB = 832 * MiB, WS_CAT = 864 * MiB, WS_H0 = 896 * MiB, WS_HS = 960 * MiB;
constexpr size_t WS_U0 = 1032 * MiB, WS_HID = 1112 * MiB, WS_U1F = 1224 * MiB, WS_CKV = 1272 * MiB, WS_CQ = 1276 * MiB;
constexpr size_t WS_HID2 = 1032 * MiB;
constexpr size_t WS_KNRAW = 1284 * MiB, WS_VT = 1308 * MiB, WS_QRAW = 1332 * MiB, WS_KF = 1368 * MiB, WS_QF = 1404 * MiB;
constexpr size_t WS_Y = 1284 * MiB;
constexpr size_t WS_KPE = WS_U1F;
constexpr size_t WS_KSS = WS_SSQ + 768 * 1024, WS_SSQQ = WS_SSQ + 832 * 1024, WS_RS0 = WS_SSQ + 896 * 1024;
constexpr size_t WS_XB8 = 928 * MiB;
constexpr size_t WS_YP = 384 * MiB;
constexpr size_t WS_END = 1440 * MiB;
constexpr size_t MT_TOKE = 0, MT_TOKW = 64 * 1024, MT_TOKR = 128 * 1024, MT_CNT = 160 * 1024, MT_TOKPOS = 192 * 1024, MT_PAIRW = 256 * 1024, MT_PAIRR = 328 * 1024, MT_MTE = 512 * 1024, MT_NMT = 513 * 1024;
constexpr int CW_BAR = 4096;

constexpr int RING_BYTES = 131072;
constexpr int LDSCTL_OFF = 132096  , MISC_OFF = LDSCTL_OFF + 320, RSTAB_OFF = LDSCTL_OFF + 1024;
constexpr int LDS_BYTES = 147456;

#define LDS_WAIT() asm volatile("s_waitcnt lgkmcnt(0)" ::: "memory")
#define VM_WAIT() asm volatile("s_waitcnt vmcnt(0)" ::: "memory")
__device__ __forceinline__ unsigned cvt_pk_bf16(float lo, float hi) { unsigned r; asm volatile("v_cvt_pk_bf16_f32 %0, %1, %2" : "=v"(r) : "v"(lo), "v"(hi)); return r; }
__device__ __forceinline__ unsigned pk4_fp8(float a, float b, float c, float d) { int w = 0; w = __builtin_amdgcn_cvt_pk_fp8_f32(a, b, w, false); w = __builtin_amdgcn_cvt_pk_fp8_f32(c, d, w, true); return (unsigned)w; }
__device__ __forceinline__ unsigned pk4_i8(float a, float b, float c, float d) {
    unsigned w = 0;
    w = __builtin_amdgcn_cvt_pk_u8_f32(a + 128.0f, 0, w); w = __builtin_amdgcn_cvt_pk_u8_f32(b + 128.0f, 1, w);
    w = __builtin_amdgcn_cvt_pk_u8_f32(c + 128.0f, 2, w); w = __builtin_amdgcn_cvt_pk_u8_f32(d + 128.0f, 3, w);
    return w ^ 0x80808080u; }
__device__ __forceinline__ unsigned pk4_i8s(float a, float b, float c, float d, float q) {
    unsigned w = 0;
    w = __builtin_amdgcn_cvt_pk_u8_f32(__builtin_fmaf(a, q, 128.0f), 0, w); w = __builtin_amdgcn_cvt_pk_u8_f32(__builtin_fmaf(b, q, 128.0f), 1, w);
    w = __builtin_amdgcn_cvt_pk_u8_f32(__builtin_fmaf(c, q, 128.0f), 2, w); w = __builtin_amdgcn_cvt_pk_u8_f32(__builtin_fmaf(d, q, 128.0f), 3, w);
    return w ^ 0x80808080u; }
__device__ __forceinline__ float bf_lo(unsigned w) { return __uint_as_float(w << 16); }
__device__ __forceinline__ float bf_hi(unsigned w) { return __uint_as_float(w & 0xffff0000u); }
template <int CTRL, int ROWS = 0xf> __device__ __forceinline__ float dpp_f(float v) { return __builtin_bit_cast(float, __builtin_amdgcn_update_dpp(0, __builtin_bit_cast(int, v), CTRL, ROWS, 0xf, false)); }
__device__ __forceinline__ float row16_sum(float v) {
    v += dpp_f<0xB1>(v); v += dpp_f<0x4E>(v);
    v += dpp_f<0x141>(v); v += dpp_f<0x140>(v);
    return v; }
__device__ __forceinline__ float wave_sum(float v) {
    v = row16_sum(v);
    v += dpp_f<0x142, 0xA>(v);
    v += dpp_f<0x143, 0xC>(v);
    return __builtin_bit_cast(float, __builtin_amdgcn_readlane(__builtin_bit_cast(int, v), 63)); }
__device__ __forceinline__ int lane_now() { int l; asm volatile("v_mbcnt_lo_u32_b32 %0, -1, 0\n\tv_mbcnt_hi_u32_b32 %0, -1, %0" : "=v"(l)); return l; }
__device__ __forceinline__ float max3f(float a, float b, float c) { float r; asm("v_max3_f32 %0, %1, %2, %3" : "=v"(r) : "v"(a), "v"(b), "v"(c)); return r; }
__device__ __forceinline__ float half_max(float x) { const unsigned u = __float_as_uint(x); auto r = __builtin_amdgcn_permlane32_swap(u, u, false, false); return fmaxf(__uint_as_float(r[0]), __uint_as_float(r[1])); }
__device__ __forceinline__ float other_half(float x, int lane) { const unsigned u = __float_as_uint(x); auto r = __builtin_amdgcn_permlane32_swap(u, u, false, false); return __uint_as_float(lane < 32 ? r[1] : r[0]); }
__device__ __forceinline__ float rows4_sum(float x) { const unsigned u = __float_as_uint(x); auto r = __builtin_amdgcn_permlane16_swap(u, u, false, false); const float y = __uint_as_float(r[0]) + __uint_as_float(r[1]);
    const unsigned v = __float_as_uint(y); auto q = __builtin_amdgcn_permlane32_swap(v, v, false, false); return __uint_as_float(q[0]) + __uint_as_float(q[1]); }
__device__ __forceinline__ float half_sum(float x) { const unsigned u = __float_as_uint(x); auto r = __builtin_amdgcn_permlane32_swap(u, u, false, false); return __uint_as_float(r[0]) + __uint_as_float(r[1]); }
__device__ __forceinline__ float silu_f(float x) { return x * __builtin_amdgcn_rcpf(1.0f + __builtin_amdgcn_exp2f(-x * LOG2E)); }

namespace pg8 {
constexpr int BM = 256, BK = 64, HALF = 128, HTB = HALF * BK * 2, STAGE_BYTES = 8 * HTB, NXCD = 8, WGM = 8;
__host__ __device__ __forceinline__ int lds_byte(int r, int c) { const int st = (r >> 4) * 2 + (c >> 5), rr = r & 15, cc = c & 31, ob = rr * 64 + cc * 2; return st * 1024 + (ob ^ (((ob >> 9) & 1) << 5)); }
__host__ __device__ __forceinline__ void stage_rc(int b, int& R, int& C) { const int st = b / 1024, sb = b % 1024, swz = sb ^ (((sb >> 9) & 1) << 5); R = (st >> 1) * 16 + swz / 64; C = (st & 1) * 32 + (swz % 64) / 2; }
__host__ __device__ __forceinline__ int perm32(int rho) { const int n = rho >> 4, i = rho & 15; return 8 * (i >> 2) + 4 * n + (i & 3); }

struct Unit { int pm, pn, am, bn, koff, ks; };
struct Gemm { const bf16_t* A; const bf16_t* Bt; int K, ld; };

struct StaticOrder {
    int nM, nN, nwg, G, c;
    __device__ __forceinline__ void init(int nM_, int nN_, int G_, int c_) { nM = nM_; nN = nN_; nwg = nM * nN; G = G_; c = c_; }
    __device__ __forceinline__ bool map(int i, Unit& u) const {
        const long L = (long)i * G + c; if (L >= nwg) return false;
        int wgid = (int)L; { const int q = nwg / NXCD, r = nwg % NXCD, xcd = wgid % NXCD, off = wgid / NXCD; wgid = (xcd < r ? xcd * (q + 1) : r * (q + 1) + (xcd - r) * q) + off; }
        const int nig = WGM * nN, gid = wgid / nig, fm = gid * WGM, gsz = (nM - fm) < WGM ? (nM - fm) : WGM;
        u.pm = fm + ((wgid % nig) % gsz); u.pn = (wgid % nig) / gsz; return true;
    }
    __device__ __forceinline__ bool next(int i, Unit& u) const { if (!map(i, u)) return false; u.am = u.pm; u.bn = u.pn; u.koff = 0; u.ks = 0; return true; }
};
struct MoeOrder : StaticOrder {
    const int* mte; int ntpe;
    __device__ __forceinline__ bool next(int i, Unit& u) const { if (!map(i, u)) return false; u.am = u.pm; u.bn = mte[u.pm] * ntpe + u.pn; u.koff = 0; u.ks = 0; return true; }
};
struct MoeTailOrder {
    int nL, G, c; const int* mte;
    __device__ __forceinline__ bool next(int i, Unit& u) const {
        const int L = i * G + c; if (L >= nL * 56) return false;
        u.pn = L & 7; const int t = L >> 3; u.pm = t % nL; u.ks = t / nL; u.am = 64 + u.pm; u.bn = mte[64 + u.pm] * 8 + u.pn; u.koff = u.ks * 1024; return true; }
};

struct EpiBf16Plain {
    static constexpr bool PERM = true, AFTER_DRAIN = false;
    bf16_t* O; int ldc; const LAS float* rl;
    __device__ __forceinline__ void operator()(const f32x4 (&acc)[2][2][4][2], const Unit& u, int wr, int wc, int fr, int fq) const {
        const int row0 = u.pm * BM + wr * 64 + fr, col0 = u.pn * BM + wc * 32 + 8 * fq;
#pragma unroll
        for (int ai = 0; ai < 2; ++ai)
#pragma unroll
            for (int m = 0; m < 4; ++m) { bf16_t* rowp = O + (size_t)(row0 + ai * HALF + m * 16) * ldc + col0; const float r = rl ? rl[wr * 64 + fr + ai * HALF + m * 16] : 1.0f;
#pragma unroll
                for (int bj = 0; bj < 2; ++bj) { const f32x4 v0 = acc[ai][bj][m][0] * r, v1 = acc[ai][bj][m][1] * r;
                    u32x4 w; w.x = cvt_pk_bf16(v0[0], v0[1]); w.y = cvt_pk_bf16(v0[2], v0[3]); w.z = cvt_pk_bf16(v1[0], v1[1]); w.w = cvt_pk_bf16(v1[2], v1[3]);
                    *(u32x4*)(rowp + bj * HALF) = w; } }
    }
};
template <int MODE> struct EpiSwiGLU {
    static constexpr bool PERM = true, AFTER_DRAIN = false;
    bf16_t* H; int ldh; const float* rs;
    __device__ __forceinline__ void operator()(const f32x4 (&acc)[2][2][4][2], const Unit& u, int wr, int wc, int fr, int fq) const {
        const int row0 = u.pm * BM + wr * 64 + fr, col0 = u.pn * HALF + wc * 32 + 8 * fq;
#pragma unroll
        for (int ai = 0; ai < 2; ++ai)
#pragma unroll
            for (int m = 0; m < 4; ++m) { const int row = row0 + ai * HALF + m * 16; float r;
                if (MODE == 0) { const f32x4 a = *(const f32x4*)(rs + (size_t)row * 8), b = *(const f32x4*)(rs + (size_t)row * 8 + 4);
                    r = 1.0f * __builtin_amdgcn_rsqf(((a[0] + a[1]) + (a[2] + a[3]) + (b[0] + b[1]) + (b[2] + b[3])) * (1.0f / 2048.0f) + EPS); }
                else r = rs[row];
                const f32x4 g0 = acc[ai][0][m][0] * r, g1 = acc[ai][0][m][1] * r, u0 = acc[ai][1][m][0] * r, u1 = acc[ai][1][m][1] * r;
                u32x4 w; w.x = cvt_pk_bf16(silu_f(g0[0]) * u0[0], silu_f(g0[1]) * u0[1]); w.y = cvt_pk_bf16(silu_f(g0[2]) * u0[2], silu_f(g0[3]) * u0[3]);
                w.z = cvt_pk_bf16(silu_f(g1[0]) * u1[0], silu_f(g1[1]) * u1[1]); w.w = cvt_pk_bf16(silu_f(g1[2]) * u1[2], silu_f(g1[3]) * u1[3]);
                *(u32x4*)(H + (size_t)row * ldh + col0) = w; }
    }
};
template <int MODE> struct EpiSwiGLU8 {
    static constexpr bool PERM = true, AFTER_DRAIN = false;
    unsigned char* H; int ldh; const float* rs; const LAS float* rl; float cs, qo;
    __device__ __forceinline__ void operator()(const f32x4 (&acc)[2][2][4][2], const Unit& u, int wr, int wc, int fr, int fq) const {
        const int row0 = u.pm * BM + wr * 64 + fr, col0 = u.pn * HALF + wc * 32 + 8 * fq;
#pragma unroll
        for (int ai = 0; ai < 2; ++ai)
#pragma unroll
            for (int m = 0; m < 4; ++m) { const int row = row0 + ai * HALF + m * 16; float r;
                if (MODE == 3) r = rl[wr * 64 + fr + ai * HALF + m * 16];
                else if (MODE == 0) { const f32x4 a = *(const f32x4*)(rs + (size_t)row * 8), b = *(const f32x4*)(rs + (size_t)row * 8 + 4);
                    r = 1.0f * __builtin_amdgcn_rsqf(((a[0] + a[1]) + (a[2] + a[3]) + (b[0] + b[1]) + (b[2] + b[3])) * (1.0f / 2048.0f) + EPS); }
                else if (MODE == 1) r = rs[row]; else r = cs;
                const f32x4 ag0 = acc[ai][0][m][0], ag1 = acc[ai][0][m][1], au0 = acc[ai][1][m][0], au1 = acc[ai][1][m][1];
                const float c1 = -LOG2E * r, c2 = r * r * (qo != 0.f ? qo : 1.0f);
                f32x4 e0 = ag0 * c1, e1 = ag1 * c1;
#pragma unroll
                for (int i = 0; i < 4; ++i) { e0[i] = __builtin_amdgcn_exp2f(e0[i]); e1[i] = __builtin_amdgcn_exp2f(e1[i]); }
                f32x4 d0 = e0 + 1.0f, d1 = e1 + 1.0f;
#pragma unroll
                for (int i = 0; i < 4; ++i) { d0[i] = __builtin_amdgcn_rcpf(d0[i]); d1[i] = __builtin_amdgcn_rcpf(d1[i]); }
                const f32x4 t0 = (ag0 * au0) * d0, t1 = (ag1 * au1) * d1;
                u32x2 w;
                if (qo != 0.f) { const f32x4 y0 = __builtin_elementwise_fma(t0, (f32x4){c2, c2, c2, c2}, (f32x4){128.0f, 128.0f, 128.0f, 128.0f}), y1 = __builtin_elementwise_fma(t1, (f32x4){c2, c2, c2, c2}, (f32x4){128.0f, 128.0f, 128.0f, 128.0f}); unsigned a = 0, c = 0;
#pragma unroll
                    for (int i = 0; i < 4; ++i) { a = __builtin_amdgcn_cvt_pk_u8_f32(y0[i], i, a); c = __builtin_amdgcn_cvt_pk_u8_f32(y1[i], i, c); }
                    w.x = a ^ 0x80808080u; w.y = c ^ 0x80808080u; }
                else { const f32x4 h0 = t0 * c2, h1 = t1 * c2; w.x = pk4_fp8(h0[0], h0[1], h0[2], h0[3]); w.y = pk4_fp8(h1[0], h1[1], h1[2], h1[3]); }
                *(u32x2*)(H + (size_t)row * ldh + col0) = w; }
    }
};
struct EpiRowScaleF32 {
    static constexpr bool PERM = false, AFTER_DRAIN = false;
    float* O; int ldc; const float* ssq;
    __device__ __forceinline__ void operator()(const f32x4 (&acc)[2][2][4][2], const Unit& u, int wr, int wc, int fr, int fq) const {
        const int row0 = u.pm * BM + wr * 64 + fr, col0 = u.pn * BM + wc * 32 + 4 * fq;
#pragma unroll
        for (int ai = 0; ai < 2; ++ai)
#pragma unroll
            for (int m = 0; m < 4; ++m) { const int row = row0 + ai * HALF + m * 16;
                const f32x4 a = *(const f32x4*)(ssq + (size_t)row * 8), b = *(const f32x4*)(ssq + (size_t)row * 8 + 4);
                const float r = 1.0f * __builtin_amdgcn_rsqf(((a[0] + a[1]) + (a[2] + a[3]) + (b[0] + b[1]) + (b[2] + b[3])) * (1.0f / 2048.0f) + EPS);
                float* rowp = O + (size_t)row * ldc + col0;
#pragma unroll
                for (int bj = 0; bj < 2; ++bj)
#pragma unroll
                    for (int n = 0; n < 2; ++n) *(f32x4*)(rowp + bj * HALF + n * 16) = acc[ai][bj][m][n] * r; }
    }
};
struct EpiMoeDown {
    static constexpr bool PERM = true, AFTER_DRAIN = false;
    bf16_t* Y; float ds;
    __device__ __forceinline__ void operator()(const f32x4 (&acc)[2][2][4][2], const Unit& u, int wr, int wc, int fr, int fq) const {
        const int row0 = u.pm * BM + wr * 64 + fr, col0 = u.pn * BM + wc * 32 + 8 * fq;
#pragma unroll
        for (int ai = 0; ai < 2; ++ai)
#pragma unroll
            for (int m = 0; m < 4; ++m) { bf16_t* rowp = Y + (size_t)(row0 + ai * HALF + m * 16) * DM + col0;
#pragma unroll
                for (int bj = 0; bj < 2; ++bj) { const f32x4 v0 = acc[ai][bj][m][0] * ds, v1 = acc[ai][bj][m][1] * ds;
                    u32x4 w; w.x = cvt_pk_bf16(v0[0], v0[1]); w.y = cvt_pk_bf16(v0[2], v0[3]); w.z = cvt_pk_bf16(v1[0], v1[1]); w.w = cvt_pk_bf16(v1[2], v1[3]);
                    *(u32x4*)(rowp + bj * HALF) = w; } }
    }
};
struct EpiMoeDownPart {
    static constexpr bool PERM = true, AFTER_DRAIN = false;
    bf16_t* YP; float ds;
    __device__ __forceinline__ void operator()(const f32x4 (&acc)[2][2][4][2], const Unit& u, int wr, int wc, int fr, int fq) const {
        const int row0 = u.pm * BM + wr * 64 + fr, col0 = u.pn * BM + wc * 32 + 8 * fq;
#pragma unroll
        for (int ai = 0; ai < 2; ++ai)
#pragma unroll
            for (int m = 0; m < 4; ++m) { bf16_t* rowp = YP + ((size_t)u.ks * 2048 + row0 + ai * HALF + m * 16) * DM + col0;
#pragma unroll
                for (int bj = 0; bj < 2; ++bj) { const f32x4 v0 = acc[ai][bj][m][0] * ds, v1 = acc[ai][bj][m][1] * ds;
                    u32x4 w; w.x = cvt_pk_bf16(v0[0], v0[1]); w.y = cvt_pk_bf16(v0[2], v0[3]); w.z = cvt_pk_bf16(v1[0], v1[1]); w.w = cvt_pk_bf16(v1[2], v1[3]);
                    *(u32x4*)(rowp + bj * HALF) = w; } }
    }
};
struct EpiStream {
    static constexpr bool PERM = false, AFTER_DRAIN = true;
    bf16_t* xb; float* ssq; unsigned char* x8; float q8, ds;
    __device__ __forceinline__ void fused(f32x4 (&acc)[2][2][4][2], const Unit& u, int wr, int wc, int fr, int fq, LAS unsigned char* lds, int wid, int lane) const {
        LAS float* P = (LAS float*)lds;
        const int col0 = u.pn * BM + wc * 32 + 4 * fq;
#pragma unroll
        for (int ai = 0; ai < 2; ++ai) {
            u32x2 rv[4][2][2];
#pragma unroll
            for (int m = 0; m < 4; ++m) { const size_t off = (size_t)(u.pm * BM + ai * HALF + wr * 64 + m * 16 + fr) * DM + col0;
#pragma unroll
                for (int bj = 0; bj < 2; ++bj)
#pragma unroll
                    for (int n = 0; n < 2; ++n) rv[m][bj][n] = *(const u32x2*)(xb + off + bj * HALF + n * 16); }
#pragma unroll
            for (int m = 0; m < 4; ++m) { const int rl = ai * HALF + wr * 64 + m * 16 + fr; const size_t off = (size_t)(u.pm * BM + rl) * DM + col0; float s = 0.f;
#pragma unroll
                for (int bj = 0; bj < 2; ++bj)
#pragma unroll
                    for (int n = 0; n < 2; ++n) { const f32x4 a = acc[ai][bj][m][n] * ds; const u32x2 r = rv[m][bj][n];
                        const float v0 = bf_lo(r.x) + a[0], v1 = bf_hi(r.x) + a[1], v2 = bf_lo(r.y) + a[2], v3 = bf_hi(r.y) + a[3];
                        u32x2 w; w.x = cvt_pk_bf16(v0, v1); w.y = cvt_pk_bf16(v2, v3);
                        *(u32x2*)(xb + off + bj * HALF + n * 16) = w; s += (v0 * v0 + v1 * v1) + (v2 * v2 + v3 * v3);
                        if (x8) *(unsigned*)(x8 + off + bj * HALF + n * 16) = q8 == 0.f ? pk4_fp8(v0, v1, v2, v3) : pk4_i8s(v0, v1, v2, v3, q8); }
                s = rows4_sum(s);
                if (fq == 0) P[rl * 4 + wc] = s; }
            asm volatile("" ::: "memory"); }
        asm volatile("s_waitcnt lgkmcnt(0)" ::: "memory"); __builtin_amdgcn_s_barrier(); asm volatile("" ::: "memory");
        const int t = wid * 64 + lane;
        if (t < 256) { const f32x4 p = *(const LAS f32x4*)(P + t * 4); ssq[(size_t)(u.pm * BM + t) * 8 + u.pn] = (p[0] + p[1]) + (p[2] + p[3]); }
        asm volatile("s_waitcnt lgkmcnt(0)" ::: "memory"); __builtin_amdgcn_s_barrier(); asm volatile("" ::: "memory");
    }
};

struct EpiL1In {
    static constexpr bool PERM = false, AFTER_DRAIN = true;
    const float* ssq2; bf16_t* ckv; float* kpe; float* kss; bf16_t* cq; float* ssqq; bf16_t* qm; const float* g_mq1; float cmem;
    __device__ __forceinline__ void fused(f32x4 (&acc)[2][2][4][2], const Unit& u, int wr, int wc, int fr, int fq, LAS unsigned char* lds, int wid, int lane) const {
        LAS float* P = (LAS float*)lds;
#pragma unroll
        for (int ai = 0; ai < 2; ++ai)
#pragma unroll
            for (int m = 0; m < 4; ++m) { const int rl = ai * HALF + wr * 64 + m * 16 + fr;
#pragma unroll
                for (int bj = 0; bj < 2; ++bj) { const f32x4 a = acc[ai][bj][m][0], b = acc[ai][bj][m][1];
                    float s = (a[0] * a[0] + a[1] * a[1]) + (a[2] * a[2] + a[3] * a[3]) + (b[0] * b[0] + b[1] * b[1]) + (b[2] * b[2] + b[3] * b[3]);
                    s = rows4_sum(s);
                    if (fq == 0) P[(rl * 2 + bj) * 4 + wc] = s; } }
        asm volatile("s_waitcnt lgkmcnt(0)" ::: "memory"); __builtin_amdgcn_s_barrier(); asm volatile("" ::: "memory");
        const int pn = u.pn;
        float r2s[2][4];
        { f32x4 qa[2][4], qb[2][4];
#pragma unroll
          for (int ai = 0; ai < 2; ++ai)
#pragma unroll
              for (int m = 0; m < 4; ++m) { const int row = u.pm * BM + ai * HALF + wr * 64 + m * 16 + fr; qa[ai][m] = *(const f32x4*)(ssq2 + (size_t)row * 8); qb[ai][m] = *(const f32x4*)(ssq2 + (size_t)row * 8 + 4); }
#pragma unroll
          for (int ai = 0; ai < 2; ++ai)
#pragma unroll
              for (int m = 0; m < 4; ++m) r2s[ai][m] = __builtin_amdgcn_rsqf(((qa[ai][m][0] + qa[ai][m][1]) + (qa[ai][m][2] + qa[ai][m][3]) + (qb[ai][m][0] + qb[ai][m][1]) + (qb[ai][m][2] + qb[ai][m][3])) * (1.0f / 2048.0f) + EPS); }
#pragma unroll
        for (int ai = 0; ai < 2; ++ai)
#pragma unroll
            for (int m = 0; m < 4; ++m) { const int rl = ai * HALF + wr * 64 + m * 16 + fr, row = u.pm * BM + rl;
                const float r2 = r2s[ai][m];
                const f32x4 p0 = *(const LAS f32x4*)(P + (rl * 2 + 0) * 4), p1 = *(const LAS f32x4*)(P + (rl * 2 + 1) * 4);
                const float ss0 = (p0[0] + p0[1]) + (p0[2] + p0[3]), ss1 = (p1[0] + p1[1]) + (p1[2] + p1[3]);
                const int cl = wc * 32 + 4 * fq;
                if (pn == 0) { const float sc = r2 * __builtin_amdgcn_rsqf(r2 * r2 * (ss0 + ss1) * (1.0f / 256.0f) + EPS);
#pragma unroll
                    for (int bj = 0; bj < 2; ++bj)
#pragma unroll
                        for (int n = 0; n < 2; ++n) { const f32x4 v = acc[ai][bj][m][n] * sc; u32x2 w; w.x = cvt_pk_bf16(v[0], v[1]); w.y = cvt_pk_bf16(v[2], v[3]);
                            *(u32x2*)(ckv + (size_t)row * 256 + bj * HALF + cl + n * 16) = w; } }
                else if (pn == 1) { if (wc < 2) {
#pragma unroll
                        for (int n = 0; n < 2; ++n) *(f32x4*)(kpe + (size_t)row * 64 + cl + n * 16) = acc[ai][0][m][n] * r2; }
                    if (wc == 0 && fq == 0) kss[row] = r2 * r2 * ss0; }
                else if (pn < 4) {
#pragma unroll
                    for (int bj = 0; bj < 2; ++bj)
#pragma unroll
                        for (int n = 0; n < 2; ++n) { const f32x4 v = acc[ai][bj][m][n] * r2; u32x2 w; w.x = cvt_pk_bf16(v[0], v[1]); w.y = cvt_pk_bf16(v[2], v[3]);
                            *(u32x2*)(cq + (size_t)row * 512 + (pn - 2) * 256 + bj * HALF + cl + n * 16) = w; }
                    if (wc == 0 && fq == 0) ssqq[row * 2 + (pn - 2)] = r2 * r2 * (ss0 + ss1); }
                else { const int b = row >> 12, s = row & (SEQ - 1);
#pragma unroll
                    for (int bj = 0; bj < 2; ++bj) { const int head = (pn - 4) * 2 + bj; const float rr = cmem * r2 * __builtin_amdgcn_rsqf(r2 * r2 * (bj ? ss1 : ss0) * (1.0f / 128.0f) + EPS);
#pragma unroll
                        for (int n = 0; n < 2; ++n) { const f32x4 g = *(const f32x4*)(g_mq1 + cl + n * 16); const f32x4 v = acc[ai][bj][m][n] * rr * g; u32x2 w; w.x = cvt_pk_bf16(v[0], v[1]); w.y = cvt_pk_bf16(v[2], v[3]);
                            *(u32x2*)(qm + ((size_t)(b * 4 + head) * SEQ + s) * 128 + cl + n * 16) = w; } } }
                asm volatile("" ::: "memory"); }
    }
};

template <class Epi, class Sched, bool ALIGN_EPI = false, bool SP2 = false, bool F8 = false, bool I8 = false>
__device__ __forceinline__ void gemm_phase(LAS unsigned char* lds, const int wid, const Gemm g, const Sched& S, const Epi& E, const int f8s = 0x7f7f7f7f) {
    const int lane = lane_now(), tid = wid * 64 + lane, wr = wid >> 2, wc = wid & 3, fr = lane & 15, fq = lane >> 4;
    const int K = g.ld, nt = g.K / BK;
    unsigned voffA, voffB;
    { int R, C; stage_rc(tid * 16, R, C); const int Rb = Epi::PERM ? ((R & ~31) + perm32(R & 31)) : R;
      voffA = (unsigned)(R * K + C) * 2u; voffB = (unsigned)(Rb * K + C) * 2u; }
    const unsigned qstep = 64u * (unsigned)K * 2u;
    const unsigned kstep = (unsigned)(BK * 2);
    const unsigned hstep = (unsigned)HALF * K * 2;
    const unsigned tstep = 2 * hstep;
    const __amdgpu_buffer_rsrc_t rA = __builtin_amdgcn_make_buffer_rsrc((void*)g.A, 0, 0xffffffffu, 0x00020000), rB = __builtin_amdgcn_make_buffer_rsrc((void*)g.Bt, 0, 0xffffffffu, 0x00020000);
    const unsigned ldsw = (unsigned)wid * 1024u;
    const int aoff = lds_byte(wr * 64 + fr, fq * 8), boff = lds_byte(wc * 32 + fr, fq * 8);
#define PG8_SA(b, h) (((b) * 2 + (h)) * HTB)
#define PG8_SB(b, h) ((4 + (b) * 2 + (h)) * HTB)
#define PG8_STAGE(bufoff, rs, so, voff) do { _Pragma("unroll") for (int _i = 0; _i < 2; ++_i) \
        __builtin_amdgcn_raw_ptr_buffer_load_lds(rs, (LAS unsigned*)(lds + (bufoff) + ldsw + _i * 8192), 16, (int)(voff), (int)((so) + _i * qstep), 0, 0); } while (0)
#define PG8_LDA(dst, b, h) do { _Pragma("unroll") for (int m = 0; m < 4; ++m) _Pragma("unroll") for (int k = 0; k < 2; ++k) dst[m][k] = *(const LAS bf16x8*)(lds + PG8_SA(b, h) + aoff + m * 2048 + k * 1024); } while (0)
#define PG8_LDB(dst, b, h) do { _Pragma("unroll") for (int n = 0; n < 2; ++n) _Pragma("unroll") for (int k = 0; k < 2; ++k) dst[n][k] = *(const LAS bf16x8*)(lds + PG8_SB(b, h) + boff + n * 2048 + k * 1024); } while (0)
#define PG8_CAT(x0, x1) __builtin_shufflevector(__builtin_bit_cast(v4i_t, x0), __builtin_bit_cast(v4i_t, x1), 0, 1, 2, 3, 4, 5, 6, 7)
#define PG8_MMA(ai, bj, At, Bt) do { __builtin_amdgcn_s_setprio(1); _Pragma("unroll") for (int m = 0; m < 4; ++m) _Pragma("unroll") for (int n = 0; n < 2; ++n) { \
        if constexpr (F8) acc[ai][bj][m][n] = __builtin_amdgcn_mfma_scale_f32_16x16x128_f8f6f4(PG8_CAT(Bt[n][0], Bt[n][1]), PG8_CAT(At[m][0], At[m][1]), acc[ai][bj][m][n], 0, 0, 0, f8s, 1, f8s); \
        else if constexpr (I8) { _Pragma("unroll") for (int k = 0; k < 2; ++k) acc[ai][bj][m][n] = __builtin_bit_cast(f32x4, __builtin_amdgcn_mfma_i32_16x16x64_i8(__builtin_bit_cast(v4i_t, Bt[n][k]), __builtin_bit_cast(v4i_t, At[m][k]), __builtin_bit_cast(v4i_t, acc[ai][bj][m][n]), 0, 0, 0)); } \
        else { _Pragma("unroll") for (int k = 0; k < 2; ++k) acc[ai][bj][m][n] = __builtin_amdgcn_mfma_f32_16x16x32_bf16(Bt[n][k], At[m][k], acc[ai][bj][m][n], 0, 0, 0); } } \
        __builtin_amdgcn_s_setprio(0); } while (0)
#define PG8_WAIT_V(n) asm volatile("s_waitcnt vmcnt(" #n ")" ::: "memory")
#define PG8_WAIT_L(n) asm volatile("s_waitcnt lgkmcnt(" #n ")" ::: "memory")
#define PG8_BAR __builtin_amdgcn_s_barrier()
#define PG8_SCHED __builtin_amdgcn_sched_barrier(0)
    Unit cur, nxt; int ui = 0;
    if (!S.next(0, cur)) return;
    f32x4 acc[2][2][4][2];
#pragma unroll
    for (int a = 0; a < 2; ++a)
#pragma unroll
        for (int b = 0; b < 2; ++b)
#pragma unroll
            for (int m = 0; m < 4; ++m)
#pragma unroll
                for (int n = 0; n < 2; ++n) acc[a][b][m][n] = (f32x4){0.f, 0.f, 0.f, 0.f};
    bf16x8 At[4][2], B0[2][2], B1[2][2];
    unsigned cA = (unsigned)cur.am * tstep + (unsigned)cur.koff, cB = (unsigned)cur.bn * tstep + (unsigned)cur.koff;
    if constexpr (SP2) {
        PG8_STAGE(PG8_SB(0, 0), rB, cB, voffB); PG8_STAGE(PG8_SB(0, 1), rB, cB + hstep, voffB); PG8_STAGE(PG8_SA(0, 0), rA, cA, voffA); PG8_STAGE(PG8_SA(0, 1), rA, cA + hstep, voffA);
        if (wr == 1) PG8_BAR;
        PG8_WAIT_V(2); PG8_BAR;
        PG8_STAGE(PG8_SB(1, 0), rB, cB + kstep, voffB); PG8_STAGE(PG8_SA(1, 0), rA, cA + kstep, voffA); PG8_STAGE(PG8_SB(1, 1), rB, cB + hstep + kstep, voffB);
        PG8_WAIT_V(6); PG8_BAR;
    } else {
        PG8_STAGE(PG8_SB(0, 0), rB, cB, voffB); PG8_STAGE(PG8_SA(0, 0), rA, cA, voffA); PG8_STAGE(PG8_SB(0, 1), rB, cB + hstep, voffB); PG8_STAGE(PG8_SA(0, 1), rA, cA + hstep, voffA);
        if (wr == 1) PG8_BAR;
        PG8_WAIT_V(4); PG8_BAR;
        PG8_STAGE(PG8_SB(1, 0), rB, cB + kstep, voffB); PG8_STAGE(PG8_SA(1, 0), rA, cA + kstep, voffA); PG8_STAGE(PG8_SB(1, 1), rB, cB + hstep + kstep, voffB);
        PG8_WAIT_V(6); PG8_BAR;
    }
    for (;;) {
        const bool has_next = S.next(ui + 1, nxt);
        const unsigned nA = has_next ? (unsigned)nxt.am * tstep + (unsigned)nxt.koff : cA, nB = has_next ? (unsigned)nxt.bn * tstep + (unsigned)nxt.koff : cB;
#pragma unroll 1
        for (int t = 0; t < nt; t += 2) {
            const bool last = (t == nt - 2);
            const unsigned a1 = cA + (unsigned)(t + 1) * kstep;
            const unsigned a2 = last ? nA : cA + (unsigned)(t + 2) * kstep, b2 = last ? nB : cB + (unsigned)(t + 2) * kstep;
            const unsigned a3 = a2 + kstep, b3 = b2 + kstep;
            if constexpr (SP2) {
            PG8_LDB(B0, 0, 0); PG8_LDB(B1, 0, 1); PG8_SCHED; PG8_LDA(At, 0, 0); PG8_STAGE(PG8_SA(1, 1), rA, a1 + hstep, voffA);
            PG8_WAIT_V(8); PG8_WAIT_L(0); PG8_BAR; PG8_MMA(0, 0, At, B0); PG8_MMA(0, 1, At, B1); PG8_BAR; PG8_SCHED;
            PG8_LDA(At, 0, 1); PG8_STAGE(PG8_SB(0, 0), rB, b2, voffB); PG8_STAGE(PG8_SB(0, 1), rB, b2 + hstep, voffB); PG8_STAGE(PG8_SA(0, 0), rA, a2, voffA);
            PG8_WAIT_V(8); PG8_WAIT_L(0); PG8_BAR; PG8_MMA(1, 0, At, B0); PG8_MMA(1, 1, At, B1); PG8_BAR; PG8_SCHED;
            PG8_LDB(B0, 1, 0); PG8_LDB(B1, 1, 1); PG8_SCHED; PG8_LDA(At, 1, 0); PG8_STAGE(PG8_SA(0, 1), rA, a2 + hstep, voffA);
            PG8_WAIT_V(8); PG8_WAIT_L(0); PG8_BAR; PG8_MMA(0, 0, At, B0); PG8_MMA(0, 1, At, B1); PG8_BAR; PG8_SCHED;
            PG8_LDA(At, 1, 1); PG8_STAGE(PG8_SB(1, 0), rB, b3, voffB); PG8_STAGE(PG8_SB(1, 1), rB, b3 + hstep, voffB); PG8_STAGE(PG8_SA(1, 0), rA, a3, voffA);
            PG8_WAIT_V(8); PG8_WAIT_L(0); PG8_BAR; PG8_MMA(1, 0, At, B0); PG8_MMA(1, 1, At, B1); PG8_BAR; PG8_SCHED;
            } else {
            PG8_LDB(B0, 0, 0); PG8_SCHED; PG8_LDA(At, 0, 0); PG8_STAGE(PG8_SA(1, 1), rA, a1 + hstep, voffA);
            PG8_WAIT_L(8); PG8_BAR; PG8_WAIT_L(0); PG8_MMA(0, 0, At, B0); PG8_BAR; PG8_SCHED;
            PG8_LDB(B1, 0, 1); PG8_STAGE(PG8_SB(0, 0), rB, b2, voffB);
            PG8_BAR; PG8_WAIT_L(0); PG8_MMA(0, 1, At, B1); PG8_BAR;
            PG8_LDA(At, 0, 1); PG8_STAGE(PG8_SA(0, 0), rA, a2, voffA);
            PG8_BAR; PG8_WAIT_L(0); PG8_MMA(1, 0, At, B0); PG8_BAR; PG8_SCHED;
            PG8_STAGE(PG8_SB(0, 1), rB, b2 + hstep, voffB);
            PG8_WAIT_V(6); PG8_BAR; PG8_MMA(1, 1, At, B1); PG8_BAR;
            PG8_LDB(B0, 1, 0); PG8_SCHED; PG8_LDA(At, 1, 0); PG8_STAGE(PG8_SA(0, 1), rA, a2 + hstep, voffA);
            PG8_WAIT_L(8); PG8_BAR; PG8_WAIT_L(0); PG8_MMA(0, 0, At, B0); PG8_BAR; PG8_SCHED;
            PG8_LDB(B1, 1, 1); PG8_STAGE(PG8_SB(1, 0), rB, b3, voffB);
            PG8_BAR; PG8_WAIT_L(0); PG8_MMA(0, 1, At, B1); PG8_BAR;
            PG8_LDA(At, 1, 1); PG8_STAGE(PG8_SA(1, 0), rA, a3, voffA);
            PG8_BAR; PG8_WAIT_L(0); PG8_MMA(1, 0, At, B0); PG8_BAR; PG8_SCHED;
            PG8_STAGE(PG8_SB(1, 1), rB, b3 + hstep, voffB);
            PG8_WAIT_V(6); PG8_BAR; PG8_MMA(1, 1, At, B1); PG8_BAR;
            }
        }
        if constexpr (ALIGN_EPI) { if (wr == 0) PG8_BAR; }
        if constexpr (I8) {
#pragma unroll
            for (int a = 0; a < 2; ++a)
#pragma unroll
                for (int b = 0; b < 2; ++b)
#pragma unroll
                    for (int m = 0; m < 4; ++m)
#pragma unroll
                        for (int n = 0; n < 2; ++n) acc[a][b][m][n] = __builtin_convertvector(__builtin_bit_cast(v4i_t, acc[a][b][m][n]), f32x4); }
        if constexpr (!Epi::AFTER_DRAIN) { E(acc, cur, wr, wc, fr, fq); }
        if (!has_next) break;
#pragma unroll
        for (int a = 0; a < 2; ++a)
#pragma unroll
            for (int b = 0; b < 2; ++b)
#pragma unroll
                for (int m = 0; m < 4; ++m)
#pragma unroll
                    for (int n = 0; n < 2; ++n) acc[a][b][m][n] = (f32x4){0.f, 0.f, 0.f, 0.f};
        cur = nxt; cA = nA; cB = nB; ++ui;
        if constexpr (ALIGN_EPI) { if (wr == 1) PG8_BAR; }
    }
    PG8_WAIT_V(0);
    if constexpr (!ALIGN_EPI) { if (wr == 0) PG8_BAR; }
    PG8_BAR;
    if constexpr (Epi::AFTER_DRAIN) { E.fused(acc, cur, wr, wc, fr, fq, lds, wid, lane); }
#undef PG8_SA
#undef PG8_SB
#undef PG8_STAGE
#undef PG8_LDA
#undef PG8_LDB
#undef PG8_MMA
#undef PG8_CAT
#undef PG8_WAIT_V
#undef PG8_WAIT_L
#undef PG8_BAR
#undef PG8_SCHED
}
}

#define XB_TMO      128
#define XB_XCNT(j)  (256  + 64 * (j))
#define XB_XSUB(j)  (1280 + 64 * (j))
#define XB_XGEN(j)  (2304 + 64 * (j))
#define XB_TOP      3328
#define XB_TOPGEN   3392
#define XCD_BAR_WORDS 3456
#define XB_SPIN_CAP (1u << 18)
__device__ __forceinline__ unsigned xb_ld(unsigned* p)              { return __hip_atomic_load(p, __ATOMIC_RELAXED, __HIP_MEMORY_SCOPE_AGENT); }
__device__ __forceinline__ unsigned xb_add(unsigned* p, unsigned v) { return __hip_atomic_fetch_add(p, v, __ATOMIC_RELAXED, __HIP_MEMORY_SCOPE_AGENT); }
__device__ __forceinline__ unsigned xb_xcc_id() { return (unsigned)__builtin_amdgcn_s_getreg((3 << 11) | 20) & 0xFu; }
#define XB_SPIN(cond, bar) do { unsigned _sp = 0; while (cond) { __builtin_amdgcn_s_sleep(1); \
    if ((++_sp & 255u) == 0u) { if (xb_ld(&(bar)[XB_TMO])) break; if (_sp > XB_SPIN_CAP) { atomicAdd(&(bar)[XB_TMO], 1u); break; } } } } while (0)
struct XcdBarrier { unsigned* bar; unsigned x; volatile LAS unsigned* st; int wave; };
__device__ __forceinline__ XcdBarrier xcd_barrier_post(unsigned* bar, volatile LAS unsigned* st, int wave) {
    XcdBarrier b; b.bar = bar; b.x = xb_xcc_id(); b.st = st; b.wave = wave;
    if (wave == 0 && lane_now() == 0) (void)xb_add(&bar[XB_XCNT(b.x)], 1u);
    return b;
}
__device__ __forceinline__ void xcd_barrier_complete(unsigned* bar, unsigned x, unsigned& nloc, unsigned& nx) {
    const unsigned G = gridDim.x * gridDim.y * gridDim.z;
    unsigned sum, cnt, mine, sp = 0u;
    for (;;) {
        sum = 0u; cnt = 0u; mine = 0u;
#pragma unroll
        for (unsigned j = 0; j < 16; ++j) { const unsigned c = xb_ld(&bar[XB_XCNT(j)]); sum += c; cnt += (c > 0u) ? 1u : 0u; mine = (j == x) ? c : mine; }
        if (sum == G) break;
        __builtin_amdgcn_s_sleep(1);
        if ((++sp & 255u) == 0u) { if (xb_ld(&bar[XB_TMO])) break; if (sp > XB_SPIN_CAP) { atomicAdd(&bar[XB_TMO], 1u); break; } }
    }
    nloc = mine > 0u ? mine : 1u; nx = cnt > 0u ? cnt : 1u;
}
__device__ __forceinline__ void xcd_barrier(const XcdBarrier& b) {
    asm volatile("s_waitcnt vmcnt(0)" ::: "memory");
    __syncthreads();
    if (b.wave == 0 && lane_now() == 0) {
        unsigned* bar = b.bar;
        __builtin_amdgcn_s_waitcnt(0);
        unsigned nloc = b.st[0], nx = b.st[1];
        if (nloc == 0u) { xcd_barrier_complete(bar, b.x, nloc, nx); b.st[0] = nloc; b.st[1] = nx; }
        const unsigned old = xb_add(&bar[XB_XSUB(b.x)], 1u);
        const unsigned gen = old / nloc;
        if (old + 1u == (gen + 1u) * nloc) {
            __builtin_amdgcn_fence(__ATOMIC_RELEASE, "agent");
            asm volatile("s_waitcnt vmcnt(0)" ::: "memory");
            const unsigned og = xb_add(&bar[XB_TOP], 1u);
            const unsigned tg = og / nx;
            if (og + 1u == (tg + 1u) * nx) xb_add(&bar[XB_TOPGEN], 1u);
            else XB_SPIN(xb_ld(&bar[XB_TOPGEN]) == tg, bar);
            __builtin_amdgcn_fence(__ATOMIC_ACQUIRE, "agent");
            xb_add(&bar[XB_XGEN(b.x)], 1u);
            asm volatile("s_waitcnt vmcnt(0)" ::: "memory");
        } else {
            XB_SPIN(xb_ld(&bar[XB_XGEN(b.x)]) == gen, bar);
            __builtin_amdgcn_fence(__ATOMIC_ACQUIRE, "agent");
            asm volatile("s_waitcnt vmcnt(0)" ::: "memory");
        }
    }
    __syncthreads();
}

typedef const __attribute__((address_space(4))) unsigned char* kptr_t;
struct Frame {
    LAS unsigned char* lds;
    int wave, vcu, G;
    kptr_t kp;
    float* out; unsigned char* ws;
};
__device__ __forceinline__ const float* inp(const Frame& F, int i) { kptr_t p = F.kp; asm volatile("" : "+s"(p)); return *(const float* const __attribute__((address_space(4)))*)(p + 8 * i); }
#define WSP(T, off) ((T*)(F.ws + (off)))

__device__ const double INVF_REV[32] = {0.15915494309189535, 0.11934937021124886, 0.089499401608891013, 0.067115083005227255, 0.050329212104487035, 0.037741584717419778, 0.028302195830623399, 0.02122365276477766,
    0.015915494309189534, 0.011934937021124886, 0.0089499401608891006, 0.0067115083005227253, 0.0050329212104487037, 0.0037741584717419768, 0.0028302195830623399, 0.0021223652764777662,
    0.0015915494309189536, 0.0011934937021124887, 0.00089499401608891024, 0.0006711508300522726, 0.00050329212104487043, 0.00037741584717419774, 0.00028302195830623401, 0.00021223652764777661,
    0.00015915494309189535, 0.00011934937021124886, 8.9499401608891018e-05, 6.7115083005227268e-05, 5.0329212104487035e-05, 3.7741584717419777e-05, 2.8302195830623399e-05, 2.1223652764777659e-05};

template <bool F8 = false>
__device__ __forceinline__ void tr_tile64(const float* W, int N, const float* gain, bf16_t* WT, int ldt, int drow, int k0, int ncol, int rg, float sc = 1.0f) {
    const float* src = W + (size_t)(k0 + rg * 16) * N + ncol;
    f32x4 v[16];
#pragma unroll
    for (int i = 0; i < 16; ++i) v[i] = __builtin_nontemporal_load((const f32x4*)(src + (size_t)i * N));
    if (gain) { f32x4 g[4];
#pragma unroll
        for (int q = 0; q < 4; ++q) g[q] = *(const f32x4*)(gain + k0 + rg * 16 + 4 * q);
#pragma unroll
        for (int i = 0; i < 16; ++i) v[i] = v[i] * g[i >> 2][i & 3]; }
    if constexpr (F8) {
#pragma unroll
        for (int j = 0; j < 4; ++j) { u32x4 a;
            a.x = pk4_fp8(v[0][j] * sc, v[1][j] * sc, v[2][j] * sc, v[3][j] * sc); a.y = pk4_fp8(v[4][j] * sc, v[5][j] * sc, v[6][j] * sc, v[7][j] * sc);
            a.z = pk4_fp8(v[8][j] * sc, v[9][j] * sc, v[10][j] * sc, v[11][j] * sc); a.w = pk4_fp8(v[12][j] * sc, v[13][j] * sc, v[14][j] * sc, v[15][j] * sc);
            *(u32x4*)((unsigned char*)WT + (size_t)(drow + j) * ldt + k0 + rg * 16) = a; }
        return; }
#pragma unroll
    for (int j = 0; j < 4; ++j) { u32x4 a, b;
        a.x = cvt_pk_bf16(v[0][j], v[1][j]); a.y = cvt_pk_bf16(v[2][j], v[3][j]); a.z = cvt_pk_bf16(v[4][j], v[5][j]); a.w = cvt_pk_bf16(v[6][j], v[7][j]);
        b.x = cvt_pk_bf16(v[8][j], v[9][j]); b.y = cvt_pk_bf16(v[10][j], v[11][j]); b.z = cvt_pk_bf16(v[12][j], v[13][j]); b.w = cvt_pk_bf16(v[14][j], v[15][j]);
        bf16_t* d = WT + (size_t)(drow + j) * ldt + k0 + rg * 16; *(u32x4*)d = a; *(u32x4*)(d + 8) = b; }
}
template <bool F8>
__device__ __forceinline__ void tr_tile128(const float* W, int N, const float* gain, unsigned char* WT  , int ldt  , int k0, int ncol, int rg, float sc) {
    f32x4 v[16];
    if constexpr (F8) { const float* src = W + (size_t)(k0 + rg * 16) * N + ncol;
#pragma unroll
        for (int i = 0; i < 16; ++i) v[i] = __builtin_nontemporal_load((const f32x4*)(src + (size_t)i * N));
        if (gain) { f32x4 g[4];
#pragma unroll
            for (int q = 0; q < 4; ++q) g[q] = *(const f32x4*)(gain + k0 + rg * 16 + 4 * q);
#pragma unroll
            for (int i = 0; i < 16; ++i) v[i] = v[i] * (g[i >> 2][i & 3] * sc); }
        else {
#pragma unroll
            for (int i = 0; i < 16; ++i) v[i] = v[i] * sc; }
#pragma unroll
        for (int j = 0; j < 4; ++j) { u32x4 a;
            a.x = pk4_fp8(v[0][j], v[1][j], v[2][j], v[3][j]); a.y = pk4_fp8(v[4][j], v[5][j], v[6][j], v[7][j]);
            a.z = pk4_fp8(v[8][j], v[9][j], v[10][j], v[11][j]); a.w = pk4_fp8(v[12][j], v[13][j], v[14][j], v[15][j]);
            *(u32x4*)(WT + (size_t)j * ldt + rg * 16) = a; } }
    else { const float* src = W + (size_t)(k0 + rg * 8) * N + ncol;
#pragma unroll
        for (int i = 0; i < 8; ++i) { v[i] = __builtin_nontemporal_load((const f32x4*)(src + (size_t)i * N)); v[8 + i] = __builtin_nontemporal_load((const f32x4*)(src + (size_t)(64 + i) * N)); }
        if (gain) { f32x4 g[4];
#pragma unroll
            for (int q = 0; q < 2; ++q) { g[q] = *(const f32x4*)(gain + k0 + rg * 8 + 4 * q); g[2 + q] = *(const f32x4*)(gain + k0 + 64 + rg * 8 + 4 * q); }
#pragma unroll
            for (int i = 0; i < 16; ++i) v[i] = v[i] * g[i >> 2][i & 3]; }
#pragma unroll
        for (int j = 0; j < 4; ++j) { u32x4 a, b;
            a.x = cvt_pk_bf16(v[0][j], v[1][j]); a.y = cvt_pk_bf16(v[2][j], v[3][j]); a.z = cvt_pk_bf16(v[4][j], v[5][j]); a.w = cvt_pk_bf16(v[6][j], v[7][j]);
            b.x = cvt_pk_bf16(v[8][j], v[9][j]); b.y = cvt_pk_bf16(v[10][j], v[11][j]); b.z = cvt_pk_bf16(v[12][j], v[13][j]); b.w = cvt_pk_bf16(v[14][j], v[15][j]);
            *(u32x4*)(WT + (size_t)j * ldt + rg * 16) = a; *(u32x4*)(WT + (size_t)j * ldt + 128 + rg * 16) = b; } }
}
__device__ __forceinline__ void norm_row_bf16(const float* xrow, bf16_t* orow, bf16_t* raw, float* rs, int lane) {
    const f32x4* xr = (const f32x4*)xrow + lane; f32x4 v[8]; float s = 0.f;
#pragma unroll
    for (int j = 0; j < 8; ++j) { v[j] = xr[64 * j]; s += (v[j][0] * v[j][0] + v[j][1] * v[j][1]) + (v[j][2] * v[j][2] + v[j][3] * v[j][3]); }
    const float r = 1.0f * __builtin_amdgcn_rsqf(wave_sum(s) * (1.0f / 2048.0f) + EPS);
    if (orow) { u32x2* o8 = (u32x2*)orow + lane;
#pragma unroll
        for (int j = 0; j < 8; ++j) { u32x2 w; w.x = cvt_pk_bf16(v[j][0] * r, v[j][1] * r); w.y = cvt_pk_bf16(v[j][2] * r, v[j][3] * r); o8[64 * j] = w; } }
    if (raw) { u32x2* r8 = (u32x2*)raw + lane;
#pragma unroll
        for (int j = 0; j < 8; ++j) { u32x2 w; w.x = cvt_pk_bf16(v[j][0], v[j][1]); w.y = cvt_pk_bf16(v[j][2], v[j][3]); r8[64 * j] = w; } }
    if (rs && lane == 0) *rs = r;
}
struct TrItem { const float* src; const float* gain; unsigned char* dst; int N, ldt, hi_rows, g_hi; float sc; int f8, useg; };
__device__ __forceinline__ void tr_load16(f32x4 (&v)[16], f32x4 (&g)[4], const TrItem& it) {
#pragma unroll
    for (int i = 0; i < 8; ++i) { v[i] = __builtin_nontemporal_load((const f32x4*)(it.src + (size_t)i * it.N)); v[8 + i] = __builtin_nontemporal_load((const f32x4*)(it.src + (size_t)(it.hi_rows + i) * it.N)); }
#pragma unroll
    for (int q = 0; q < 2; ++q) { const f32x4 a = *(const f32x4*)(it.gain + 4 * q), b = *(const f32x4*)(it.gain + it.g_hi + 4 * q);
        g[q] = it.useg ? a : (f32x4){1.f, 1.f, 1.f, 1.f}; g[2 + q] = it.useg ? b : (f32x4){1.f, 1.f, 1.f, 1.f}; }
}
__device__ __forceinline__ void tr_store16(f32x4 (&v)[16], const f32x4 (&g)[4], const TrItem& it) {
#pragma unroll
    for (int i = 0; i < 16; ++i) v[i] = v[i] * (g[i >> 2][i & 3] * it.sc);
    if (it.f8 == 2) {
#pragma unroll
        for (int j = 0; j < 4; ++j) { u32x4 a;
            a.x = pk4_i8(v[0][j], v[1][j], v[2][j], v[3][j]); a.y = pk4_i8(v[4][j], v[5][j], v[6][j], v[7][j]);
            a.z = pk4_i8(v[8][j], v[9][j], v[10][j], v[11][j]); a.w = pk4_i8(v[12][j], v[13][j], v[14][j], v[15][j]);
            __builtin_nontemporal_store(a, (u32x4*)(it.dst + (size_t)j * it.ldt)); } }
    else if (it.f8) {
#pragma unroll
        for (int j = 0; j < 4; ++j) { u32x4 a;
            a.x = pk4_fp8(v[0][j], v[1][j], v[2][j], v[3][j]); a.y = pk4_fp8(v[4][j], v[5][j], v[6][j], v[7][j]);
            a.z = pk4_fp8(v[8][j], v[9][j], v[10][j], v[11][j]); a.w = pk4_fp8(v[12][j], v[13][j], v[14][j], v[15][j]);
            __builtin_nontemporal_store(a, (u32x4*)(it.dst + (size_t)j * it.ldt)); } }
    else {
#pragma unroll
        for (int j = 0; j < 4; ++j) { u32x4 a, b;
            a.x = cvt_pk_bf16(v[0][j], v[1][j]); a.y = cvt_pk_bf16(v[2][j], v[3][j]); a.z = cvt_pk_bf16(v[4][j], v[5][j]); a.w = cvt_pk_bf16(v[6][j], v[7][j]);
            b.x = cvt_pk_bf16(v[8][j], v[9][j]); b.y = cvt_pk_bf16(v[10][j], v[11][j]); b.z = cvt_pk_bf16(v[12][j], v[13][j]); b.w = cvt_pk_bf16(v[14][j], v[15][j]);
            __builtin_nontemporal_store(a, (u32x4*)(it.dst + (size_t)j * it.ldt)); __builtin_nontemporal_store(b, (u32x4*)(it.dst + (size_t)j * it.ldt + 128)); } }
}
__device__ __forceinline__ void p0_prologue(Frame& F) {
    const int gw = F.vcu * 8 + F.wave, NGW = F.G * 8, lane = lane_now(), c4 = (lane & 15) * 4, rg = lane >> 4;
    const float* g_mix = inp(F, 3); const float* g_ffn = inp(F, 4); const float* g_mem = inp(F, 5);
    constexpr int IT_E = 3584;
    constexpr int I_MOE = 24 * IT_E, I_FFN = 3 * IT_E, I_IN0 = 32 * 80, I_OUT = 32 * 32, I_KVA = 32 * 5, I_BIN = 32 * 16, I_KVB = 4 * 48, I_QB = 8 * 36, I_MEM = 32 * 16;
    constexpr int NITEMS = I_MOE + I_FFN + I_IN0 + 2 * I_OUT + I_KVA + I_BIN + I_KVB + I_QB + 2 * I_MEM;
    {
      const int rg8 = lane & 7, c8 = (lane >> 3) * 4;
      auto decode = [&](int r) -> TrItem { TrItem t;
          const int e = r / (3 * IT_E), q = r % (3 * IT_E), kind = q / IT_E, j = q % IT_E; const bool moe = e < 8;
          if (kind < 2) { const float* W = moe ? inp(F, kind == 0 ? 25 : 26) + (size_t)e * DM * DFF : inp(F, kind == 0 ? 21 : 22);
              const int kb = j / 224, nb = j % 224, n = nb * 32 + c8, drow = (n >> 7) * 256 + (n & 127) + (kind ? 128 : 0), k0 = kb * 128, kl = k0 + 16 * rg8;
              t.src = W + (size_t)kl * DFF + n; t.N = DFF; t.hi_rows = 8; t.g_hi = 8; t.gain = g_ffn + (moe ? DM : 0) + kl; t.useg = 1; t.f8 = 2; t.sc = QWGU;
              t.ldt = DM; t.dst = (moe ? F.ws + WS_W_MGU + (size_t)e * 2 * DFF * DM : F.ws + WS_W_GU0) + (size_t)drow * DM + k0 + rg8 * 16; }
          else { const float* W = moe ? inp(F, 27) + (size_t)e * DFF * DM : inp(F, 23);
              const int kb = j / 64, nb = j % 64, n = nb * 32 + c8, k0 = kb * 128, kl = k0 + 16 * rg8;
              t.src = W + (size_t)kl * DM + n; t.N = DM; t.hi_rows = 8; t.g_hi = 8; t.gain = g_ffn; t.useg = 0; t.f8 = 2; t.sc = QWD;
              t.ldt = DFF; t.dst = (moe ? F.ws + WS_W_MD + (size_t)e * DM * DFF : F.ws + WS_W_D0) + (size_t)n * DFF + k0 + rg8 * 16; }
          return t; };
      constexpr int NBIG = I_MOE + I_FFN, NIT = 2 * ((NBIG + 2 * 2048 - 1) / (2 * 2048));
      auto item_of = [&](int k) -> int { const int kk = k < NIT - 1 ? k : NIT - 1; const int r = gw * 2 + (kk & 1) + (kk >> 1) * (2 * NGW); return NBIG - 1 - (r < NBIG ? r : r - 2 * NGW); };
      TrItem ia = decode(item_of(0)), ib; f32x4 va[16], ga[4], vb[16], gb[4]; tr_load16(va, ga, ia);
      for (int k = 0; k < NIT; k += 2) {
          ib = decode(item_of(k + 1)); tr_load16(vb, gb, ib);
          tr_store16(va, ga, ia);
          ia = decode(item_of(k + 2)); tr_load16(va, ga, ia);
          tr_store16(vb, gb, ib); } }
    for (int it = (I_MOE + I_FFN) + gw; it < NITEMS; it += NGW) {
        int r = it;
        r -= I_MOE + I_FFN;
        { const int rg8 = lane & 7, c8 = (lane >> 3) * 4;
        if (r < I_IN0) { const int k0 = (r / 160) * 128, n = (r % 160) * 32 + c8; tr_tile128<false>(inp(F, 10), NIN0, g_mix, F.ws + WS_W_IN0 + ((size_t)n * DM + k0) * 2, DM * 2, k0, n, rg8, 1.0f); continue; } r -= I_IN0;
        if (r < 2 * I_OUT) { const int l = r / I_OUT, j = r % I_OUT, k0 = (j / 64) * 128, n = (j % 64) * 32 + c8;
            if (l) tr_tile128<true>(inp(F, 9) + (size_t)DM * DM, DM, nullptr, F.ws + WS_W_OUT1 + (size_t)n * DM + k0, DM, k0, n, rg8, 64.0f);
            else tr_tile128<false>(inp(F, 9), DM, nullptr, F.ws + WS_W_OUT0 + ((size_t)n * DM + k0) * 2, DM * 2, k0, n, rg8, 1.0f); continue; } r -= 2 * I_OUT;
        if (r < I_KVA) { const int k0 = (r / 10) * 128, n = (r % 10) * 32 + c8; tr_tile128<true>(inp(F, 17), 320, inp(F, 16), F.ws + WS_W_1 + (size_t)n * DM + k0, DM, k0, n, rg8, 64.0f); continue; } r -= I_KVA;
        if (r < I_BIN) { const int k0 = (r / 32) * 128, n = (r % 32) * 32 + c8; tr_tile128<true>(inp(F, 12), 1024, g_mix + DM, F.ws + WS_W_1 + (size_t)(512 + n) * DM + k0, DM, k0, n, rg8, 64.0f); continue; } r -= I_BIN;
        if (r < I_KVB) { const int k0 = (r / 96) * 128, n = (r % 96) * 32 + c8, h = n >> 8, j = n & 255;
            tr_tile128<false>(inp(F, 19), 3072, inp(F, 18), F.ws + (j < 128 ? WS_W_KN : WS_W_V) + ((size_t)(h * 128 + (j & 127)) * 256 + k0) * 2, 512, k0, n, rg8, 1.0f); continue; } r -= I_KVB;
        if (r < I_QB) { const int k0 = (r / 72) * 128, n = (r % 72) * 32 + c8; tr_tile128<false>(inp(F, 14), 2304, inp(F, 13), F.ws + WS_W_QB + ((size_t)n * 512 + k0) * 2, 1024, k0, n, rg8, 1.0f); continue; } r -= I_QB;
        { const int l = r / I_MEM, j = r % I_MEM, k0 = (j / 32) * 128, n = (j % 32) * 32 + c8;
            tr_tile128<false>(inp(F, 6) + (size_t)l * DM * 1024, 1024, g_mem + l * DM, F.ws + (n < 512 ? WS_W_MK : WS_W_MV) + ((size_t)(l * 512 + (n & 511)) * DM + k0) * 2, DM * 2, k0, n, rg8, 1.0f); } }
    }
    for (int m = gw; m < NTOK; m += 2 * NGW) {
        const f32x4* xa = (const f32x4*)(inp(F, 0) + (size_t)m * DM) + lane; const f32x4* xc = xa + (size_t)NGW * (DM / 4); f32x4 va[8], vc[8]; float sa = 0.f, sc = 0.f;
#pragma unroll
        for (int j = 0; j < 8; ++j) { va[j] = xa[64 * j]; vc[j] = xc[64 * j]; }
#pragma unroll
        for (int j = 0; j < 8; ++j) { sa += (va[j][0] * va[j][0] + va[j][1] * va[j][1]) + (va[j][2] * va[j][2] + va[j][3] * va[j][3]); sc += (vc[j][0] * vc[j][0] + vc[j][1] * vc[j][1]) + (vc[j][2] * vc[j][2] + vc[j][3] * vc[j][3]); }
        sa = wave_sum(sa); sc = wave_sum(sc);
        u32x2* ra = (u32x2*)(WSP(bf16_t, WS_XB) + (size_t)m * DM) + lane; u32x2* rc = ra + (size_t)NGW * (DM / 4);
#pragma unroll
        for (int j = 0; j < 8; ++j) { u32x2 w; w.x = cvt_pk_bf16(va[j][0], va[j][1]); w.y = cvt_pk_bf16(va[j][2], va[j][3]); ra[64 * j] = w; w.x = cvt_pk_bf16(vc[j][0], vc[j][1]); w.y = cvt_pk_bf16(vc[j][2], vc[j][3]); rc[64 * j] = w; }
        if (lane == 0) { WSP(float, WS_RS0)[m] = 1.0f * __builtin_amdgcn_rsqf(sa * (1.0f / 2048.0f) + EPS); WSP(float, WS_RS0)[m + NGW] = 1.0f * __builtin_amdgcn_rsqf(sc * (1.0f / 2048.0f) + EPS); } }
    for (int m = gw; m < 512; m += NGW) norm_row_bf16(inp(F, 1) + (size_t)m * DM, WSP(bf16_t, WS_MEMN) + (size_t)m * DM, nullptr, nullptr, lane);
    const int gt = F.vcu * 512 + F.wave * 64 + lane_now(), NGT = F.G * 512;
    for (int i = gt; i < 8 * DM; i += NGT) { const int e = i / DM, k = i % DM; WSP(float, WS_WR)[i] = g_ffn[DM + k] * inp(F, 24)[k * 8 + e]; }
    for (int i = gt; i < 192 * DM / 16; i += NGT) ((u32x4*)(F.ws + WS_W_1 + (size_t)320 * DM))[i] = (u32x4){0u, 0u, 0u, 0u};
}

__device__ __forceinline__ void unpack8(const u32x4 w, float (&f)[8]) { f[0] = bf_lo(w.x); f[1] = bf_hi(w.x); f[2] = bf_lo(w.y); f[3] = bf_hi(w.y); f[4] = bf_lo(w.z); f[5] = bf_hi(w.z); f[6] = bf_lo(w.w); f[7] = bf_hi(w.w); }
__device__ __forceinline__ void p2_conv(Frame& F) {
    const bf16_t* U0 = WSP(bf16_t, WS_U0); bf16_t* CAT = WSP(bf16_t, WS_CAT); const float* cw = inp(F, 11);
    const int gt = F.vcu * 512 + F.wave * 64 + lane_now(), NGT = F.G * 512;
    for (int idx = gt; idx < NTOK * 192; idx += NGT) {
        const int t = idx / 192, c = (idx % 192) * 8, s = t & (SEQ - 1);
        const bf16_t* r0 = U0 + (size_t)t * NIN0 + c; const bf16_t* r1 = r0 - (s >= 1 ? NIN0 : 0); const bf16_t* r2 = r0 - (s >= 2 ? 2 * NIN0 : 0);
        const u32x4 qx0 = *(const u32x4*)r0, qg0 = *(const u32x4*)(r0 + 3072), qb = *(const u32x4*)(r0 + 1536), qx1 = *(const u32x4*)r1, qg1 = *(const u32x4*)(r1 + 3072), qx2 = *(const u32x4*)r2, qg2 = *(const u32x4*)(r2 + 3072);
        const f32x4 w2a = *(const f32x4*)(cw + 2 * 1536 + c), w2b = *(const f32x4*)(cw + 2 * 1536 + c + 4), w1a = *(const f32x4*)(cw + 1536 + c), w1b = *(const f32x4*)(cw + 1536 + c + 4), w0a = *(const f32x4*)(cw + c), w0b = *(const f32x4*)(cw + c + 4);
        const float m1 = s >= 1 ? 1.0f : 0.0f, m2 = s >= 2 ? 1.0f : 0.0f;
        float xin[8], gc[8], gb[8], y[8];
        unpack8(qx0, xin); unpack8(qg0, gc); unpack8(qb, gb);
#pragma unroll
        for (int i = 0; i < 8; ++i) y[i] = (i < 4 ? w2a[i] : w2b[i - 4]) * (gc[i] * xin[i]);
        unpack8(qx1, xin); unpack8(qg1, gc);
#pragma unroll
        for (int i = 0; i < 8; ++i) y[i] += (m1 * (i < 4 ? w1a[i] : w1b[i - 4])) * (gc[i] * xin[i]);
        unpack8(qx2, xin); unpack8(qg2, gc);
#pragma unroll
        for (int i = 0; i < 8; ++i) y[i] += (m2 * (i < 4 ? w0a[i] : w0b[i - 4])) * (gc[i] * xin[i]);
        u32x4 o; o.x = cvt_pk_bf16(gb[0] * y[0], gb[1] * y[1]); o.y = cvt_pk_bf16(gb[2] * y[2], gb[3] * y[3]); o.z = cvt_pk_bf16(gb[4] * y[4], gb[5] * y[5]); o.w = cvt_pk_bf16(gb[6] * y[6], gb[7] * y[7]);
        *(u32x4*)(CAT + (size_t)t * DM + c) = o;
    }
}
constexpr float CMEM = 0.08838834764831845f * LOG2E;
constexpr float CMLA = 0.07216878364870323f * LOG2E;
__device__ __forceinline__ int crow(int r, int hi) { return (r & 3) + 8 * (r >> 2) + 4 * hi; }
template <int NK16, bool CAUSAL, bool OUT8 = false>
__device__ __forceinline__ void attn_wave(const bf16_t* Qp, const bf16_t* Kp, const bf16_t* Vt, int ldv, int ntiles, bf16_t* Op, int ldo, int lane, int kt0 = 0, LAS float* xch = nullptr, int xrole = -1, const float* qgain = nullptr, int ldq = 0, float qscale = 0.f) {
    constexpr int DQK = NK16 * 16;
    const int r32 = lane & 31, hi = lane >> 5;
    bf16x8 qf[NK16];
    if (qgain) { u32x4 raw[NK16]; float ss = 0.f;
#pragma unroll
        for (int d0 = 0; d0 < NK16; ++d0) raw[d0] = *(const u32x4*)(Qp + (size_t)r32 * ldq + d0 * 16 + hi * 8);
#pragma unroll
        for (int d0 = 0; d0 < NK16; ++d0) { float a[8]; unpack8(raw[d0], a);
#pragma unroll
            for (int e = 0; e < 8; ++e) ss += a[e] * a[e]; }
        ss += other_half(ss, lane);
        const float r = qscale * __builtin_amdgcn_rsqf(ss * (1.0f / DQK) + EPS);
#pragma unroll
        for (int d0 = 0; d0 < NK16; ++d0) { float a[8]; unpack8(raw[d0], a); const f32x4 g0 = *(const f32x4*)(qgain + d0 * 16 + hi * 8), g1 = *(const f32x4*)(qgain + d0 * 16 + hi * 8 + 4);
            u32x4 wv; wv.x = cvt_pk_bf16(a[0] * r * g0[0], a[1] * r * g0[1]); wv.y = cvt_pk_bf16(a[2] * r * g0[2], a[3] * r * g0[3]); wv.z = cvt_pk_bf16(a[4] * r * g1[0], a[5] * r * g1[1]); wv.w = cvt_pk_bf16(a[6] * r * g1[2], a[7] * r * g1[3]);
            qf[d0] = __builtin_bit_cast(bf16x8, wv); } }
    else {
#pragma unroll
        for (int d0 = 0; d0 < NK16; ++d0) qf[d0] = *(const bf16x8*)(Qp + (size_t)r32 * DQK + d0 * 16 + hi * 8); }
    f32x16 o[4]; float m = -1e30f, l = 0.f;
#pragma unroll
    for (int db = 0; db < 4; ++db)
#pragma unroll
        for (int r = 0; r < 16; ++r) o[db][r] = 0.f;
    bf16x8 kf[NK16], vf[4][2];
    auto ldk = [&](int kt) { const bf16_t* kr = Kp + (size_t)(kt * 32 + r32) * DQK + hi * 8;
#pragma unroll
        for (int d0 = 0; d0 < NK16; ++d0) kf[d0] = *(const bf16x8*)(kr + d0 * 16); };
    auto ldvt = [&](int kt) { const bf16_t* vr0 = Vt + (size_t)r32 * ldv + kt * 32 + hi * 8;
#pragma unroll
        for (int db = 0; db < 4; ++db)
#pragma unroll
            for (int ks = 0; ks < 2; ++ks) vf[db][ks] = *(const bf16x8*)(vr0 + (size_t)(db * 32) * ldv + ks * 16); };
    ldk(kt0); ldvt(kt0);
    for (int kt = kt0; kt < ntiles; ++kt) {
        const int ktn = kt + 1 < ntiles ? kt + 1 : kt;
        f32x16 p;
#pragma unroll
        for (int r = 0; r < 16; ++r) p[r] = 0.f;
        __builtin_amdgcn_sched_barrier(0);
#pragma unroll
        for (int d0 = 0; d0 < NK16; ++d0) p = __builtin_amdgcn_mfma_f32_32x32x16_bf16(kf[d0], qf[d0], p, 0, 0, 0);
        __builtin_amdgcn_sched_barrier(0);
        ldk(ktn);
        __builtin_amdgcn_sched_barrier(0);
        if (CAUSAL && kt == ntiles - 1) {
#pragma unroll
            for (int r = 0; r < 16; ++r) if (crow(r, hi) > r32) p[r] = -__builtin_inff();
        }
        float pm = p[0];
#pragma unroll
        for (int r = 1; r < 16; ++r) pm = fmaxf(pm, p[r]);
        pm = half_max(pm);
        const float mn = fmaxf(m, pm), alpha = __builtin_amdgcn_exp2f(m - mn); m = mn;
        float ps = 0.f;
#pragma unroll
        for (int r = 0; r < 16; ++r) { p[r] = __builtin_amdgcn_exp2f(p[r] - mn); ps += p[r]; }
        ps = half_sum(ps); l = l * alpha + ps;
        if (!__all(alpha == 1.0f)) {
#pragma unroll
            for (int db = 0; db < 4; ++db)
#pragma unroll
                for (int r = 0; r < 16; ++r) o[db][r] *= alpha;
        }
        bf16x8 pa[2];
#pragma unroll
        for (int ks = 0; ks < 2; ++ks) { const unsigned a0 = cvt_pk_bf16(p[8 * ks + 0], p[8 * ks + 1]), a1 = cvt_pk_bf16(p[8 * ks + 2], p[8 * ks + 3]), b0 = cvt_pk_bf16(p[8 * ks + 4], p[8 * ks + 5]), b1 = cvt_pk_bf16(p[8 * ks + 6], p[8 * ks + 7]);
            auto r0 = __builtin_amdgcn_permlane32_swap(a0, b0, false, false); auto r1 = __builtin_amdgcn_permlane32_swap(a1, b1, false, false);
            u32x4 w = {r0[0], r1[0], r0[1], r1[1]}; pa[ks] = __builtin_bit_cast(bf16x8, w); }
#pragma unroll
        for (int ks = 0; ks < 2; ++ks)
#pragma unroll
            for (int db = 0; db < 4; ++db) o[db] = __builtin_amdgcn_mfma_f32_32x32x16_bf16(vf[db][ks], pa[ks], o[db], 0, 0, 0);
        __builtin_amdgcn_sched_barrier(0);
        ldvt(ktn);
    }
    if (xrole >= 0) {
        if (xrole == 1) {
#pragma unroll
            for (int db = 0; db < 4; ++db)
#pragma unroll
                for (int r = 0; r < 16; ++r) xch[(db * 16 + r) * 64 + lane] = o[db][r];
            xch[64 * 64 + lane] = m; xch[65 * 64 + lane] = l; }
        asm volatile("s_waitcnt lgkmcnt(0)" ::: "memory"); __builtin_amdgcn_s_barrier(); asm volatile("" ::: "memory");
        if (xrole == 1) return;
        const float mb = xch[64 * 64 + lane], lb = xch[65 * 64 + lane], M = fmaxf(m, mb), fa = __builtin_amdgcn_exp2f(m - M), fb = __builtin_amdgcn_exp2f(mb - M);
        l = l * fa + lb * fb;
#pragma unroll
        for (int db = 0; db < 4; ++db)
#pragma unroll
            for (int r = 0; r < 16; ++r) o[db][r] = o[db][r] * fa + xch[(db * 16 + r) * 64 + lane] * fb; }
    if constexpr (OUT8) { const float inv = 16.0f / l; unsigned char* orow = (unsigned char*)Op + (size_t)r32 * ldo + 4 * hi;
#pragma unroll
        for (int db = 0; db < 4; ++db)
#pragma unroll
            for (int g = 0; g < 4; ++g) *(unsigned*)(orow + db * 32 + 8 * g) = pk4_fp8(o[db][4 * g] * inv, o[db][4 * g + 1] * inv, o[db][4 * g + 2] * inv, o[db][4 * g + 3] * inv);
        return; }
    const float inv = 1.0f / l;
    bf16_t* orow = Op + (size_t)r32 * ldo + 4 * hi;
#pragma unroll
    for (int db = 0; db < 4; ++db)
#pragma unroll
        for (int g = 0; g < 4; ++g) { u32x2 w; w.x = cvt_pk_bf16(o[db][4 * g] * inv, o[db][4 * g + 1] * inv); w.y = cvt_pk_bf16(o[db][4 * g + 2] * inv, o[db][4 * g + 3] * inv);
            *(u32x2*)(orow + db * 32 + 8 * g) = w; }
}
__device__ __forceinline__ void mem_attn_unit(Frame& F, int l, int uid) {
    const int bh = uid >> 7, qb = uid & 127, b = bh >> 2, h = bh & 3;
    const bf16_t* Qp = WSP(bf16_t, WS_QM) + ((size_t)bh * SEQ + qb * 32) * 128; const bf16_t* Kp = WSP(bf16_t, WS_MEMKF) + (size_t)((l * 2 + b) * 4 + h) * 256 * 128;
    const bf16_t* Vp = WSP(bf16_t, WS_MEMVT) + (size_t)(l * 512 + h * 128) * 512 + b * 256;
    if (l == 0) { const int half = F.wave >> 2;
        attn_wave<8, false, false>(WSP(bf16_t, WS_U0) + (size_t)(b * SEQ + qb * 32) * NIN0 + 4608 + h * 128, Kp, Vp, 512, 4 * half + 4, WSP(bf16_t, WS_CAT) + (size_t)(b * SEQ + qb * 32) * DM + 1536 + h * 128, DM, lane_now(),
                                   4 * half, (LAS float*)F.lds + (F.wave & 3) * (66 * 64), half, inp(F, 7), NIN0, CMEM); }
    else attn_wave<8, false, true>(Qp, Kp, Vp, 512, 8, (bf16_t*)(F.ws + WS_CAT + (size_t)(b * SEQ + qb * 32) * DM + 1536 + h * 128), DM, lane_now());
}

__device__ __forceinline__ void p6b_latents(Frame& F) {
    const int gw = F.vcu * 8 + F.wave, NGW = F.G * 8, lane = lane_now();
    const float* U1F = WSP(float, WS_U1F); const float* g_mq1 = inp(F, 7) + 128;
    for (int t = gw; t < NTOK; t += NGW) { const float* row = U1F + (size_t)t * N1; const int b = t >> 12, s = t & (SEQ - 1);
        { const f32x4 v = *(const f32x4*)(row + 4 * lane); const float r = 1.0f * __builtin_amdgcn_rsqf(wave_sum((v[0] * v[0] + v[1] * v[1]) + (v[2] * v[2] + v[3] * v[3])) * (1.0f / 256.0f) + EPS);
          u32x2 w; w.x = cvt_pk_bf16(v[0] * r, v[1] * r); w.y = cvt_pk_bf16(v[2] * r, v[3] * r); *(u32x2*)(WSP(bf16_t, WS_CKV) + (size_t)t * 256 + 4 * lane) = w; }
        { const f32x4 v0 = *(const f32x4*)(row + 512 + 8 * lane), v1 = *(const f32x4*)(row + 512 + 8 * lane + 4);
          const float r = 1.0f * __builtin_amdgcn_rsqf(wave_sum((v0[0] * v0[0] + v0[1] * v0[1]) + (v0[2] * v0[2] + v0[3] * v0[3]) + (v1[0] * v1[0] + v1[1] * v1[1]) + (v1[2] * v1[2] + v1[3] * v1[3])) * (1.0f / 512.0f) + EPS);
          u32x4 w; w.x = cvt_pk_bf16(v0[0] * r, v0[1] * r); w.y = cvt_pk_bf16(v0[2] * r, v0[3] * r); w.z = cvt_pk_bf16(v1[0] * r, v1[1] * r); w.w = cvt_pk_bf16(v1[2] * r, v1[3] * r);
          *(u32x4*)(WSP(bf16_t, WS_CQ) + (size_t)t * 512 + 8 * lane) = w; }
        { const f32x4 v0 = *(const f32x4*)(row + 1024 + 8 * lane), v1 = *(const f32x4*)(row + 1024 + 8 * lane + 4);
          float ss = (v0[0] * v0[0] + v0[1] * v0[1]) + (v0[2] * v0[2] + v0[3] * v0[3]) + (v1[0] * v1[0] + v1[1] * v1[1]) + (v1[2] * v1[2] + v1[3] * v1[3]);
          ss = row16_sum(ss);
          const float r = CMEM * __builtin_amdgcn_rsqf(ss * (1.0f / 128.0f) + EPS); const int h = lane >> 4, d = (lane & 15) * 8;
          const f32x4 g0 = *(const f32x4*)(g_mq1 + d), g1 = *(const f32x4*)(g_mq1 + d + 4);
          u32x4 w; w.x = cvt_pk_bf16(v0[0] * r * g0[0], v0[1] * r * g0[1]); w.y = cvt_pk_bf16(v0[2] * r * g0[2], v0[3] * r * g0[3]); w.z = cvt_pk_bf16(v1[0] * r * g1[0], v1[1] * r * g1[1]); w.w = cvt_pk_bf16(v1[2] * r * g1[2], v1[3] * r * g1[3]);
          *(u32x4*)(WSP(bf16_t, WS_QM) + ((size_t)(b * 4 + h) * SEQ + s) * 128 + d) = w; }
    }
}
struct EpiMemKFinal {
    static constexpr bool PERM = true, AFTER_DRAIN = false;
    bf16_t* KF; const float* g_mk; LAS float* P;
    __device__ __forceinline__ void operator()(const f32x4 (&acc)[2][2][4][2], const pg8::Unit& u, int wr, int wc, int fr, int fq) const {
        using pg8::HALF;
#pragma unroll
        for (int ai = 0; ai < 2; ++ai)
#pragma unroll
            for (int m = 0; m < 4; ++m) { const int rl = ai * HALF + wr * 64 + m * 16 + fr;
#pragma unroll
                for (int bj = 0; bj < 2; ++bj) { const f32x4 a = acc[ai][bj][m][0], b = acc[ai][bj][m][1];
                    float s = (a[0] * a[0] + a[1] * a[1]) + (a[2] * a[2] + a[3] * a[3]) + (b[0] * b[0] + b[1] * b[1]) + (b[2] * b[2] + b[3] * b[3]);
                    s = rows4_sum(s);
                    if (fq == 0) P[(rl * 2 + bj) * 4 + wc] = s; } }
        asm volatile("s_waitcnt lgkmcnt(0)" ::: "memory"); __builtin_amdgcn_s_barrier(); asm volatile("" ::: "memory");
        const int cl = wc * 32 + 8 * fq, ly = u.pn >> 1;
        const f32x4 gk0 = *(const f32x4*)(g_mk + ly * 128 + cl), gk1 = *(const f32x4*)(g_mk + ly * 128 + cl + 4);
#pragma unroll
        for (int ai = 0; ai < 2; ++ai)
#pragma unroll
            for (int m = 0; m < 4; ++m) { const int rl = ai * HALF + wr * 64 + m * 16 + fr;
#pragma unroll
                for (int bj = 0; bj < 2; ++bj) { const int h = 2 * (u.pn & 1) + bj; const f32x4 p4 = *(const LAS f32x4*)(P + (rl * 2 + bj) * 4);
                    const float r = __builtin_amdgcn_rsqf(((p4[0] + p4[1]) + (p4[2] + p4[3])) * (1.0f / 128.0f) + EPS);
                    const f32x4 v0 = acc[ai][bj][m][0] * r * gk0, v1 = acc[ai][bj][m][1] * r * gk1;
                    u32x4 w; w.x = cvt_pk_bf16(v0[0], v0[1]); w.y = cvt_pk_bf16(v0[2], v0[3]); w.z = cvt_pk_bf16(v1[0], v1[1]); w.w = cvt_pk_bf16(v1[2], v1[3]);
                    *(u32x4*)(KF + ((size_t)((ly * 2 + u.pm) * 4 + h) * 256 + rl) * 128 + cl) = w; } }
    }
};
struct EpiKnFinal {
    static constexpr bool PERM = true, AFTER_DRAIN = false;
    bf16_t* KF; const float* kpe; const float* kss; const int* positions; const float* g_kn; LAS float* P;
    __device__ __forceinline__ void operator()(const f32x4 (&acc)[2][2][4][2], const pg8::Unit& u, int wr, int wc, int fr, int fq) const {
        using pg8::BM; using pg8::HALF;
#pragma unroll
        for (int ai = 0; ai < 2; ++ai)
#pragma unroll
            for (int m = 0; m < 4; ++m) { const int rl = ai * HALF + wr * 64 + m * 16 + fr;
#pragma unroll
                for (int bj = 0; bj < 2; ++bj) { const f32x4 a = acc[ai][bj][m][0], b = acc[ai][bj][m][1];
                    float s = (a[0] * a[0] + a[1] * a[1]) + (a[2] * a[2] + a[3] * a[3]) + (b[0] * b[0] + b[1] * b[1]) + (b[2] * b[2] + b[3] * b[3]);
                    s = rows4_sum(s);
                    if (fq == 0) P[(rl * 2 + bj) * 4 + wc] = s; } }
        asm volatile("s_waitcnt lgkmcnt(0)" ::: "memory"); __builtin_amdgcn_s_barrier(); asm volatile("" ::: "memory");
        const int cl = wc * 32 + 8 * fq, i0 = 8 * wc + 2 * fq;
        const f32x4 gk0 = *(const f32x4*)(g_kn + cl), gk1 = *(const f32x4*)(g_kn + cl + 4);
        const float glo0 = g_kn[128 + i0], glo1 = g_kn[128 + i0 + 1], ghi0 = g_kn[160 + i0], ghi1 = g_kn[160 + i0 + 1];
        const double if0 = INVF_REV[i0], if1 = INVF_REV[i0 + 1];
#pragma unroll
        for (int ai = 0; ai < 2; ++ai)
#pragma unroll
            for (int m = 0; m < 4; ++m) { const int rl = ai * HALF + wr * 64 + m * 16 + fr, row = u.pm * BM + rl, b = row >> 12, sq = row & (SEQ - 1);
                const float kssv = kss[row]; const double pos = (double)positions[row];
                typedef float f32x2_t __attribute__((ext_vector_type(2)));
                const f32x2_t klo = *(const f32x2_t*)(kpe + (size_t)row * 64 + i0), khi = *(const f32x2_t*)(kpe + (size_t)row * 64 + 32 + i0);
                const double r0 = pos * if0, r1 = pos * if1; const float f0 = (float)(r0 - __builtin_rint(r0)), f1 = (float)(r1 - __builtin_rint(r1));
                const float cs0 = __builtin_amdgcn_cosf(f0), sn0 = __builtin_amdgcn_sinf(f0), cs1 = __builtin_amdgcn_cosf(f1), sn1 = __builtin_amdgcn_sinf(f1);
#pragma unroll
                for (int bj = 0; bj < 2; ++bj) { const int h = 2 * u.pn + bj; const f32x4 p4 = *(const LAS f32x4*)(P + (rl * 2 + bj) * 4);
                    const float r = __builtin_amdgcn_rsqf(((p4[0] + p4[1]) + (p4[2] + p4[3]) + kssv) * (1.0f / 192.0f) + EPS);
                    bf16_t* dst = KF + ((size_t)(b * 12 + h) * SEQ + sq) * 192;
                    const f32x4 v0 = acc[ai][bj][m][0] * r * gk0, v1 = acc[ai][bj][m][1] * r * gk1;
                    u32x4 w; w.x = cvt_pk_bf16(v0[0], v0[1]); w.y = cvt_pk_bf16(v0[2], v0[3]); w.z = cvt_pk_bf16(v1[0], v1[1]); w.w = cvt_pk_bf16(v1[2], v1[3]);
                    *(u32x4*)(dst + cl) = w;
                    const float yl0 = klo[0] * r * glo0, yl1 = klo[1] * r * glo1, yh0 = khi[0] * r * ghi0, yh1 = khi[1] * r * ghi1;
                    *(unsigned*)(dst + 128 + i0) = cvt_pk_bf16(yl0 * cs0 - yh0 * sn0, yl1 * cs1 - yh1 * sn1);
                    *(unsigned*)(dst + 160 + i0) = cvt_pk_bf16(yh0 * cs0 + yl0 * sn0, yh1 * cs1 + yl1 * sn1); } }
    }
};
constexpr int AT_KROW = 400, AT_VROW = 144, AT_KBYTES = 64 * AT_KROW, AT_STAGE = AT_KBYTES + 128 * AT_VROW;
static_assert(AT_KBYTES == 25 * 1024 && AT_STAGE == 43 * 1024 && 3 * AT_STAGE <= LDSCTL_OFF && RSTAB_OFF + 1024 <= LDS_BYTES, "attention LDS stages");
__device__ __forceinline__ void causal_wg_unit(Frame& F, int bh, int QB) {
    const int lane = lane_now(), w = F.wave, r32 = lane & 31, hi = lane >> 5, b = bh / 12, h = bh % 12;
    const bf16_t* Qp = WSP(bf16_t, WS_QF) + ((size_t)bh * SEQ + QB * 256 + w * 32) * 192;
    const char* Kg = (const char*)(WSP(bf16_t, WS_KF) + (size_t)bh * SEQ * 192);
    const char* Vg = (const char*)(WSP(bf16_t, WS_VT) + (size_t)(h * 128) * NTOK + b * SEQ);
    unsigned goff[6];
#pragma unroll
    for (int i = 0; i < 6; ++i) { const int j = w + 8 * i;
        if (j < 25) { const int q = j * 64 + lane, row = q / 25, c = q % 25; goff[i] = (unsigned)(row * 384 + (c < 24 ? c : 23) * 16); }
        else { const int q = (j - 25) * 64 + lane, d = q / 9, c = q % 9; goff[i] = (unsigned)(d * (NTOK * 2) + (c < 8 ? c : 7) * 16); } }
    bf16x8 qf[12];
    {
      const int tq = b * SEQ + QB * 256 + w * 32 + r32;
      const bf16_t* qrow = WSP(bf16_t, WS_QRAW) + (size_t)tq * 2304 + h * 192 + hi * 8; const float* g_qn = inp(F, 15);
      u32x4 raw[12];
#pragma unroll
      for (int d0 = 0; d0 < 12; ++d0) raw[d0] = *(const u32x4*)(qrow + d0 * 16);
      const float* sq2 = WSP(float, WS_SSQQ) + 2 * tq; const float rq = __builtin_amdgcn_rsqf((sq2[0] + sq2[1]) * (1.0f / 512.0f) + EPS);
      const double pos = (double)((const int*)inp(F, 2))[tq];
      float ss = 0.f;
#pragma unroll
      for (int d0 = 0; d0 < 12; ++d0) { float a[8]; unpack8(raw[d0], a);
#pragma unroll
          for (int e = 0; e < 8; ++e) ss += a[e] * a[e]; }
      ss += other_half(ss, lane);
      const float r = CMLA * rq * __builtin_amdgcn_rsqf(ss * rq * rq * (1.0f / 192.0f) + EPS);
#pragma unroll
      for (int d0 = 0; d0 < 8; ++d0) { float a[8]; unpack8(raw[d0], a); const f32x4 g0 = *(const f32x4*)(g_qn + d0 * 16 + hi * 8), g1 = *(const f32x4*)(g_qn + d0 * 16 + hi * 8 + 4);
          u32x4 wv; wv.x = cvt_pk_bf16(a[0] * r * g0[0], a[1] * r * g0[1]); wv.y = cvt_pk_bf16(a[2] * r * g0[2], a[3] * r * g0[3]); wv.z = cvt_pk_bf16(a[4] * r * g1[0], a[5] * r * g1[1]); wv.w = cvt_pk_bf16(a[6] * r * g1[2], a[7] * r * g1[3]);
          qf[d0] = __builtin_bit_cast(bf16x8, wv); }
#pragma unroll
      for (int dd = 0; dd < 2; ++dd) { float lo[8], hv[8], ol[8], oh[8]; unpack8(raw[8 + dd], lo); unpack8(raw[10 + dd], hv); const int i0 = dd * 16 + hi * 8;
#pragma unroll
          for (int e = 0; e < 8; ++e) { const double rev = pos * INVF_REV[i0 + e]; const float fr = (float)(rev - __builtin_rint(rev)); const float cs = __builtin_amdgcn_cosf(fr), sn = __builtin_amdgcn_sinf(fr);
              const float yl = lo[e] * r * g_qn[128 + i0 + e], yh = hv[e] * r * g_qn[160 + i0 + e]; ol[e] = yl * cs - yh * sn; oh[e] = yh * cs + yl * sn; }
          u32x4 wl, wh; wl.x = cvt_pk_bf16(ol[0], ol[1]); wl.y = cvt_pk_bf16(ol[2], ol[3]); wl.z = cvt_pk_bf16(ol[4], ol[5]); wl.w = cvt_pk_bf16(ol[6], ol[7]);
          wh.x = cvt_pk_bf16(oh[0], oh[1]); wh.y = cvt_pk_bf16(oh[2], oh[3]); wh.z = cvt_pk_bf16(oh[4], oh[5]); wh.w = cvt_pk_bf16(oh[6], oh[7]);
          qf[8 + dd] = __builtin_bit_cast(bf16x8, wl); qf[10 + dd] = __builtin_bit_cast(bf16x8, wh); } }
    f32x16 o[4], negm; float l = 0.f;
#pragma unroll
    for (int r = 0; r < 16; ++r) negm[r] = 0.f;
#pragma unroll
    for (int db = 0; db < 4; ++db)
#pragma unroll
        for (int r = 0; r < 16; ++r) o[db][r] = 0.f;
    const int ntiles = 4 * QB + 4;
    LAS unsigned char* lds = F.lds;
#define AT_DMA(t_, st_) do { _Pragma("unroll") for (int i_ = 0; i_ < 6; ++i_) { const int j_ = w + 8 * i_; if (j_ < 43) { \
        const char* g_ = (j_ < 25 ? Kg + (size_t)(t_) * (64 * 384) : Vg + (size_t)(t_) * 128) + goff[i_]; \
        __builtin_amdgcn_global_load_lds((const unsigned*)g_, (LAS unsigned*)(lds + (st_) * AT_STAGE + j_ * 1024), 16, 0, 0); } } } while (0)
    asm volatile("s_waitcnt lgkmcnt(0)" ::: "memory"); __builtin_amdgcn_s_barrier(); asm volatile("" ::: "memory");
    AT_DMA(0, 0); AT_DMA(1, 1);
    const int kb0 = r32 * AT_KROW + hi * 16, vb0 = AT_KBYTES + r32 * AT_VROW + hi * 16;
    const bool np6 = w < 3;
    for (int t = 0; t < ntiles; ++t) {
        if (t + 1 < ntiles) { if (np6) asm volatile("s_waitcnt vmcnt(6)" ::: "memory"); else asm volatile("s_waitcnt vmcnt(5)" ::: "memory"); }
        else asm volatile("s_waitcnt vmcnt(0)" ::: "memory");
        __builtin_amdgcn_s_barrier(); asm volatile("" ::: "memory");
        if (t + 2 < ntiles) AT_DMA(t + 2, (t + 2) % 3);
        const int tp = t - 4 * QB;
        if (tp >= 0 && 2 * tp > w) continue;
        const int so = (t % 3) * AT_STAGE;
        const bool act1 = tp < 0 || 2 * tp + 1 <= w;
        f32x16 p0 = negm, p1 = negm;
        { const LAS unsigned char* kp = lds + so + kb0; bf16x8 ka[6], kb[6];
#define AT_KLD(dst, st, base) do { _Pragma("unroll") for (int i_ = 0; i_ < 6; ++i_) dst[i_] = *(const LAS bf16x8*)(kp + (st) * 32 * AT_KROW + ((base) + i_) * 32); } while (0)
          AT_KLD(ka, 0, 0); AT_KLD(kb, 0, 6); __builtin_amdgcn_sched_barrier(0); __builtin_amdgcn_s_setprio(1);
#pragma unroll
          for (int i = 0; i < 6; ++i) p0 = __builtin_amdgcn_mfma_f32_32x32x16_bf16(ka[i], qf[i], p0, 0, 0, 0);
          __builtin_amdgcn_sched_barrier(0); AT_KLD(ka, 1, 0); __builtin_amdgcn_sched_barrier(0);
#pragma unroll
          for (int i = 0; i < 6; ++i) p0 = __builtin_amdgcn_mfma_f32_32x32x16_bf16(kb[i], qf[6 + i], p0, 0, 0, 0);
          __builtin_amdgcn_sched_barrier(0); AT_KLD(kb, 1, 6); __builtin_amdgcn_sched_barrier(0);
#pragma unroll
          for (int i = 0; i < 6; ++i) p1 = __builtin_amdgcn_mfma_f32_32x32x16_bf16(ka[i], qf[i], p1, 0, 0, 0);
          __builtin_amdgcn_sched_barrier(0);
#pragma unroll
          for (int i = 0; i < 6; ++i) p1 = __builtin_amdgcn_mfma_f32_32x32x16_bf16(kb[i], qf[6 + i], p1, 0, 0, 0);
          __builtin_amdgcn_s_setprio(0);
#undef AT_KLD
        }
        bf16x8 vf[2][4], vg[2][4];
        const LAS unsigned char* vp = lds + so + vb0;
#pragma unroll
        for (int ks = 0; ks < 2; ++ks)
#pragma unroll
            for (int db = 0; db < 4; ++db) vf[ks][db] = *(const LAS bf16x8*)(vp + db * 32 * AT_VROW + ks * 32);
        __builtin_amdgcn_sched_barrier(0);
        if (tp >= 0) {
            if (2 * tp == w) {
#pragma unroll
                for (int r = 0; r < 16; ++r) if (crow(r, hi) > r32) p0[r] = -__builtin_inff(); }
            if (!act1) {
#pragma unroll
                for (int r = 0; r < 16; ++r) p1[r] = -__builtin_inff(); }
            else if (2 * tp + 1 == w) {
#pragma unroll
                for (int r = 0; r < 16; ++r) if (crow(r, hi) > r32) p1[r] = -__builtin_inff(); }
        }
        float pm = max3f(p0[0], p1[0], p0[1]);
        pm = max3f(pm, p1[1], p0[2]);
#pragma unroll
        for (int r = 2; r < 15; ++r) pm = max3f(pm, p1[r], p0[r + 1]);
        pm = max3f(pm, p1[15], pm);
        pm = half_max(pm);
        if (!__all(pm <= 8.0f)) {
            const float d = fmaxf(pm, 0.f), alpha = __builtin_amdgcn_exp2f(-d);
#pragma unroll
            for (int r = 0; r < 16; ++r) { p0[r] -= d; p1[r] -= d; negm[r] -= d; }
            l *= alpha;
#pragma unroll
            for (int db = 0; db < 4; ++db)
#pragma unroll
                for (int r = 0; r < 16; ++r) o[db][r] *= alpha;
        }
#pragma unroll
        for (int r = 0; r < 16; ++r) { p0[r] = __builtin_amdgcn_exp2f(p0[r]); p1[r] = __builtin_amdgcn_exp2f(p1[r]); }
        { typedef float f32x2 __attribute__((ext_vector_type(2))); f32x2 s2 = {0.f, 0.f};
#pragma unroll
          for (int r = 0; r < 16; r += 2) { s2 += (f32x2){p0[r], p0[r + 1]}; s2 += (f32x2){p1[r], p1[r + 1]}; }
          l += half_sum(s2[0] + s2[1]); }
        bf16x8 pa[4];
#define AT_PK(P, B_, OUT) do { const unsigned a0_ = cvt_pk_bf16(P[B_ + 0], P[B_ + 1]), a1_ = cvt_pk_bf16(P[B_ + 2], P[B_ + 3]), b0_ = cvt_pk_bf16(P[B_ + 4], P[B_ + 5]), b1_ = cvt_pk_bf16(P[B_ + 6], P[B_ + 7]); \
        auto r0_ = __builtin_amdgcn_permlane32_swap(a0_, b0_, false, false); auto r1_ = __builtin_amdgcn_permlane32_swap(a1_, b1_, false, false); \
        u32x4 w_ = {r0_[0], r1_[0], r0_[1], r1_[1]}; OUT = __builtin_bit_cast(bf16x8, w_); } while (0)
        AT_PK(p0, 0, pa[0]); AT_PK(p0, 8, pa[1]); AT_PK(p1, 0, pa[2]); AT_PK(p1, 8, pa[3]);
        __builtin_amdgcn_sched_barrier(0);
#pragma unroll
        for (int ks = 0; ks < 2; ++ks)
#pragma unroll
            for (int db = 0; db < 4; ++db) vg[ks][db] = *(const LAS bf16x8*)(vp + db * 32 * AT_VROW + (2 + ks) * 32);
        __builtin_amdgcn_sched_barrier(0); __builtin_amdgcn_s_setprio(1);
#pragma unroll
        for (int ks = 0; ks < 2; ++ks)
#pragma unroll
            for (int db = 0; db < 4; ++db) o[db] = __builtin_amdgcn_mfma_f32_32x32x16_bf16(vf[ks][db], pa[ks], o[db], 0, 0, 0);
        __builtin_amdgcn_sched_barrier(0);
#pragma unroll
        for (int ks = 0; ks < 2; ++ks)
#pragma unroll
            for (int db = 0; db < 4; ++db) o[db] = __builtin_amdgcn_mfma_f32_32x32x16_bf16(vg[ks][db], pa[2 + ks], o[db], 0, 0, 0);
        __builtin_amdgcn_s_setprio(0);
    }
#undef AT_PK
#undef AT_DMA
    const float inv = 16.0f / l;
    unsigned char* orow = F.ws + WS_CAT + (size_t)(b * SEQ + QB * 256 + w * 32 + r32) * DM + h * 128 + 4 * hi;
#pragma unroll
    for (int db = 0; db < 4; ++db)
#pragma unroll
        for (int g = 0; g < 4; ++g) *(unsigned*)(orow + db * 32 + 8 * g) = pk4_fp8(o[db][4 * g] * inv, o[db][4 * g + 1] * inv, o[db][4 * g + 2] * inv, o[db][4 * g + 3] * inv);
}
__device__ __forceinline__ void p11_attention(Frame& F) {
    const int xcd = F.vcu >> 5, j = F.vcu & 31;
    causal_wg_unit(F, 3 * xcd + j % 3, 15 - j / 3);
    if (j >= 16) { const int v = 63 - j; causal_wg_unit(F, 3 * xcd + v % 3, 15 - v / 3);
        mem_attn_unit(F, 1, ((xcd * 16 + (j - 16)) * 8 + F.wave)); }
    asm volatile("s_waitcnt vmcnt(0) lgkmcnt(0)" ::: "memory"); __builtin_amdgcn_s_barrier(); asm volatile("" ::: "memory");
}

__device__ __forceinline__ void p11_router(Frame& F) {
    const int lane = lane_now(), wg = blockIdx.x, tid = F.wave * 64 + lane;
    const bf16_t* X3 = WSP(bf16_t, WS_XB); const float* WR = WSP(float, WS_WR);
    int* tok_e = (int*)(F.ws + WS_META + MT_TOKE); float* tok_w = (float*)(F.ws + WS_META + MT_TOKW); float* tok_r = (float*)(F.ws + WS_META + MT_TOKR); int* cnt = (int*)(F.ws + WS_META + MT_CNT);
    LAS int* le = (LAS int*)F.lds;
    f32x4 v[4][8]; float r[4], l1[4], l2[4]; int i1[4], i2[4];
#pragma unroll
    for (int j = 0; j < 4; ++j) { const int t = wg * 32 + F.wave * 4 + j; const u32x2* xr = (const u32x2*)(X3 + (size_t)t * DM) + lane; float s = 0.f;
#pragma unroll
        for (int q = 0; q < 8; ++q) { const u32x2 w = xr[64 * q]; v[j][q] = (f32x4){bf_lo(w.x), bf_hi(w.x), bf_lo(w.y), bf_hi(w.y)}; s += (v[j][q][0] * v[j][q][0] + v[j][q][1] * v[j][q][1]) + (v[j][q][2] * v[j][q][2] + v[j][q][3] * v[j][q][3]); }
        r[j] = s; l1[j] = -__builtin_inff(); l2[j] = -__builtin_inff(); i1[j] = -1; i2[j] = -1; }
#pragma unroll
    for (int j = 0; j < 4; ++j) r[j] = wave_sum(r[j]);
#pragma unroll
    for (int j = 0; j < 4; ++j) r[j] = 1.0f * __builtin_amdgcn_rsqf(r[j] * (1.0f / 2048.0f) + EPS);
    f32x4 wn[8];
#pragma unroll
    for (int q = 0; q < 8; ++q) wn[q] = ((const f32x4*)WR + lane)[64 * q];
#pragma unroll 1
    for (int e = 0; e < 8; ++e) { f32x4 w[8]; float d[4];
#pragma unroll
        for (int q = 0; q < 8; ++q) w[q] = wn[q];
        { const f32x4* wr = (const f32x4*)(WR + (e < 7 ? e + 1 : 7) * DM) + lane;
#pragma unroll
          for (int q = 0; q < 8; ++q) wn[q] = wr[64 * q]; }
#pragma unroll
        for (int j = 0; j < 4; ++j) { d[j] = 0.f;
#pragma unroll
            for (int q = 0; q < 8; ++q) d[j] += (v[j][q][0] * w[q][0] + v[j][q][1] * w[q][1]) + (v[j][q][2] * w[q][2] + v[j][q][3] * w[q][3]); }
#pragma unroll
        for (int j = 0; j < 4; ++j) d[j] = wave_sum(d[j]);
#pragma unroll
        for (int j = 0; j < 4; ++j) { const float x = d[j] * r[j];
            if (x > l1[j]) { l2[j] = l1[j]; i2[j] = i1[j]; l1[j] = x; i1[j] = e; } else if (x > l2[j]) { l2[j] = x; i2[j] = e; } } }
#pragma unroll
    for (int j = 0; j < 4; ++j) { const int tl = F.wave * 4 + j, t = wg * 32 + tl;
        const float w1 = 1.0f / (1.0f + __expf(l2[j] - l1[j])), w2 = 1.0f - w1;
        if (lane == 0) { tok_e[2 * t] = i1[j]; tok_e[2 * t + 1] = i2[j]; tok_w[2 * t] = w1; tok_w[2 * t + 1] = w2; tok_r[t] = r[j]; le[2 * tl] = i1[j]; le[2 * tl + 1] = i2[j]; } }
    LDS_WAIT(); __syncthreads();
    if (tid < 8) { int c = 0; for (int i = 0; i < 64; ++i) c += (le[i] == tid) ? 1 : 0; cnt[wg * 8 + tid] = c; }
    __syncthreads();
}
__device__ __forceinline__ void p12_scatter(Frame& F) {
    const int lane = lane_now(), wg = blockIdx.x, tid = F.wave * 64 + lane;
    const int* tok_e = (const int*)(F.ws + WS_META + MT_TOKE); const float* tok_w = (const float*)(F.ws + WS_META + MT_TOKW); const float* tok_r = (const float*)(F.ws + WS_META + MT_TOKR); const int* cnt = (const int*)(F.ws + WS_META + MT_CNT);
    int* tok_pos = (int*)(F.ws + WS_META + MT_TOKPOS); int* mte = (int*)(F.ws + WS_META + MT_MTE); int* nmt = (int*)(F.ws + WS_META + MT_NMT);
    LAS int* L = (LAS int*)F.lds;
    if (tid < 16) L[tid] = 0;
    LDS_WAIT(); __syncthreads();
    { const int e = tid & 7, wq = tid >> 3; int c[4], tot = 0, mine = 0;
#pragma unroll
      for (int k = 0; k < 4; ++k) c[k] = cnt[(wq * 4 + k) * 8 + e];
#pragma unroll
      for (int k = 0; k < 4; ++k) { tot += c[k]; mine += (wq * 4 + k < wg) ? c[k] : 0; }
      __hip_atomic_fetch_add(L + e, tot, __ATOMIC_RELAXED, __HIP_MEMORY_SCOPE_WORKGROUP); __hip_atomic_fetch_add(L + 8 + e, mine, __ATOMIC_RELAXED, __HIP_MEMORY_SCOPE_WORKGROUP); }
    LDS_WAIT(); __syncthreads();
    if (tid == 0) { int seg = 0; for (int e = 0; e < 8; ++e) { L[16 + e] = seg + L[8 + e]; const int nt = (L[e] + 255) >> 8; if (wg == 0) for (int q = 0; q < nt; ++q) mte[(seg >> 8) + q] = e; seg += nt << 8; } if (wg == 0) nmt[0] = seg >> 8; }
    LDS_WAIT(); __syncthreads();
    if (F.wave == 0) { const int e = tok_e[wg * 64 + lane]; int pos = 0;
#pragma unroll
        for (int k = 0; k < 8; ++k) { const unsigned long long m = __ballot(e == k); if (e == k) pos = L[16 + k] + __popcll(m & ((1ull << lane) - 1ull)); }
        L[32 + lane] = pos; }
    LDS_WAIT(); __syncthreads();
    unsigned char* HS = F.ws + WS_HS;
    for (int i0 = F.wave; i0 < 64; i0 += 32) {
        u32x2 w[4][8]; float rr[4]; int pos[4];
#pragma unroll
        for (int k = 0; k < 4; ++k) { const int i = i0 + 8 * k, t = wg * 32 + (i >> 1); pos[k] = L[32 + i]; rr[k] = tok_r[t];
            const u32x2* src = (const u32x2*)(WSP(bf16_t, WS_XB) + (size_t)t * DM) + lane;
#pragma unroll
            for (int q = 0; q < 8; ++q) w[k][q] = src[64 * q]; }
#pragma unroll
        for (int k = 0; k < 4; ++k) { unsigned* dst = (unsigned*)(HS + (size_t)pos[k] * DM) + lane; const float r = rr[k] * QH;
#pragma unroll
            for (int q = 0; q < 8; ++q) dst[64 * q] = pk4_i8s(bf_lo(w[k][q].x), bf_hi(w[k][q].x), bf_lo(w[k][q].y), bf_hi(w[k][q].y), r);
            if (lane == 0) tok_pos[wg * 64 + i0 + 8 * k] = pos[k]; } }
    __syncthreads();
}
__device__ __forceinline__ void p15_combine(Frame& F) {
    const int gw = F.vcu * 8 + F.wave, NGW = F.G * 8, lane = lane_now();
    const int* tok_pos = (const int*)(F.ws + WS_META + MT_TOKPOS); const float* tok_w = (const float*)(F.ws + WS_META + MT_TOKW);
    const bf16_t* Y = WSP(bf16_t, WS_Y); const bf16_t* YP = WSP(bf16_t, WS_YP);
    for (int t = gw; t < NTOK; t += NGW) {
        f32x4* o = (f32x4*)(F.out + (size_t)t * DM) + lane; const u32x2* xs = (const u32x2*)(WSP(bf16_t, WS_XB) + (size_t)t * DM) + lane; f32x4 acc[8];
        const int p0 = tok_pos[2 * t], p1 = tok_pos[2 * t + 1]; const float g0 = tok_w[2 * t], g1 = tok_w[2 * t + 1];
        if (p0 < 16384 && p1 < 16384) {
            const u32x2* y0 = (const u32x2*)(Y + (size_t)p0 * DM) + lane; const u32x2* y1 = (const u32x2*)(Y + (size_t)p1 * DM) + lane; u32x2 wx[8], wa[8], wb[8];
#pragma unroll
            for (int q = 0; q < 8; ++q) { wx[q] = __builtin_nontemporal_load(xs + 64 * q); wa[q] = __builtin_nontemporal_load(y0 + 64 * q); wb[q] = __builtin_nontemporal_load(y1 + 64 * q); }
#pragma unroll
            for (int q = 0; q < 8; ++q) __builtin_nontemporal_store((f32x4){bf_lo(wx[q].x), bf_hi(wx[q].x), bf_lo(wx[q].y), bf_hi(wx[q].y)} + (f32x4){bf_lo(wa[q].x), bf_hi(wa[q].x), bf_lo(wa[q].y), bf_hi(wa[q].y)} * g0
                                                   + (f32x4){bf_lo(wb[q].x), bf_hi(wb[q].x), bf_lo(wb[q].y), bf_hi(wb[q].y)} * g1, o + 64 * q);
            continue; }
#pragma unroll
        for (int q = 0; q < 8; ++q) { const u32x2 w = xs[64 * q]; acc[q] = (f32x4){bf_lo(w.x), bf_hi(w.x), bf_lo(w.y), bf_hi(w.y)}; }
        for (int s = 0; s < 2; ++s) { const int p = s ? p1 : p0; const float gwt = s ? g1 : g0;
            if (p < 16384) { const u32x2* y = (const u32x2*)(Y + (size_t)p * DM) + lane;
#pragma unroll
                for (int q = 0; q < 8; ++q) { const u32x2 w = y[64 * q]; acc[q] = acc[q] + (f32x4){bf_lo(w.x), bf_hi(w.x), bf_lo(w.y), bf_hi(w.y)} * gwt; } }
            else { f32x4 ys[8];
#pragma unroll
                for (int q = 0; q < 8; ++q) ys[q] = (f32x4){0.f, 0.f, 0.f, 0.f};
#pragma unroll
                for (int k0 = 0; k0 < 7; k0 += 4) { u32x2 wv[4][8];
#pragma unroll
                    for (int kk = 0; kk < 4; ++kk) if (k0 + kk < 7) { const u32x2* y = (const u32x2*)(YP + ((size_t)(k0 + kk) * 2048 + (p - 16384)) * DM) + lane;
#pragma unroll
                        for (int q = 0; q < 8; ++q) wv[kk][q] = y[64 * q]; }
#pragma unroll
                    for (int kk = 0; kk < 4; ++kk) if (k0 + kk < 7) {
#pragma unroll
                        for (int q = 0; q < 8; ++q) { const u32x2 w = wv[kk][q]; ys[q] = ys[q] + (f32x4){bf_lo(w.x), bf_hi(w.x), bf_lo(w.y), bf_hi(w.y)}; } } }
#pragma unroll
                for (int q = 0; q < 8; ++q) acc[q] = acc[q] + ys[q] * gwt; } }
#pragma unroll
        for (int q = 0; q < 8; ++q) __builtin_nontemporal_store(acc[q], o + 64 * q); }
}

constexpr int NPHASE = 17;
struct Args { const void* in[28]; float* out; unsigned char* ws; int ph_lo, ph_hi; };
__global__ void __launch_bounds__(512, 2) yoco_fwd(Args args) {
    extern __shared__ __attribute__((aligned(16))) unsigned char lds_raw[];
    Frame F;
    F.lds = (LAS unsigned char*)lds_raw;
    F.wave = __builtin_amdgcn_readfirstlane(threadIdx.x >> 6);
    F.G = gridDim.x; { const int bx = blockIdx.x; F.vcu = (F.G % 8 == 0) ? (bx % 8) * (F.G / 8) + bx / 8 : bx; }
    F.kp = (kptr_t)__builtin_amdgcn_kernarg_segment_ptr();
    F.out = args.out; F.ws = args.ws;
    for (int u = F.wave * 64 + lane_now(); u < (LDS_BYTES - LDSCTL_OFF) / 4; u += 512) ((LAS unsigned*)(F.lds + LDSCTL_OFF))[u] = 0u;
    __syncthreads();
    unsigned* ctl = (unsigned*)(F.ws + WS_CTL);
    XcdBarrier bar; bar.bar = ctl + CW_BAR; bar.x = 0; bar.st = nullptr; bar.wave = F.wave;
    if (!MK_SPLIT) bar = xcd_barrier_post(ctl + CW_BAR, (volatile LAS unsigned*)(F.lds + MISC_OFF) + 8, F.wave);
    const int lo = args.ph_lo, hi = args.ph_hi;
#define IN(k) (lo <= (k) && (k) < hi)
#define SEAM(k) do { if (!MK_SPLIT && IN((k) + 1)) xcd_barrier(bar); } while (0)
    LAS unsigned char* ring = F.lds;
    const int bx = blockIdx.x, G = F.G;
    using pg8::Gemm; using pg8::StaticOrder; using pg8::MoeOrder;

#define PHASE(k, ...) do { if (IN(k)) { { __VA_ARGS__ } if constexpr (((REPMASK) >> (k)) & 1) { if (!MK_SPLIT) xcd_barrier(bar); { __VA_ARGS__ } } SEAM(k); } } while (0)
    PHASE(0, p0_prologue(F););
    PHASE(1,
        { Gemm g{WSP(bf16_t, WS_XB), WSP(bf16_t, WS_W_IN0), DM, DM}; StaticOrder S; S.init(32, 20, G, bx);
          LAS float* rl = (LAS float*)(F.lds + RSTAB_OFF);
          { pg8::Unit u0; if (S.next(0, u0)) { const int t = F.wave * 64 + lane_now(); if (t < 256) rl[t] = WSP(float, WS_RS0)[u0.pm * 256 + t]; } }
          LDS_WAIT(); __syncthreads();
          pg8::EpiBf16Plain E{WSP(bf16_t, WS_U0), NIN0, rl};
          pg8::gemm_phase<pg8::EpiBf16Plain, StaticOrder, true, true>(ring, F.wave, g, S, E); }
        { Gemm g{WSP(bf16_t, WS_MEMN), WSP(bf16_t, WS_W_MK), DM, DM}; StaticOrder S; S.init(2, 4, G, (bx + 128) % G); EpiMemKFinal E{WSP(bf16_t, WS_MEMKF), inp(F, 8), (LAS float*)(F.lds + RSTAB_OFF + 1024)};
          pg8::gemm_phase<EpiMemKFinal, StaticOrder, true, true>(ring, F.wave, g, S, E); }
        { Gemm g{WSP(bf16_t, WS_W_MV), WSP(bf16_t, WS_MEMN), DM, DM}; StaticOrder S; S.init(4, 2, G, (bx + 120) % G); pg8::EpiBf16Plain E{WSP(bf16_t, WS_MEMVT), 512, nullptr};
          pg8::gemm_phase<pg8::EpiBf16Plain, StaticOrder, true, true>(ring, F.wave, g, S, E); });
    PHASE(2, p2_conv(F); mem_attn_unit(F, 0, (F.wave & 3) * 256 + F.vcu););
    PHASE(4,
        Gemm g{WSP(bf16_t, WS_CAT), WSP(bf16_t, WS_W_OUT0), DM, DM}; StaticOrder S; S.init(32, 8, G, bx);
        pg8::EpiStream E{WSP(bf16_t, WS_XB), WSP(float, WS_SSQ), F.ws + WS_XB8, QX1, 1.0f};
        pg8::gemm_phase<pg8::EpiStream, StaticOrder, false, true>(ring, F.wave, g, S, E););
    PHASE(5,
        Gemm g{WSP(bf16_t, WS_XB8), WSP(bf16_t, WS_W_GU0), DM / 2, DM / 2}; StaticOrder S; S.init(32, 56, G, bx);
        LAS float* rl = (LAS float*)(F.lds + RSTAB_OFF);
        { pg8::Unit u0; if (S.next(0, u0)) { const int t = F.wave * 64 + lane_now(); if (t < 256) { const float* q = WSP(float, WS_SSQ) + (size_t)(u0.pm * 256 + t) * 8; const f32x4 a = *(const f32x4*)q, b = *(const f32x4*)(q + 4);
              rl[t] = (1.0f / (QX1 * QWGU)) * __builtin_amdgcn_rsqf(((a[0] + a[1]) + (a[2] + a[3]) + (b[0] + b[1]) + (b[2] + b[3])) * (1.0f / 2048.0f) + EPS); } } }
        LDS_WAIT(); __syncthreads();
        pg8::EpiSwiGLU8<3> E{F.ws + WS_HID, DFF, nullptr, rl, 1.0f, QHID};
        pg8::gemm_phase<pg8::EpiSwiGLU8<3>, StaticOrder, true, true, false, true>(ring, F.wave, g, S, E););
    PHASE(6,
        Gemm g{WSP(bf16_t, WS_HID), WSP(bf16_t, WS_W_D0), DFF / 2, DFF / 2}; StaticOrder S; S.init(32, 8, G, bx);
        pg8::EpiStream E{WSP(bf16_t, WS_XB), WSP(float, WS_SSQ) + NTOK * 8, F.ws + WS_XB8, 0.f, 1.0f / (QHID * QWD)};
        pg8::gemm_phase<pg8::EpiStream, StaticOrder, false, true, false, true>(ring, F.wave, g, S, E););
    PHASE(7,
        Gemm g{WSP(bf16_t, WS_XB8), WSP(bf16_t, WS_W_1), DM / 2, DM / 2}; StaticOrder S; S.init(32, 6, G, bx);
        pg8::EpiL1In E{WSP(float, WS_SSQ) + NTOK * 8, WSP(bf16_t, WS_CKV), WSP(float, WS_KPE), WSP(float, WS_KSS), WSP(bf16_t, WS_CQ), WSP(float, WS_SSQQ), WSP(bf16_t, WS_QM), inp(F, 7) + 128, CMEM};
        pg8::gemm_phase<pg8::EpiL1In, StaticOrder, false, true, true>(ring, F.wave, g, S, E, 0x7f7f7f79););
    PHASE(8,
        { Gemm g{WSP(bf16_t, WS_CKV), WSP(bf16_t, WS_W_KN), 256, 256}; StaticOrder S; S.init(32, 6, G, bx); EpiKnFinal E{WSP(bf16_t, WS_KF), WSP(float, WS_KPE), WSP(float, WS_KSS), (const int*)inp(F, 2), inp(F, 20), (LAS float*)(F.lds + RSTAB_OFF + 1024)};
          pg8::gemm_phase<EpiKnFinal, StaticOrder, true, true>(ring, F.wave, g, S, E); }
        { Gemm g{WSP(bf16_t, WS_W_V), WSP(bf16_t, WS_CKV), 256, 256}; StaticOrder S; S.init(6, 32, G, (bx + 64) % G); pg8::EpiBf16Plain E{WSP(bf16_t, WS_VT), NTOK, nullptr};
          pg8::gemm_phase<pg8::EpiBf16Plain, StaticOrder, true, true>(ring, F.wave, g, S, E); }
        { Gemm g{WSP(bf16_t, WS_CQ), WSP(bf16_t, WS_W_QB), 512, 512}; StaticOrder S; S.init(32, 9, G, (bx + 128) % G); pg8::EpiBf16Plain E{WSP(bf16_t, WS_QRAW), 2304, nullptr};
          pg8::gemm_phase<pg8::EpiBf16Plain, StaticOrder, true, true>(ring, F.wave, g, S, E); });
    PHASE(10,
        p11_attention(F););
    PHASE(11,
        Gemm g{WSP(bf16_t, WS_CAT), WSP(bf16_t, WS_W_OUT1), DM / 2, DM / 2}; StaticOrder S; S.init(32, 8, G, bx);
        pg8::EpiStream E{WSP(bf16_t, WS_XB), WSP(float, WS_SSQ) + 2 * NTOK * 8, nullptr, 0.f, 1.0f};
        pg8::gemm_phase<pg8::EpiStream, StaticOrder, false, true, true>(ring, F.wave, g, S, E, 0x7f7f7b79););
    PHASE(12, p11_router(F););
    PHASE(13, p12_scatter(F););
    PHASE(14,
        const int* mte = (const int*)(F.ws + WS_META + MT_MTE); const int nmt = *(const int*)(F.ws + WS_META + MT_NMT);
        Gemm g{WSP(bf16_t, WS_HS), WSP(bf16_t, WS_W_MGU), DM / 2, DM / 2}; MoeOrder S; S.init(nmt, 56, G, bx); S.mte = mte; S.ntpe = 56;
        pg8::EpiSwiGLU8<2> E{F.ws + WS_HID2, DFF, nullptr, nullptr, 1.0f / (QH * QWGU), QHID};
        pg8::gemm_phase<pg8::EpiSwiGLU8<2>, MoeOrder, true, true, false, true>(ring, F.wave, g, S, E););
    PHASE(15,
        const int* mte = (const int*)(F.ws + WS_META + MT_MTE); const int nmt = *(const int*)(F.ws + WS_META + MT_NMT);
        { Gemm g{WSP(bf16_t, WS_HID2), WSP(bf16_t, WS_W_MD), DFF / 2, DFF / 2}; MoeOrder S; S.init(64, 8, G, bx); S.mte = mte; S.ntpe = 8;
          pg8::EpiMoeDown E{WSP(bf16_t, WS_Y), 1.0f / (QHID * QWD)};
          pg8::gemm_phase<pg8::EpiMoeDown, MoeOrder, true, true, false, true>(ring, F.wave, g, S, E); }
        { Gemm g{WSP(bf16_t, WS_HID2), WSP(bf16_t, WS_W_MD), 512, DFF / 2}; pg8::MoeTailOrder S{nmt - 64, G, bx, mte};
          pg8::EpiMoeDownPart E{WSP(bf16_t, WS_YP), 1.0f / (QHID * QWD)};
          pg8::gemm_phase<pg8::EpiMoeDownPart, pg8::MoeTailOrder, true, true, false, true>(ring, F.wave, g, S, E); });
    if (IN(16)) { p15_combine(F); }
#undef PHASE
#undef IN
#undef SEAM
}

extern "C" void kernel_launch(void* const* d_in, const int* in_sizes, int n_in, void* d_out, int out_size, void* d_ws, size_t ws_size, hipStream_t stream) {
    static int ready = 0;
    if (ready == 0) {
        ready = -1;
        if (n_in != 28 || in_sizes[0] != NTOK * DM || out_size != NTOK * DM || ws_size < WS_END) { fprintf(stderr, "kernel_launch: unexpected shapes (n_in %d, out %d, ws %zu < %zu)\n", n_in, out_size, ws_size, (size_t)WS_END); return; }
        if (hipFuncSetAttribute((const void*)yoco_fwd, hipFuncAttributeMaxDynamicSharedMemorySize, LDS_BYTES) != hipSuccess) { fprintf(stderr, "kernel_launch: hipFuncSetAttribute failed\n"); return; }
        int per_cu = 0; if (hipOccupancyMaxActiveBlocksPerMultiprocessor(&per_cu, (const void*)yoco_fwd, 512, LDS_BYTES) != hipSuccess || per_cu < 1) fprintf(stderr, "kernel_launch: occupancy query reports %d\n", per_cu);
        (void)hipGetLastError();
        ready = 1;
    }
    if (ready < 0) return;
    (void)hipMemsetAsync((char*)d_ws + WS_CTL, 0, CTL_ZERO_BYTES, stream);
    Args a{};
    for (int i = 0; i < 28; ++i) a.in[i] = d_in[i];
    a.out = (float*)d_out; a.ws = (unsigned char*)d_ws;
#if MK_SPLIT
    for (int p = 0; p < NPHASE; ++p) { a.ph_lo = p; a.ph_hi = p + 1; hipLaunchKernelGGL(yoco_fwd, dim3(256), dim3(512), LDS_BYTES, stream, a); }
#else
    a.ph_lo = 0; a.ph_hi = NPHASE;
    hipLaunchKernelGGL(yoco_fwd, dim3(256), dim3(512), LDS_BYTES, stream, a);
#endif
    const hipError_t le = hipPeekAtLastError();
    if (le != hipSuccess) fprintf(stderr, "kernel_launch: launch failed: %s\n", hipGetErrorName(le));
}
```

```cpp
#include <hip/hip_runtime.h>
#include <cstdio>
#include <cstdint>

#ifndef REPMASK
#define REPMASK 0
#endif
#ifndef MK_SPLIT
#define MK_SPLIT 0
#endif

#define GAS __attribute__((address_space(1)))
#define LAS __attribute__((address_space(3)))
typedef unsigned short bf16_t;
typedef short bf16x8 __attribute__((ext_vector_type(8)));
typedef float f32x4 __attribute__((ext_vector_type(4)));
typedef float f32x16 __attribute__((ext_vector_type(16)));
typedef unsigned u32x4 __attribute__((ext_vector_type(4)));
typedef unsigned u32x2 __attribute__((ext_vector_type(2)));
typedef int v4i_t __attribute__((ext_vector_type(4)));
typedef int v8i_t __attribute__((ext_vector_type(8)));

constexpr int NTOK = 8192, DM = 2048, SEQ = 4096;
constexpr int DFF = 7168, NEXP = 8;
constexpr int NIN0 = 5120;
constexpr int N1 = 1536;
constexpr int MAXPAIR = 18432;
constexpr float EPS = 1e-6f;
constexpr float LOG2E = 1.4426950408889634f;
constexpr float QX1 = 127.0f / 6.5f;
constexpr float QWGU = 127.0f / 0.12f;
constexpr float QHID = 127.0f / 8.0f;
constexpr float QWD = 127.0f / 0.064f;
constexpr float QH = 127.0f / 5.5f;

constexpr size_t MiB = 1u << 20;
constexpr size_t WS_CTL = 0, CTL_ZERO_BYTES = 64 * 1024;
constexpr size_t WS_META = 1 * MiB;
constexpr size_t WS_SSQ = 2 * MiB;
constexpr size_t WS_WR = 3 * MiB;
constexpr size_t WS_MEMN = 4 * MiB;
constexpr size_t WS_MEMKR = 6 * MiB;
constexpr size_t WS_MEMKF = 7 * MiB;
constexpr size_t WS_MEMVT = 8 * MiB;
constexpr size_t WS_QM = 10 * MiB;
constexpr size_t WS_W_IN0 = 20 * MiB, WS_W_OUT0 = 40 * MiB, WS_W_OUT1 = 48 * MiB, WS_W_GU0 = 56 * MiB, WS_W_D0 = 112 * MiB, WS_W_1 = 140 * MiB;
constexpr size_t WS_W_KN = 146 * MiB, WS_W_V = 147 * MiB, WS_W_QB = 148 * MiB, WS_W_MK = 151 * MiB, WS_W_MV = 155 * MiB;
constexpr size_t WS_W_MGU = 160 * MiB, WS_W_MD = 608 * MiB;
constexpr size_t WS_XB = 832 * MiB, WS_CAT = 864 * MiB, WS_H0 = 896 * MiB, WS_HS = 960 * MiB;
constexpr size_t WS_U0 = 1032 * MiB, WS_HID = 1112 * MiB, WS_U1F = 1224 * MiB, WS_CKV = 1272 * MiB, WS_CQ = 1276 * MiB;
constexpr size_t WS_HID2 = 1032 * MiB;
constexpr size_t WS_KNRAW = 1284 * MiB, WS_VT = 1308 * MiB, WS_QRAW = 1332 * MiB, WS_KF = 1368 * MiB, WS_QF = 1404 * MiB;
constexpr size_t WS_Y = 1284 * MiB;
constexpr size_t WS_KPE = WS_U1F;
constexpr size_t WS_KSS = WS_SSQ + 768 * 1024, WS_SSQQ = WS_SSQ + 832 * 1024, WS_RS0 = WS_SSQ + 896 * 1024;
constexpr size_t WS_XB8 = 928 * MiB;
constexpr size_t WS_YP = 384 * MiB;
constexpr size_t WS_END = 1440 * MiB;
constexpr size_t MT_TOKE = 0, MT_TOKW = 64 * 1024, MT_TOKR = 128 * 1024, MT_CNT = 160 * 1024, MT_TOKPOS = 192 * 1024, MT_PAIRW = 256 * 1024, MT_PAIRR = 328 * 1024, MT_MTE = 512 * 1024, MT_NMT = 513 * 1024;
constexpr int CW_BAR = 4096;

constexpr int RING_BYTES = 131072;
constexpr int LDSCTL_OFF = 132096  , MISC_OFF = LDSCTL_OFF + 320, RSTAB_OFF = LDSCTL_OFF + 1024;
constexpr int LDS_BYTES = 147456;

#define LDS_WAIT() asm volatile("s_waitcnt lgkmcnt(0)" ::: "memory")
#define VM_WAIT() asm volatile("s_waitcnt vmcnt(0)" ::: "memory")
__device__ __forceinline__ unsigned cvt_pk_bf16(float lo, float hi) { unsigned r; asm volatile("v_cvt_pk_bf16_f32 %0, %1, %2" : "=v"(r) : "v"(lo), "v"(hi)); return r; }
__device__ __forceinline__ unsigned pk4_fp8(float a, float b, float c, float d) { int w = 0; w = __builtin_amdgcn_cvt_pk_fp8_f32(a, b, w, false); w = __builtin_amdgcn_cvt_pk_fp8_f32(c, d, w, true); return (unsigned)w; }
__device__ __forceinline__ unsigned pk4_i8(float a, float b, float c, float d) {
    unsigned w = 0;
    w = __builtin_amdgcn_cvt_pk_u8_f32(a + 128.0f, 0, w); w = __builtin_amdgcn_cvt_pk_u8_f32(b + 128.0f, 1, w);
    w = __builtin_amdgcn_cvt_pk_u8_f32(c + 128.0f, 2, w); w = __builtin_amdgcn_cvt_pk_u8_f32(d + 128.0f, 3, w);
    return w ^ 0x80808080u; }
__device__ __forceinline__ unsigned pk4_i8s(float a, float b, float c, float d, float q) {
    unsigned w = 0;
    w = __builtin_amdgcn_cvt_pk_u8_f32(__builtin_fmaf(a, q, 128.0f), 0, w); w = __builtin_amdgcn_cvt_pk_u8_f32(__builtin_fmaf(b, q, 128.0f), 1, w);
    w = __builtin_amdgcn_cvt_pk_u8_f32(__builtin_fmaf(c, q, 128.0f), 2, w); w = __builtin_amdgcn_cvt_pk_u8_f32(__builtin_fmaf(d, q, 128.0f), 3, w);
    return w ^ 0x80808080u; }
__device__ __forceinline__ float bf_lo(unsigned w) { return __uint_as_float(w << 16); }
__device__ __forceinline__ float bf_hi(unsigned w) { return __uint_as_float(w & 0xffff0000u); }
template <int CTRL, int ROWS = 0xf> __device__ __forceinline__ float dpp_f(float v) { return __builtin_bit_cast(float, __builtin_amdgcn_update_dpp(0, __builtin_bit_cast(int, v), CTRL, ROWS, 0xf, false)); }
__device__ __forceinline__ float row16_sum(float v) {
    v += dpp_f<0xB1>(v); v += dpp_f<0x4E>(v);
    v += dpp_f<0x141>(v); v += dpp_f<0x140>(v);
    return v; }
__device__ __forceinline__ float wave_sum(float v) {
    v = row16_sum(v);
    v += dpp_f<0x142, 0xA>(v);
    v += dpp_f<0x143, 0xC>(v);
    return __builtin_bit_cast(float, __builtin_amdgcn_readlane(__builtin_bit_cast(int, v), 63)); }
__device__ __forceinline__ int lane_now() { int l; asm volatile("v_mbcnt_lo_u32_b32 %0, -1, 0\n\tv_mbcnt_hi_u32_b32 %0, -1, %0" : "=v"(l)); return l; }
__device__ __forceinline__ float max3f(float a, float b, float c) { float r; asm("v_max3_f32 %0, %1, %2, %3" : "=v"(r) : "v"(a), "v"(b), "v"(c)); return r; }
__device__ __forceinline__ float half_max(float x) { const unsigned u = __float_as_uint(x); auto r = __builtin_amdgcn_permlane32_swap(u, u, false, false); return fmaxf(__uint_as_float(r[0]), __uint_as_float(r[1])); }
__device__ __forceinline__ float other_half(float x, int lane) { const unsigned u = __float_as_uint(x); auto r = __builtin_amdgcn_permlane32_swap(u, u, false, false); return __uint_as_float(lane < 32 ? r[1] : r[0]); }
__device__ __forceinline__ float rows4_sum(float x) { const unsigned u = __float_as_uint(x); auto r = __builtin_amdgcn_permlane16_swap(u, u, false, false); const float y = __uint_as_float(r[0]) + __uint_as_float(r[1]);
    const unsigned v = __float_as_uint(y); auto q = __builtin_amdgcn_permlane32_swap(v, v, false, false); return __uint_as_float(q[0]) + __uint_as_float(q[1]); }
__device__ __forceinline__ float half_sum(float x) { const unsigned u = __float_as_uint(x); auto r = __builtin_amdgcn_permlane32_swap(u, u, false, false); return __uint_as_float(r[0]) + __uint_as_float(r[1]); }
__device__ __forceinline__ float silu_f(float x) { return x * __builtin_amdgcn_rcpf(1.0f + __builtin_amdgcn_exp2f(-x * LOG2E)); }

namespace pg8 {
constexpr int BM = 256, BK = 64, HALF = 128, HTB = HALF * BK * 2, STAGE_BYTES = 8 * HTB, NXCD = 8, WGM = 8;
__host__ __device__ __forceinline__ int lds_byte(int r, int c) { const int st = (r >> 4) * 2 + (c >> 5), rr = r & 15, cc = c & 31, ob = rr * 64 + cc * 2; return st * 1024 + (ob ^ (((ob >> 9) & 1) << 5)); }
__host__ __device__ __forceinline__ void stage_rc(int b, int& R, int& C) { const int st = b / 1024, sb = b % 1024, swz = sb ^ (((sb >> 9) & 1) << 5); R = (st >> 1) * 16 + swz / 64; C = (st & 1) * 32 + (swz % 64) / 2; }
__host__ __device__ __forceinline__ int perm32(int rho) { const int n = rho >> 4, i = rho & 15; return 8 * (i >> 2) + 4 * n + (i & 3); }

struct Unit { int pm, pn, am, bn, koff, ks; };
struct Gemm { const bf16_t* A; const bf16_t* Bt; int K, ld; };

struct StaticOrder {
    int nM, nN, nwg, G, c;
    __device__ __forceinline__ void init(int nM_, int nN_, int G_, int c_) { nM = nM_; nN = nN_; nwg = nM * nN; G = G_; c = c_; }
    __device__ __forceinline__ bool map(int i, Unit& u) const {
        const long L = (long)i * G + c; if (L >= nwg) return false;
        int wgid = (int)L; { const int q = nwg / NXCD, r = nwg % NXCD, xcd = wgid % NXCD, off = wgid / NXCD; wgid = (xcd < r ? xcd * (q + 1) : r * (q + 1) + (xcd - r) * q) + off; }
        const int nig = WGM * nN, gid = wgid / nig, fm = gid * WGM, gsz = (nM - fm) < WGM ? (nM - fm) : WGM;
        u.pm = fm + ((wgid % nig) % gsz); u.pn = (wgid % nig) / gsz; return true;
    }
    __device__ __forceinline__ bool next(int i, Unit& u) const { if (!map(i, u)) return false; u.am = u.pm; u.bn = u.pn; u.koff = 0; u.ks = 0; return true; }
};
struct MoeOrder : StaticOrder {
    const int* mte; int ntpe;
    __device__ __forceinline__ bool next(int i, Unit& u) const { if (!map(i, u)) return false; u.am = u.pm; u.bn = mte[u.pm] * ntpe + u.pn; u.koff = 0; u.ks = 0; return true; }
};
struct MoeTailOrder {
    int nL, G, c; const int* mte;
    __device__ __forceinline__ bool next(int i, Unit& u) const {
        const int L = i * G + c; if (L >= nL * 56) return false;
        u.pn = L & 7; const int t = L >> 3; u.pm = t % nL; u.ks = t / nL; u.am = 64 + u.pm; u.bn = mte[64 + u.pm] * 8 + u.pn; u.koff = u.ks * 1024; return true; }
};

struct EpiBf16Plain {
    static constexpr bool PERM = true, AFTER_DRAIN = false;
    bf16_t* O; int ldc; const LAS float* rl;
    __device__ __forceinline__ void operator()(const f32x4 (&acc)[2][2][4][2], const Unit& u, int wr, int wc, int fr, int fq) const {
        const int row0 = u.pm * BM + wr * 64 + fr, col0 = u.pn * BM + wc * 32 + 8 * fq;
#pragma unroll
        for (int ai = 0; ai < 2; ++ai)
#pragma unroll
            for (int m = 0; m < 4; ++m) { bf16_t* rowp = O + (size_t)(row0 + ai * HALF + m * 16) * ldc + col0; const float r = rl ? rl[wr * 64 + fr + ai * HALF + m * 16] : 1.0f;
#pragma unroll
                for (int bj = 0; bj < 2; ++bj) { const f32x4 v0 = acc[ai][bj][m][0] * r, v1 = acc[ai][bj][m][1] * r;
                    u32x4 w; w.x = cvt_pk_bf16(v0[0], v0[1]); w.y = cvt_pk_bf16(v0[2], v0[3]); w.z = cvt_pk_bf16(v1[0], v1[1]); w.w = cvt_pk_bf16(v1[2], v1[3]);
                    *(u32x4*)(rowp + bj * HALF) = w; } }
    }
};
template <int MODE> struct EpiSwiGLU {
    static constexpr bool PERM = true, AFTER_DRAIN = false;
    bf16_t* H; int ldh; const float* rs;
    __device__ __forceinline__ void operator()(const f32x4 (&acc)[2][2][4][2], const Unit& u, int wr, int wc, int fr, int fq) const {
        const int row0 = u.pm * BM + wr * 64 + fr, col0 = u.pn * HALF + wc * 32 + 8 * fq;
#pragma unroll
        for (int ai = 0; ai < 2; ++ai)
#pragma unroll
            for (int m = 0; m < 4; ++m) { const int row = row0 + ai * HALF + m * 16; float r;
                if (MODE == 0) { const f32x4 a = *(const f32x4*)(rs + (size_t)row * 8), b = *(const f32x4*)(rs + (size_t)row * 8 + 4);
                    r = 1.0f * __builtin_amdgcn_rsqf(((a[0] + a[1]) + (a[2] + a[3]) + (b[0] + b[1]) + (b[2] + b[3])) * (1.0f / 2048.0f) + EPS); }
                else r = rs[row];
                const f32x4 g0 = acc[ai][0][m][0] * r, g1 = acc[ai][0][m][1] * r, u0 = acc[ai][1][m][0] * r, u1 = acc[ai][1][m][1] * r;
                u32x4 w; w.x = cvt_pk_bf16(silu_f(g0[0]) * u0[0], silu_f(g0[1]) * u0[1]); w.y = cvt_pk_bf16(silu_f(g0[2]) * u0[2], silu_f(g0[3]) * u0[3]);
                w.z = cvt_pk_bf16(silu_f(g1[0]) * u1[0], silu_f(g1[1]) * u1[1]); w.w = cvt_pk_bf16(silu_f(g1[2]) * u1[2], silu_f(g1[3]) * u1[3]);
                *(u32x4*)(H + (size_t)row * ldh + col0) = w; }
    }
};
template <int MODE> struct EpiSwiGLU8 {
    static constexpr bool PERM = true, AFTER_DRAIN = false;
    unsigned char* H; int ldh; const float* rs; const LAS float* rl; float cs, qo;
    __device__ __forceinline__ void operator()(const f32x4 (&acc)[2][2][4][2], const Unit& u, int wr, int wc, int fr, int fq) const {
        const int row0 = u.pm * BM + wr * 64 + fr, col0 = u.pn * HALF + wc * 32 + 8 * fq;
#pragma unroll
        for (int ai = 0; ai < 2; ++ai)
#pragma unroll
            for (int m = 0; m < 4; ++m) { const int row = row0 + ai * HALF + m * 16; float r;
                if (MODE == 3) r = rl[wr * 64 + fr + ai * HALF + m * 16];
                else if (MODE == 0) { const f32x4 a = *(const f32x4*)(rs + (size_t)row * 8), b = *(const f32x4*)(rs + (size_t)row * 8 + 4);
                    r = 1.0f * __builtin_amdgcn_rsqf(((a[0] + a[1]) + (a[2] + a[3]) + (b[0] + b[1]) + (b[2] + b[3])) * (1.0f / 2048.0f) + EPS); }
                else if (MODE == 1) r = rs[row]; else r = cs;
                const f32x4 ag0 = acc[ai][0][m][0], ag1 = acc[ai][0][m][1], au0 = acc[ai][1][m][0], au1 = acc[ai][1][m][1];
                const float c1 = -LOG2E * r, c2 = r * r * (qo != 0.f ? qo : 1.0f);
                f32x4 e0 = ag0 * c1, e1 = ag1 * c1;
#pragma unroll
                for (int i = 0; i < 4; ++i) { e0[i] = __builtin_amdgcn_exp2f(e0[i]); e1[i] = __builtin_amdgcn_exp2f(e1[i]); }
                f32x4 d0 = e0 + 1.0f, d1 = e1 + 1.0f;
#pragma unroll
                for (int i = 0; i < 4; ++i) { d0[i] = __builtin_amdgcn_rcpf(d0[i]); d1[i] = __builtin_amdgcn_rcpf(d1[i]); }
                const f32x4 t0 = (ag0 * au0) * d0, t1 = (ag1 * au1) * d1;
                u32x2 w;
                if (qo != 0.f) { const f32x4 y0 = __builtin_elementwise_fma(t0, (f32x4){c2, c2, c2, c2}, (f32x4){128.0f, 128.0f, 128.0f, 128.0f}), y1 = __builtin_elementwise_fma(t1, (f32x4){c2, c2, c2, c2}, (f32x4){128.0f, 128.0f, 128.0f, 128.0f}); unsigned a = 0, c = 0;
#pragma unroll
                    for (int i = 0; i < 4; ++i) { a = __builtin_amdgcn_cvt_pk_u8_f32(y0[i], i, a); c = __builtin_amdgcn_cvt_pk_u8_f32(y1[i], i, c); }
                    w.x = a ^ 0x80808080u; w.y = c ^ 0x80808080u; }
                else { const f32x4 h0 = t0 * c2, h1 = t1 * c2; w.x = pk4_fp8(h0[0], h0[1], h0[2], h0[3]); w.y = pk4_fp8(h1[0], h1[1], h1[2], h1[3]); }
                *(u32x2*)(H + (size_t)row * ldh + col0) = w; }
    }
};
struct EpiRowScaleF32 {
    static constexpr bool PERM = false, AFTER_DRAIN = false;
    float* O; int ldc; const float* ssq;
    __device__ __forceinline__ void operator()(const f32x4 (&acc)[2][2][4][2], const Unit& u, int wr, int wc, int fr, int fq) const {
        const int row0 = u.pm * BM + wr * 64 + fr, col0 = u.pn * BM + wc * 32 + 4 * fq;
#pragma unroll
        for (int ai = 0; ai < 2; ++ai)
#pragma unroll
            for (int m = 0; m < 4; ++m) { const int row = row0 + ai * HALF + m * 16;
                const f32x4 a = *(const f32x4*)(ssq + (size_t)row * 8), b = *(const f32x4*)(ssq + (size_t)row * 8 + 4);
                const float r = 1.0f * __builtin_amdgcn_rsqf(((a[0] + a[1]) + (a[2] + a[3]) + (b[0] + b[1]) + (b[2] + b[3])) * (1.0f / 2048.0f) + EPS);
                float* rowp = O + (size_t)row * ldc + col0;
#pragma unroll
                for (int bj = 0; bj < 2; ++bj)
#pragma unroll
                    for (int n = 0; n < 2; ++n) *(f32x4*)(rowp + bj * HALF + n * 16) = acc[ai][bj][m][n] * r; }
    }
};
struct EpiMoeDown {
    static constexpr bool PERM = true, AFTER_DRAIN = false;
    bf16_t* Y; float ds;
    __device__ __forceinline__ void operator()(const f32x4 (&acc)[2][2][4][2], const Unit& u, int wr, int wc, int fr, int fq) const {
        const int row0 = u.pm * BM + wr * 64 + fr, col0 = u.pn * BM + wc * 32 + 8 * fq;
#pragma unroll
        for (int ai = 0; ai < 2; ++ai)
#pragma unroll
            for (int m = 0; m < 4; ++m) { bf16_t* rowp = Y + (size_t)(row0 + ai * HALF + m * 16) * DM + col0;
#pragma unroll
                for (int bj = 0; bj < 2; ++bj) { const f32x4 v0 = acc[ai][bj][m][0] * ds, v1 = acc[ai][bj][m][1] * ds;
                    u32x4 w; w.x = cvt_pk_bf16(v0[0], v0[1]); w.y = cvt_pk_bf16(v0[2], v0[3]); w.z = cvt_pk_bf16(v1[0], v1[1]); w.w = cvt_pk_bf16(v1[2], v1[3]);
                    *(u32x4*)(rowp + bj * HALF) = w; } }
    }
};
struct EpiMoeDownPart {
    static constexpr bool PERM = true, AFTER_DRAIN = false;
    bf16_t* YP; float ds;
    __device__ __forceinline__ void operator()(const f32x4 (&acc)[2][2][4][2], const Unit& u, int wr, int wc, int fr, int fq) const {
        const int row0 = u.pm * BM + wr * 64 + fr, col0 = u.pn * BM + wc * 32 + 8 * fq;
#pragma unroll
        for (int ai = 0; ai < 2; ++ai)
#pragma unroll
            for (int m = 0; m < 4; ++m) { bf16_t* rowp = YP + ((size_t)u.ks * 2048 + row0 + ai * HALF + m * 16) * DM + col0;
#pragma unroll
                for (int bj = 0; bj < 2; ++bj) { const f32x4 v0 = acc[ai][bj][m][0] * ds, v1 = acc[ai][bj][m][1] * ds;
                    u32x4 w; w.x = cvt_pk_bf16(v0[0], v0[1]); w.y = cvt_pk_bf16(v0[2], v0[3]); w.z = cvt_pk_bf16(v1[0], v1[1]); w.w = cvt_pk_bf16(v1[2], v1[3]);
                    *(u32x4*)(rowp + bj * HALF) = w; } }
    }
};
struct EpiStream {
    static constexpr bool PERM = false, AFTER_DRAIN = true;
    bf16_t* xb; float* ssq; unsigned char* x8; float q8, ds;
    __device__ __forceinline__ void fused(f32x4 (&acc)[2][2][4][2], const Unit& u, int wr, int wc, int fr, int fq, LAS unsigned char* lds, int wid, int lane) const {
        LAS float* P = (LAS float*)lds;
        const int col0 = u.pn * BM + wc * 32 + 4 * fq;
#pragma unroll
        for (int ai = 0; ai < 2; ++ai) {
            u32x2 rv[4][2][2];
#pragma unroll
            for (int m = 0; m < 4; ++m) { const size_t off = (size_t)(u.pm * BM + ai * HALF + wr * 64 + m * 16 + fr) * DM + col0;
#pragma unroll
                for (int bj = 0; bj < 2; ++bj)
#pragma unroll
                    for (int n = 0; n < 2; ++n) rv[m][bj][n] = *(const u32x2*)(xb + off + bj * HALF + n * 16); }
#pragma unroll
            for (int m = 0; m < 4; ++m) { const int rl = ai * HALF + wr * 64 + m * 16 + fr; const size_t off = (size_t)(u.pm * BM + rl) * DM + col0; float s = 0.f;
#pragma unroll
                for (int bj = 0; bj < 2; ++bj)
#pragma unroll
                    for (int n = 0; n < 2; ++n) { const f32x4 a = acc[ai][bj][m][n] * ds; const u32x2 r = rv[m][bj][n];
                        const float v0 = bf_lo(r.x) + a[0], v1 = bf_hi(r.x) + a[1], v2 = bf_lo(r.y) + a[2], v3 = bf_hi(r.y) + a[3];
                        u32x2 w; w.x = cvt_pk_bf16(v0, v1); w.y = cvt_pk_bf16(v2, v3);
                        *(u32x2*)(xb + off + bj * HALF + n * 16) = w; s += (v0 * v0 + v1 * v1) + (v2 * v2 + v3 * v3);
                        if (x8) *(unsigned*)(x8 + off + bj * HALF + n * 16) = q8 == 0.f ? pk4_fp8(v0, v1, v2, v3) : pk4_i8s(v0, v1, v2, v3, q8); }
                s = rows4_sum(s);
                if (fq == 0) P[rl * 4 + wc] = s; }
            asm volatile("" ::: "memory"); }
        asm volatile("s_waitcnt lgkmcnt(0)" ::: "memory"); __builtin_amdgcn_s_barrier(); asm volatile("" ::: "memory");
        const int t = wid * 64 + lane;
        if (t < 256) { const f32x4 p = *(const LAS f32x4*)(P + t * 4); ssq[(size_t)(u.pm * BM + t) * 8 + u.pn] = (p[0] + p[1]) + (p[2] + p[3]); }
        asm volatile("s_waitcnt lgkmcnt(0)" ::: "memory"); __builtin_amdgcn_s_barrier(); asm volatile("" ::: "memory");
    }
};

struct EpiL1In {
    static constexpr bool PERM = false, AFTER_DRAIN = true;
    const float* ssq2; bf16_t* ckv; float* kpe; float* kss; bf16_t* cq; float* ssqq; bf16_t* qm; const float* g_mq1; float cmem;
    __device__ __forceinline__ void fused(f32x4 (&acc)[2][2][4][2], const Unit& u, int wr, int wc, int fr, int fq, LAS unsigned char* lds, int wid, int lane) const {
        LAS float* P = (LAS float*)lds;
#pragma unroll
        for (int ai = 0; ai < 2; ++ai)
#pragma unroll
            for (int m = 0; m < 4; ++m) { const int rl = ai * HALF + wr * 64 + m * 16 + fr;
#pragma unroll
                for (int bj = 0; bj < 2; ++bj) { const f32x4 a = acc[ai][bj][m][0], b = acc[ai][bj][m][1];
                    float s = (a[0] * a[0] + a[1] * a[1]) + (a[2] * a[2] + a[3] * a[3]) + (b[0] * b[0] + b[1] * b[1]) + (b[2] * b[2] + b[3] * b[3]);
                    s = rows4_sum(s);
                    if (fq == 0) P[(rl * 2 + bj) * 4 + wc] = s; } }
        asm volatile("s_waitcnt lgkmcnt(0)" ::: "memory"); __builtin_amdgcn_s_barrier(); asm volatile("" ::: "memory");
        const int pn = u.pn;
        float r2s[2][4];
        { f32x4 qa[2][4], qb[2][4];
#pragma unroll
          for (int ai = 0; ai < 2; ++ai)
#pragma unroll
              for (int m = 0; m < 4; ++m) { const int row = u.pm * BM + ai * HALF + wr * 64 + m * 16 + fr; qa[ai][m] = *(const f32x4*)(ssq2 + (size_t)row * 8); qb[ai][m] = *(const f32x4*)(ssq2 + (size_t)row * 8 + 4); }
#pragma unroll
          for (int ai = 0; ai < 2; ++ai)
#pragma unroll
              for (int m = 0; m < 4; ++m) r2s[ai][m] = __builtin_amdgcn_rsqf(((qa[ai][m][0] + qa[ai][m][1]) + (qa[ai][m][2] + qa[ai][m][3]) + (qb[ai][m][0] + qb[ai][m][1]) + (qb[ai][m][2] + qb[ai][m][3])) * (1.0f / 2048.0f) + EPS); }
#pragma unroll
        for (int ai = 0; ai < 2; ++ai)
#pragma unroll
            for (int m = 0; m < 4; ++m) { const int rl = ai * HALF + wr * 64 + m * 16 + fr, row = u.pm * BM + rl;
                const float r2 = r2s[ai][m];
                const f32x4 p0 = *(const LAS f32x4*)(P + (rl * 2 + 0) * 4), p1 = *(const LAS f32x4*)(P + (rl * 2 + 1) * 4);
                const float ss0 = (p0[0] + p0[1]) + (p0[2] + p0[3]), ss1 = (p1[0] + p1[1]) + (p1[2] + p1[3]);
                const int cl = wc * 32 + 4 * fq;
                if (pn == 0) { const float sc = r2 * __builtin_amdgcn_rsqf(r2 * r2 * (ss0 + ss1) * (1.0f / 256.0f) + EPS);
#pragma unroll
                    for (int bj = 0; bj < 2; ++bj)
#pragma unroll
                        for (int n = 0; n < 2; ++n) { const f32x4 v = acc[ai][bj][m][n] * sc; u32x2 w; w.x = cvt_pk_bf16(v[0], v[1]); w.y = cvt_pk_bf16(v[2], v[3]);
                            *(u32x2*)(ckv + (size_t)row * 256 + bj * HALF + cl + n * 16) = w; } }
                else if (pn == 1) { if (wc < 2) {
#pragma unroll
                        for (int n = 0; n < 2; ++n) *(f32x4*)(kpe + (size_t)row * 64 + cl + n * 16) = acc[ai][0][m][n] * r2; }
                    if (wc == 0 && fq == 0) kss[row] = r2 * r2 * ss0; }
                else if (pn < 4) {
#pragma unroll
                    for (int bj = 0; bj < 2; ++bj)
#pragma unroll
                        for (int n = 0; n < 2; ++n) { const f32x4 v = acc[ai][bj][m][n] * r2; u32x2 w; w.x = cvt_pk_bf16(v[0], v[1]); w.y = cvt_pk_bf16(v[2], v[3]);
                            *(u32x2*)(cq + (size_t)row * 512 + (pn - 2) * 256 + bj * HALF + cl + n * 16) = w; }
                    if (wc == 0 && fq == 0) ssqq[row * 2 + (pn - 2)] = r2 * r2 * (ss0 + ss1); }
                else { const int b = row >> 12, s = row & (SEQ - 1);
#pragma unroll
                    for (int bj = 0; bj < 2; ++bj) { const int head = (pn - 4) * 2 + bj; const float rr = cmem * r2 * __builtin_amdgcn_rsqf(r2 * r2 * (bj ? ss1 : ss0) * (1.0f / 128.0f) + EPS);
#pragma unroll
                        for (int n = 0; n < 2; ++n) { const f32x4 g = *(const f32x4*)(g_mq1 + cl + n * 16); const f32x4 v = acc[ai][bj][m][n] * rr * g; u32x2 w; w.x = cvt_pk_bf16(v[0], v[1]); w.y = cvt_pk_bf16(v[2], v[3]);
                            *(u32x2*)(qm + ((size_t)(b * 4 + head) * SEQ + s) * 128 + cl + n * 16) = w; } } }
                asm volatile("" ::: "memory"); }
    }
};

template <class Epi, class Sched, bool ALIGN_EPI = false, bool SP2 = false, bool F8 = false, bool I8 = false>
__device__ __forceinline__ void gemm_phase(LAS unsigned char* lds, const int wid, const Gemm g, const Sched& S, const Epi& E, const int f8s = 0x7f7f7f7f) {
    const int lane = lane_now(), tid = wid * 64 + lane, wr = wid >> 2, wc = wid & 3, fr = lane & 15, fq = lane >> 4;
    const int K = g.ld, nt = g.K / BK;
    unsigned voffA, voffB;
    { int R, C; stage_rc(tid * 16, R, C); const int Rb = Epi::PERM ? ((R & ~31) + perm32(R & 31)) : R;
      voffA = (unsigned)(R * K + C) * 2u; voffB = (unsigned)(Rb * K + C) * 2u; }
    const unsigned qstep = 64u * (unsigned)K * 2u;
    const unsigned kstep = (unsigned)(BK * 2);
    const unsigned hstep = (unsigned)HALF * K * 2;
    const unsigned tstep = 2 * hstep;
    const __amdgpu_buffer_rsrc_t rA = __builtin_amdgcn_make_buffer_rsrc((void*)g.A, 0, 0xffffffffu, 0x00020000), rB = __builtin_amdgcn_make_buffer_rsrc((void*)g.Bt, 0, 0xffffffffu, 0x00020000);
    const unsigned ldsw = (unsigned)wid * 1024u;
    const int aoff = lds_byte(wr * 64 + fr, fq * 8), boff = lds_byte(wc * 32 + fr, fq * 8);
#define PG8_SA(b, h) (((b) * 2 + (h)) * HTB)
#define PG8_SB(b, h) ((4 + (b) * 2 + (h)) * HTB)
#define PG8_STAGE(bufoff, rs, so, voff) do { _Pragma("unroll") for (int _i = 0; _i < 2; ++_i) \
        __builtin_amdgcn_raw_ptr_buffer_load_lds(rs, (LAS unsigned*)(lds + (bufoff) + ldsw + _i * 8192), 16, (int)(voff), (int)((so) + _i * qstep), 0, 0); } while (0)
#define PG8_LDA(dst, b, h) do { _Pragma("unroll") for (int m = 0; m < 4; ++m) _Pragma("unroll") for (int k = 0; k < 2; ++k) dst[m][k] = *(const LAS bf16x8*)(lds + PG8_SA(b, h) + aoff + m * 2048 + k * 1024); } while (0)
#define PG8_LDB(dst, b, h) do { _Pragma("unroll") for (int n = 0; n < 2; ++n) _Pragma("unroll") for (int k = 0; k < 2; ++k) dst[n][k] = *(const LAS bf16x8*)(lds + PG8_SB(b, h) + boff + n * 2048 + k * 1024); } while (0)
#define PG8_CAT(x0, x1) __builtin_shufflevector(__builtin_bit_cast(v4i_t, x0), __builtin_bit_cast(v4i_t, x1), 0, 1, 2, 3, 4, 5, 6, 7)
#define PG8_MMA(ai, bj, At, Bt) do { __builtin_amdgcn_s_setprio(1); _Pragma("unroll") for (int m = 0; m < 4; ++m) _Pragma("unroll") for (int n = 0; n < 2; ++n) { \
        if constexpr (F8) acc[ai][bj][m][n] = __builtin_amdgcn_mfma_scale_f32_16x16x128_f8f6f4(PG8_CAT(Bt[n][0], Bt[n][1]), PG8_CAT(At[m][0], At[m][1]), acc[ai][bj][m][n], 0, 0, 0, f8s, 1, f8s); \
        else if constexpr (I8) { _Pragma("unroll") for (int k = 0; k < 2; ++k) acc[ai][bj][m][n] = __builtin_bit_cast(f32x4, __builtin_amdgcn_mfma_i32_16x16x64_i8(__builtin_bit_cast(v4i_t, Bt[n][k]), __builtin_bit_cast(v4i_t, At[m][k]), __builtin_bit_cast(v4i_t, acc[ai][bj][m][n]), 0, 0, 0)); } \
        else { _Pragma("unroll") for (int k = 0; k < 2; ++k) acc[ai][bj][m][n] = __builtin_amdgcn_mfma_f32_16x16x32_bf16(Bt[n][k], At[m][k], acc[ai][bj][m][n], 0, 0, 0); } } \
        __builtin_amdgcn_s_setprio(0); } while (0)
#define PG8_WAIT_V(n) asm volatile("s_waitcnt vmcnt(" #n ")" ::: "memory")
#define PG8_WAIT_L(n) asm volatile("s_waitcnt lgkmcnt(" #n ")" ::: "memory")
#define PG8_BAR __builtin_amdgcn_s_barrier()
#define PG8_SCHED __builtin_amdgcn_sched_barrier(0)
    Unit cur, nxt; int ui = 0;
    if (!S.next(0, cur)) return;
    f32x4 acc[2][2][4][2];
#pragma unroll
    for (int a = 0; a < 2; ++a)
#pragma unroll
        for (int b = 0; b < 2; ++b)
#pragma unroll
            for (int m = 0; m < 4; ++m)
#pragma unroll
                for (int n = 0; n < 2; ++n) acc[a][b][m][n] = (f32x4){0.f, 0.f, 0.f, 0.f};
    bf16x8 At[4][2], B0[2][2], B1[2][2];
    unsigned cA = (unsigned)cur.am * tstep + (unsigned)cur.koff, cB = (unsigned)cur.bn * tstep + (unsigned)cur.koff;
    if constexpr (SP2) {
        PG8_STAGE(PG8_SB(0, 0), rB, cB, voffB); PG8_STAGE(PG8_SB(0, 1), rB, cB + hstep, voffB); PG8_STAGE(PG8_SA(0, 0), rA, cA, voffA); PG8_STAGE(PG8_SA(0, 1), rA, cA + hstep, voffA);
        if (wr == 1) PG8_BAR;
        PG8_WAIT_V(2); PG8_BAR;
        PG8_STAGE(PG8_SB(1, 0), rB, cB + kstep, voffB); PG8_STAGE(PG8_SA(1, 0), rA, cA + kstep, voffA); PG8_STAGE(PG8_SB(1, 1), rB, cB + hstep + kstep, voffB);
        PG8_WAIT_V(6); PG8_BAR;
    } else {
        PG8_STAGE(PG8_SB(0, 0), rB, cB, voffB); PG8_STAGE(PG8_SA(0, 0), rA, cA, voffA); PG8_STAGE(PG8_SB(0, 1), rB, cB + hstep, voffB); PG8_STAGE(PG8_SA(0, 1), rA, cA + hstep, voffA);
        if (wr == 1) PG8_BAR;
        PG8_WAIT_V(4); PG8_BAR;
        PG8_STAGE(PG8_SB(1, 0), rB, cB + kstep, voffB); PG8_STAGE(PG8_SA(1, 0), rA, cA + kstep, voffA); PG8_STAGE(PG8_SB(1, 1), rB, cB + hstep + kstep, voffB);
        PG8_WAIT_V(6); PG8_BAR;
    }
    for (;;) {
        const bool has_next = S.next(ui + 1, nxt);
        const unsigned nA = has_next ? (unsigned)nxt.am * tstep + (unsigned)nxt.koff : cA, nB = has_next ? (unsigned)nxt.bn * tstep + (unsigned)nxt.koff : cB;
#pragma unroll 1
        for (int t = 0; t < nt; t += 2) {
            const bool last = (t == nt - 2);
            const unsigned a1 = cA + (unsigned)(t + 1) * kstep;
            const unsigned a2 = last ? nA : cA + (unsigned)(t + 2) * kstep, b2 = last ? nB : cB + (unsigned)(t + 2) * kstep;
            const unsigned a3 = a2 + kstep, b3 = b2 + kstep;
            if constexpr (SP2) {
            PG8_LDB(B0, 0, 0); PG8_LDB(B1, 0, 1); PG8_SCHED; PG8_LDA(At, 0, 0); PG8_STAGE(PG8_SA(1, 1), rA, a1 + hstep, voffA);
            PG8_WAIT_V(8); PG8_WAIT_L(0); PG8_BAR; PG8_MMA(0, 0, At, B0); PG8_MMA(0, 1, At, B1); PG8_BAR; PG8_SCHED;
            PG8_LDA(At, 0, 1); PG8_STAGE(PG8_SB(0, 0), rB, b2, voffB); PG8_STAGE(PG8_SB(0, 1), rB, b2 + hstep, voffB); PG8_STAGE(PG8_SA(0, 0), rA, a2, voffA);
            PG8_WAIT_V(8); PG8_WAIT_L(0); PG8_BAR; PG8_MMA(1, 0, At, B0); PG8_MMA(1, 1, At, B1); PG8_BAR; PG8_SCHED;
            PG8_LDB(B0, 1, 0); PG8_LDB(B1, 1, 1); PG8_SCHED; PG8_LDA(At, 1, 0); PG8_STAGE(PG8_SA(0, 1), rA, a2 + hstep, voffA);
            PG8_WAIT_V(8); PG8_WAIT_L(0); PG8_BAR; PG8_MMA(0, 0, At, B0); PG8_MMA(0, 1, At, B1); PG8_BAR; PG8_SCHED;
            PG8_LDA(At, 1, 1); PG8_STAGE(PG8_SB(1, 0), rB, b3, voffB); PG8_STAGE(PG8_SB(1, 1), rB, b3 + hstep, voffB); PG8_STAGE(PG8_SA(1, 0), rA, a3, voffA);
            PG8_WAIT_V(8); PG8_WAIT_L(0); PG8_BAR; PG8_MMA(1, 0, At, B0); PG8_MMA(1, 1, At, B1); PG8_BAR; PG8_SCHED;
            } else {
            PG8_LDB(B0, 0, 0); PG8_SCHED; PG8_LDA(At, 0, 0); PG8_STAGE(PG8_SA(1, 1), rA, a1 + hstep, voffA);
            PG8_WAIT_L(8); PG8_BAR; PG8_WAIT_L(0); PG8_MMA(0, 0, At, B0); PG8_BAR; PG8_SCHED;
            PG8_LDB(B1, 0, 1); PG8_STAGE(PG8_SB(0, 0), rB, b2, voffB);
            PG8_BAR; PG8_WAIT_L(0); PG8_MMA(0, 1, At, B1); PG8_BAR;
            PG8_LDA(At, 0, 1); PG8_STAGE(PG8_SA(0, 0), rA, a2, voffA);
            PG8_BAR; PG8_WAIT_L(0); PG8_MMA(1, 0, At, B0); PG8_BAR; PG8_SCHED;
            PG8_STAGE(PG8_SB(0, 1), rB, b2 + hstep, voffB);
            PG8_WAIT_V(6); PG8_BAR; PG8_MMA(1, 1, At, B1); PG8_BAR;
            PG8_LDB(B0, 1, 0); PG8_SCHED; PG8_LDA(At, 1, 0); PG8_STAGE(PG8_SA(0, 1), rA, a2 + hstep, voffA);
            PG8_WAIT_L(8); PG8_BAR; PG8_WAIT_L(0); PG8_MMA(0, 0, At, B0); PG8_BAR; PG8_SCHED;
            PG8_LDB(B1, 1, 1); PG8_STAGE(PG8_SB(1, 0), rB, b3, voffB);
            PG8_BAR; PG8_WAIT_L(0); PG8_MMA(0, 1, At, B1); PG8_BAR;
            PG8_LDA(At, 1, 1); PG8_STAGE(PG8_SA(1, 0), rA, a3, voffA);
            PG8_BAR; PG8_WAIT_L(0); PG8_MMA(1, 0, At, B0); PG8_BAR; PG8_SCHED;
            PG8_STAGE(PG8_SB(1, 1), rB, b3 + hstep, voffB);
            PG8_WAIT_V(6); PG8_BAR; PG8_MMA(1, 1, At, B1); PG8_BAR;
            }
        }
        if constexpr (ALIGN_EPI) { if (wr == 0) PG8_BAR; }
        if constexpr (I8) {
#pragma unroll
            for (int a = 0; a < 2; ++a)
#pragma unroll
                for (int b = 0; b < 2; ++b)
#pragma unroll
                    for (int m = 0; m < 4; ++m)
#pragma unroll
                        for (int n = 0; n < 2; ++n) acc[a][b][m][n] = __builtin_convertvector(__builtin_bit_cast(v4i_t, acc[a][b][m][n]), f32x4); }
        if constexpr (!Epi::AFTER_DRAIN) { E(acc, cur, wr, wc, fr, fq); }
        if (!has_next) break;
#pragma unroll
        for (int a = 0; a < 2; ++a)
#pragma unroll
            for (int b = 0; b < 2; ++b)
#pragma unroll
                for (int m = 0; m < 4; ++m)
#pragma unroll
                    for (int n = 0; n < 2; ++n) acc[a][b][m][n] = (f32x4){0.f, 0.f, 0.f, 0.f};
        cur = nxt; cA = nA; cB = nB; ++ui;
        if constexpr (ALIGN_EPI) { if (wr == 1) PG8_BAR; }
    }
    PG8_WAIT_V(0);
    if constexpr (!ALIGN_EPI) { if (wr == 0) PG8_BAR; }
    PG8_BAR;
    if constexpr (Epi::AFTER_DRAIN) { E.fused(acc, cur, wr, wc, fr, fq, lds, wid, lane); }
#undef PG8_SA
#undef PG8_SB
#undef PG8_STAGE
#undef PG8_LDA
#undef PG8_LDB
#undef PG8_MMA
#undef PG8_CAT
#undef PG8_WAIT_V
#undef PG8_WAIT_L
#undef PG8_BAR
#undef PG8_SCHED
}
}

#define XB_TMO      128
#define XB_XCNT(j)  (256  + 64 * (j))
#define XB_XSUB(j)  (1280 + 64 * (j))
#define XB_XGEN(j)  (2304 + 64 * (j))
#define XB_TOP      3328
#define XB_TOPGEN   3392
#define XCD_BAR_WORDS 3456
#define XB_SPIN_CAP (1u << 18)
__device__ __forceinline__ unsigned xb_ld(unsigned* p)              { return __hip_atomic_load(p, __ATOMIC_RELAXED, __HIP_MEMORY_SCOPE_AGENT); }
__device__ __forceinline__ unsigned xb_add(unsigned* p, unsigned v) { return __hip_atomic_fetch_add(p, v, __ATOMIC_RELAXED, __HIP_MEMORY_SCOPE_AGENT); }
__device__ __forceinline__ unsigned xb_xcc_id() { return (unsigned)__builtin_amdgcn_s_getreg((3 << 11) | 20) & 0xFu; }
#define XB_SPIN(cond, bar) do { unsigned _sp = 0; while (cond) { __builtin_amdgcn_s_sleep(1); \
    if ((++_sp & 255u) == 0u) { if (xb_ld(&(bar)[XB_TMO])) break; if (_sp > XB_SPIN_CAP) { atomicAdd(&(bar)[XB_TMO], 1u); break; } } } } while (0)
struct XcdBarrier { unsigned* bar; unsigned x; volatile LAS unsigned* st; int wave; };
__device__ __forceinline__ XcdBarrier xcd_barrier_post(unsigned* bar, volatile LAS unsigned* st, int wave) {
    XcdBarrier b; b.bar = bar; b.x = xb_xcc_id(); b.st = st; b.wave = wave;
    if (wave == 0 && lane_now() == 0) (void)xb_add(&bar[XB_XCNT(b.x)], 1u);
    return b;
}
__device__ __forceinline__ void xcd_barrier_complete(unsigned* bar, unsigned x, unsigned& nloc, unsigned& nx) {
    const unsigned G = gridDim.x * gridDim.y * gridDim.z;
    unsigned sum, cnt, mine, sp = 0u;
    for (;;) {
        sum = 0u; cnt = 0u; mine = 0u;
#pragma unroll
        for (unsigned j = 0; j < 16; ++j) { const unsigned c = xb_ld(&bar[XB_XCNT(j)]); sum += c; cnt += (c > 0u) ? 1u : 0u; mine = (j == x) ? c : mine; }
        if (sum == G) break;
        __builtin_amdgcn_s_sleep(1);
        if ((++sp & 255u) == 0u) { if (xb_ld(&bar[XB_TMO])) break; if (sp > XB_SPIN_CAP) { atomicAdd(&bar[XB_TMO], 1u); break; } }
    }
    nloc = mine > 0u ? mine : 1u; nx = cnt > 0u ? cnt : 1u;
}
__device__ __forceinline__ void xcd_barrier(const XcdBarrier& b) {
    asm volatile("s_waitcnt vmcnt(0)" ::: "memory");
    __syncthreads();
    if (b.wave == 0 && lane_now() == 0) {
        unsigned* bar = b.bar;
        __builtin_amdgcn_s_waitcnt(0);
        unsigned nloc = b.st[0], nx = b.st[1];
        if (nloc == 0u) { xcd_barrier_complete(bar, b.x, nloc, nx); b.st[0] = nloc; b.st[1] = nx; }
        const unsigned old = xb_add(&bar[XB_XSUB(b.x)], 1u);
        const unsigned gen = old / nloc;
        if (old + 1u == (gen + 1u) * nloc) {
            __builtin_amdgcn_fence(__ATOMIC_RELEASE, "agent");
            asm volatile("s_waitcnt vmcnt(0)" ::: "memory");
            const unsigned og = xb_add(&bar[XB_TOP], 1u);
            const unsigned tg = og / nx;
            if (og + 1u == (tg + 1u) * nx) xb_add(&bar[XB_TOPGEN], 1u);
            else XB_SPIN(xb_ld(&bar[XB_TOPGEN]) == tg, bar);
            __builtin_amdgcn_fence(__ATOMIC_ACQUIRE, "agent");
            xb_add(&bar[XB_XGEN(b.x)], 1u);
            asm volatile("s_waitcnt vmcnt(0)" ::: "memory");
        } else {
            XB_SPIN(xb_ld(&bar[XB_XGEN(b.x)]) == gen, bar);
            __builtin_amdgcn_fence(__ATOMIC_ACQUIRE, "agent");
            asm volatile("s_waitcnt vmcnt(0)" ::: "memory");
        }
    }
    __syncthreads();
}

typedef const __attribute__((address_space(4))) unsigned char* kptr_t;
struct Frame {
    LAS unsigned char* lds;
    int wave, vcu, G;
    kptr_t kp;
    float* out; unsigned char* ws;
};
__device__ __forceinline__ const float* inp(const Frame& F, int i) { kptr_t p = F.kp; asm volatile("" : "+s"(p)); return *(const float* const __attribute__((address_space(4)))*)(p + 8 * i); }
#define WSP(T, off) ((T*)(F.ws + (off)))

__device__ const double INVF_REV[32] = {0.15915494309189535, 0.11934937021124886, 0.089499401608891013, 0.067115083005227255, 0.050329212104487035, 0.037741584717419778, 0.028302195830623399, 0.02122365276477766,
    0.015915494309189534, 0.011934937021124886, 0.0089499401608891006, 0.0067115083005227253, 0.0050329212104487037, 0.0037741584717419768, 0.0028302195830623399, 0.0021223652764777662,
    0.0015915494309189536, 0.0011934937021124887, 0.00089499401608891024, 0.0006711508300522726, 0.00050329212104487043, 0.00037741584717419774, 0.00028302195830623401, 0.00021223652764777661,
    0.00015915494309189535, 0.00011934937021124886, 8.9499401608891018e-05, 6.7115083005227268e-05, 5.0329212104487035e-05, 3.7741584717419777e-05, 2.8302195830623399e-05, 2.1223652764777659e-05};

template <bool F8 = false>
__device__ __forceinline__ void tr_tile64(const float* W, int N, const float* gain, bf16_t* WT, int ldt, int drow, int k0, int ncol, int rg, float sc = 1.0f) {
    const float* src = W + (size_t)(k0 + rg * 16) * N + ncol;
    f32x4 v[16];
#pragma unroll
    for (int i = 0; i < 16; ++i) v[i] = __builtin_nontemporal_load((const f32x4*)(src + (size_t)i * N));
    if (gain) { f32x4 g[4];
#pragma unroll
        for (int q = 0; q < 4; ++q) g[q] = *(const f32x4*)(gain + k0 + rg * 16 + 4 * q);
#pragma unroll
        for (int i = 0; i < 16; ++i) v[i] = v[i] * g[i >> 2][i & 3]; }
    if constexpr (F8) {
#pragma unroll
        for (int j = 0; j < 4; ++j) { u32x4 a;
            a.x = pk4_fp8(v[0][j] * sc, v[1][j] * sc, v[2][j] * sc, v[3][j] * sc); a.y = pk4_fp8(v[4][j] * sc, v[5][j] * sc, v[6][j] * sc, v[7][j] * sc);
            a.z = pk4_fp8(v[8][j] * sc, v[9][j] * sc, v[10][j] * sc, v[11][j] * sc); a.w = pk4_fp8(v[12][j] * sc, v[13][j] * sc, v[14][j] * sc, v[15][j] * sc);
            *(u32x4*)((unsigned char*)WT + (size_t)(drow + j) * ldt + k0 + rg * 16) = a; }
        return; }
#pragma unroll
    for (int j = 0; j < 4; ++j) { u32x4 a, b;
        a.x = cvt_pk_bf16(v[0][j], v[1][j]); a.y = cvt_pk_bf16(v[2][j], v[3][j]); a.z = cvt_pk_bf16(v[4][j], v[5][j]); a.w = cvt_pk_bf16(v[6][j], v[7][j]);
        b.x = cvt_pk_bf16(v[8][j], v[9][j]); b.y = cvt_pk_bf16(v[10][j], v[11][j]); b.z = cvt_pk_bf16(v[12][j], v[13][j]); b.w = cvt_pk_bf16(v[14][j], v[15][j]);
        bf16_t* d = WT + (size_t)(drow + j) * ldt + k0 + rg * 16; *(u32x4*)d = a; *(u32x4*)(d + 8) = b; }
}
template <bool F8>
__device__ __forceinline__ void tr_tile128(const float* W, int N, const float* gain, unsigned char* WT  , int ldt  , int k0, int ncol, int rg, float sc) {
    f32x4 v[16];
    if constexpr (F8) { const float* src = W + (size_t)(k0 + rg * 16) * N + ncol;
#pragma unroll
        for (int i = 0; i < 16; ++i) v[i] = __builtin_nontemporal_load((const f32x4*)(src + (size_t)i * N));
        if (gain) { f32x4 g[4];
#pragma unroll
            for (int q = 0; q < 4; ++q) g[q] = *(const f32x4*)(gain + k0 + rg * 16 + 4 * q);
#pragma unroll
            for (int i = 0; i < 16; ++i) v[i] = v[i] * (g[i >> 2][i & 3] * sc); }
        else {
#pragma unroll
            for (int i = 0; i < 16; ++i) v[i] = v[i] * sc; }
#pragma unroll
        for (int j = 0; j < 4; ++j) { u32x4 a;
            a.x = pk4_fp8(v[0][j], v[1][j], v[2][j], v[3][j]); a.y = pk4_fp8(v[4][j], v[5][j], v[6][j], v[7][j]);
            a.z = pk4_fp8(v[8][j], v[9][j], v[10][j], v[11][j]); a.w = pk4_fp8(v[12][j], v[13][j], v[14][j], v[15][j]);
            *(u32x4*)(WT + (size_t)j * ldt + rg * 16) = a; } }
    else { const float* src = W + (size_t)(k0 + rg * 8) * N + ncol;
#pragma unroll
        for (int i = 0; i < 8; ++i) { v[i] = __builtin_nontemporal_load((const f32x4*)(src + (size_t)i * N)); v[8 + i] = __builtin_nontemporal_load((const f32x4*)(src + (size_t)(64 + i) * N)); }
        if (gain) { f32x4 g[4];
#pragma unroll
            for (int q = 0; q < 2; ++q) { g[q] = *(const f32x4*)(gain + k0 + rg * 8 + 4 * q); g[2 + q] = *(const f32x4*)(gain + k0 + 64 + rg * 8 + 4 * q); }
#pragma unroll
            for (int i = 0; i < 16; ++i) v[i] = v[i] * g[i >> 2][i & 3]; }
#pragma unroll
        for (int j = 0; j < 4; ++j) { u32x4 a, b;
            a.x = cvt_pk_bf16(v[0][j], v[1][j]); a.y = cvt_pk_bf16(v[2][j], v[3][j]); a.z = cvt_pk_bf16(v[4][j], v[5][j]); a.w = cvt_pk_bf16(v[6][j], v[7][j]);
            b.x = cvt_pk_bf16(v[8][j], v[9][j]); b.y = cvt_pk_bf16(v[10][j], v[11][j]); b.z = cvt_pk_bf16(v[12][j], v[13][j]); b.w = cvt_pk_bf16(v[14][j], v[15][j]);
            *(u32x4*)(WT + (size_t)j * ldt + rg * 16) = a; *(u32x4*)(WT + (size_t)j * ldt + 128 + rg * 16) = b; } }
}
__device__ __forceinline__ void norm_row_bf16(const float* xrow, bf16_t* orow, bf16_t* raw, float* rs, int lane) {
    const f32x4* xr = (const f32x4*)xrow + lane; f32x4 v[8]; float s = 0.f;
#pragma unroll
    for (int j = 0; j < 8; ++j) { v[j] = xr[64 * j]; s += (v[j][0] * v[j][0] + v[j][1] * v[j][1]) + (v[j][2] * v[j][2] + v[j][3] * v[j][3]); }
    const float r = 1.0f * __builtin_amdgcn_rsqf(wave_sum(s) * (1.0f / 2048.0f) + EPS);
    if (orow) { u32x2* o8 = (u32x2*)orow + lane;
#pragma unroll
        for (int j = 0; j < 8; ++j) { u32x2 w; w.x = cvt_pk_bf16(v[j][0] * r, v[j][1] * r); w.y = cvt_pk_bf16(v[j][2] * r, v[j][3] * r); o8[64 * j] = w; } }
    if (raw) { u32x2* r8 = (u32x2*)raw + lane;
#pragma unroll
        for (int j = 0; j < 8; ++j) { u32x2 w; w.x = cvt_pk_bf16(v[j][0], v[j][1]); w.y = cvt_pk_bf16(v[j][2], v[j][3]); r8[64 * j] = w; } }
    if (rs && lane == 0) *rs = r;
}
struct TrItem { const float* src; const float* gain; unsigned char* dst; int N, ldt, hi_rows, g_hi; float sc; int f8, useg; };
__device__ __forceinline__ void tr_load16(f32x4 (&v)[16], f32x4 (&g)[4], const TrItem& it) {
#pragma unroll
    for (int i = 0; i < 8; ++i) { v[i] = __builtin_nontemporal_load((const f32x4*)(it.src + (size_t)i * it.N)); v[8 + i] = __builtin_nontemporal_load((const f32x4*)(it.src + (size_t)(it.hi_rows + i) * it.N)); }
#pragma unroll
    for (int q = 0; q < 2; ++q) { const f32x4 a = *(const f32x4*)(it.gain + 4 * q), b = *(const f32x4*)(it.gain + it.g_hi + 4 * q);
        g[q] = it.useg ? a : (f32x4){1.f, 1.f, 1.f, 1.f}; g[2 + q] = it.useg ? b : (f32x4){1.f, 1.f, 1.f, 1.f}; }
}
__device__ __forceinline__ void tr_store16(f32x4 (&v)[16], const f32x4 (&g)[4], const TrItem& it) {
#pragma unroll
    for (int i = 0; i < 16; ++i) v[i] = v[i] * (g[i >> 2][i & 3] * it.sc);
    if (it.f8 == 2) {
#pragma unroll
        for (int j = 0; j < 4; ++j) { u32x4 a;
            a.x = pk4_i8(v[0][j], v[1][j], v[2][j], v[3][j]); a.y = pk4_i8(v[4][j], v[5][j], v[6][j], v[7][j]);
            a.z = pk4_i8(v[8][j], v[9][j], v[10][j], v[11][j]); a.w = pk4_i8(v[12][j], v[13][j], v[14][j], v[15][j]);
            __builtin_nontemporal_store(a, (u32x4*)(it.dst + (size_t)j * it.ldt)); } }
    else if (it.f8) {
#pragma unroll
        for (int j = 0; j < 4; ++j) { u32x4 a;
            a.x = pk4_fp8(v[0][j], v[1][j], v[2][j], v[3][j]); a.y = pk4_fp8(v[4][j], v[5][j], v[6][j], v[7][j]);
            a.z = pk4_fp8(v[8][j], v[9][j], v[10][j], v[11][j]); a.w = pk4_fp8(v[12][j], v[13][j], v[14][j], v[15][j]);
            __builtin_nontemporal_store(a, (u32x4*)(it.dst + (size_t)j * it.ldt)); } }
    else {
#pragma unroll
        for (int j = 0; j < 4; ++j) { u32x4 a, b;
            a.x = cvt_pk_bf16(v[0][j], v[1][j]); a.y = cvt_pk_bf16(v[2][j], v[3][j]); a.z = cvt_pk_bf16(v[4][j], v[5][j]); a.w = cvt_pk_bf16(v[6][j], v[7][j]);
            b.x = cvt_pk_bf16(v[8][j], v[9][j]); b.y = cvt_pk_bf16(v[10][j], v[11][j]); b.z = cvt_pk_bf16(v[12][j], v[13][j]); b.w = cvt_pk_bf16(v[14][j], v[15][j]);
            __builtin_nontemporal_store(a, (u32x4*)(it.dst + (size_t)j * it.ldt)); __builtin_nontemporal_store(b, (u32x4*)(it.dst + (size_t)j * it.ldt + 128)); } }
}
__device__ __forceinline__ void p0_prologue(Frame& F) {
    const int gw = F.vcu * 8 + F.wave, NGW = F.G * 8, lane = lane_now(), c4 = (lane & 15) * 4, rg = lane >> 4;
    const float* g_mix = inp(F, 3); const float* g_ffn = inp(F, 4); const float* g_mem = inp(F, 5);
    constexpr int IT_E = 3584;
    constexpr int I_MOE = 24 * IT_E, I_FFN = 3 * IT_E, I_IN0 = 32 * 80, I_OUT = 32 * 32, I_KVA = 32 * 5, I_BIN = 32 * 16, I_KVB = 4 * 48, I_QB = 8 * 36, I_MEM = 32 * 16;
    constexpr int NITEMS = I_MOE + I_FFN + I_IN0 + 2 * I_OUT + I_KVA + I_BIN + I_KVB + I_QB + 2 * I_MEM;
    {
      const int rg8 = lane & 7, c8 = (lane >> 3) * 4;
      auto decode = [&](int r) -> TrItem { TrItem t;
          const int e = r / (3 * IT_E), q = r % (3 * IT_E), kind = q / IT_E, j = q % IT_E; const bool moe = e < 8;
          if (kind < 2) { const float* W = moe ? inp(F, kind == 0 ? 25 : 26) + (size_t)e * DM * DFF : inp(F, kind == 0 ? 21 : 22);
              const int kb = j / 224, nb = j % 224, n = nb * 32 + c8, drow = (n >> 7) * 256 + (n & 127) + (kind ? 128 : 0), k0 = kb * 128, kl = k0 + 16 * rg8;
              t.src = W + (size_t)kl * DFF + n; t.N = DFF; t.hi_rows = 8; t.g_hi = 8; t.gain = g_ffn + (moe ? DM : 0) + kl; t.useg = 1; t.f8 = 2; t.sc = QWGU;
              t.ldt = DM; t.dst = (moe ? F.ws + WS_W_MGU + (size_t)e * 2 * DFF * DM : F.ws + WS_W_GU0) + (size_t)drow * DM + k0 + rg8 * 16; }
          else { const float* W = moe ? inp(F, 27) + (size_t)e * DFF * DM : inp(F, 23);
              const int kb = j / 64, nb = j % 64, n = nb * 32 + c8, k0 = kb * 128, kl = k0 + 16 * rg8;
              t.src = W + (size_t)kl * DM + n; t.N = DM; t.hi_rows = 8; t.g_hi = 8; t.gain = g_ffn; t.useg = 0; t.f8 = 2; t.sc = QWD;
              t.ldt = DFF; t.dst = (moe ? F.ws + WS_W_MD + (size_t)e * DM * DFF : F.ws + WS_W_D0) + (size_t)n * DFF + k0 + rg8 * 16; }
          return t; };
      constexpr int NBIG = I_MOE + I_FFN, NIT = 2 * ((NBIG + 2 * 2048 - 1) / (2 * 2048));
      auto item_of = [&](int k) -> int { const int kk = k < NIT - 1 ? k : NIT - 1; const int r = gw * 2 + (kk & 1) + (kk >> 1) * (2 * NGW); return NBIG - 1 - (r < NBIG ? r : r - 2 * NGW); };
      TrItem ia = decode(item_of(0)), ib; f32x4 va[16], ga[4], vb[16], gb[4]; tr_load16(va, ga, ia);
      for (int k = 0; k < NIT; k += 2) {
          ib = decode(item_of(k + 1)); tr_load16(vb, gb, ib);
          tr_store16(va, ga, ia);
          ia = decode(item_of(k + 2)); tr_load16(va, ga, ia);
          tr_store16(vb, gb, ib); } }
    for (int it = (I_MOE + I_FFN) + gw; it < NITEMS; it += NGW) {
        int r = it;
        r -= I_MOE + I_FFN;
        { const int rg8 = lane & 7, c8 = (lane >> 3) * 4;
        if (r < I_IN0) { const int k0 = (r / 160) * 128, n = (r % 160) * 32 + c8; tr_tile128<false>(inp(F, 10), NIN0, g_mix, F.ws + WS_W_IN0 + ((size_t)n * DM + k0) * 2, DM * 2, k0, n, rg8, 1.0f); continue; } r -= I_IN0;
        if (r < 2 * I_OUT) { const int l = r / I_OUT, j = r % I_OUT, k0 = (j / 64) * 128, n = (j % 64) * 32 + c8;
            if (l) tr_tile128<true>(inp(F, 9) + (size_t)DM * DM, DM, nullptr, F.ws + WS_W_OUT1 + (size_t)n * DM + k0, DM, k0, n, rg8, 64.0f);
            else tr_tile128<false>(inp(F, 9), DM, nullptr, F.ws + WS_W_OUT0 + ((size_t)n * DM + k0) * 2, DM * 2, k0, n, rg8, 1.0f); continue; } r -= 2 * I_OUT;
        if (r < I_KVA) { const int k0 = (r / 10) * 128, n = (r % 10) * 32 + c8; tr_tile128<true>(inp(F, 17), 320, inp(F, 16), F.ws + WS_W_1 + (size_t)n * DM + k0, DM, k0, n, rg8, 64.0f); continue; } r -= I_KVA;
        if (r < I_BIN) { const int k0 = (r / 32) * 128, n = (r % 32) * 32 + c8; tr_tile128<true>(inp(F, 12), 1024, g_mix + DM, F.ws + WS_W_1 + (size_t)(512 + n) * DM + k0, DM, k0, n, rg8, 64.0f); continue; } r -= I_BIN;
        if (r < I_KVB) { const int k0 = (r / 96) * 128, n = (r % 96) * 32 + c8, h = n >> 8, j = n & 255;
            tr_tile128<false>(inp(F, 19), 3072, inp(F, 18), F.ws + (j < 128 ? WS_W_KN : WS_W_V) + ((size_t)(h * 128 + (j & 127)) * 256 + k0) * 2, 512, k0, n, rg8, 1.0f); continue; } r -= I_KVB;
        if (r < I_QB) { const int k0 = (r / 72) * 128, n = (r % 72) * 32 + c8; tr_tile128<false>(inp(F, 14), 2304, inp(F, 13), F.ws + WS_W_QB + ((size_t)n * 512 + k0) * 2, 1024, k0, n, rg8, 1.0f); continue; } r -= I_QB;
        { const int l = r / I_MEM, j = r % I_MEM, k0 = (j / 32) * 128, n = (j % 32) * 32 + c8;
            tr_tile128<false>(inp(F, 6) + (size_t)l * DM * 1024, 1024, g_mem + l * DM, F.ws + (n < 512 ? WS_W_MK : WS_W_MV) + ((size_t)(l * 512 + (n & 511)) * DM + k0) * 2, DM * 2, k0, n, rg8, 1.0f); } }
    }
    for (int m = gw; m < NTOK; m += 2 * NGW) {
        const f32x4* xa = (const f32x4*)(inp(F, 0) + (size_t)m * DM) + lane; const f32x4* xc = xa + (size_t)NGW * (DM / 4); f32x4 va[8], vc[8]; float sa = 0.f, sc = 0.f;
#pragma unroll
        for (int j = 0; j < 8; ++j) { va[j] = xa[64 * j]; vc[j] = xc[64 * j]; }
#pragma unroll
        for (int j = 0; j < 8; ++j) { sa += (va[j][0] * va[j][0] + va[j][1] * va[j][1]) + (va[j][2] * va[j][2] + va[j][3] * va[j][3]); sc += (vc[j][0] * vc[j][0] + vc[j][1] * vc[j][1]) + (vc[j][2] * vc[j][2] + vc[j][3] * vc[j][3]); }
        sa = wave_sum(sa); sc = wave_sum(sc);
        u32x2* ra = (u32x2*)(WSP(bf16_t, WS_XB) + (size_t)m * DM) + lane; u32x2* rc = ra + (size_t)NGW * (DM / 4);
#pragma unroll
        for (int j = 0; j < 8; ++j) { u32x2 w; w.x = cvt_pk_bf16(va[j][0], va[j][1]); w.y = cvt_pk_bf16(va[j][2], va[j][3]); ra[64 * j] = w; w.x = cvt_pk_bf16(vc[j][0], vc[j][1]); w.y = cvt_pk_bf16(vc[j][2], vc[j][3]); rc[64 * j] = w; }
        if (lane == 0) { WSP(float, WS_RS0)[m] = 1.0f * __builtin_amdgcn_rsqf(sa * (1.0f / 2048.0f) + EPS); WSP(float, WS_RS0)[m + NGW] = 1.0f * __builtin_amdgcn_rsqf(sc * (1.0f / 2048.0f) + EPS); } }
    for (int m = gw; m < 512; m += NGW) norm_row_bf16(inp(F, 1) + (size_t)m * DM, WSP(bf16_t, WS_MEMN) + (size_t)m * DM, nullptr, nullptr, lane);
    const int gt = F.vcu * 512 + F.wave * 64 + lane_now(), NGT = F.G * 512;
    for (int i = gt; i < 8 * DM; i += NGT) { const int e = i / DM, k = i % DM; WSP(float, WS_WR)[i] = g_ffn[DM + k] * inp(F, 24)[k * 8 + e]; }
    for (int i = gt; i < 192 * DM / 16; i += NGT) ((u32x4*)(F.ws + WS_W_1 + (size_t)320 * DM))[i] = (u32x4){0u, 0u, 0u, 0u};
}

__device__ __forceinline__ void unpack8(const u32x4 w, float (&f)[8]) { f[0] = bf_lo(w.x); f[1] = bf_hi(w.x); f[2] = bf_lo(w.y); f[3] = bf_hi(w.y); f[4] = bf_lo(w.z); f[5] = bf_hi(w.z); f[6] = bf_lo(w.w); f[7] = bf_hi(w.w); }
__device__ __forceinline__ void p2_conv(Frame& F) {
    const bf16_t* U0 = WSP(bf16_t, WS_U0); bf16_t* CAT = WSP(bf16_t, WS_CAT); const float* cw = inp(F, 11);
    const int gt = F.vcu * 512 + F.wave * 64 + lane_now(), NGT = F.G * 512;
    for (int idx = gt; idx < NTOK * 192; idx += NGT) {
        const int t = idx / 192, c = (idx % 192) * 8, s = t & (SEQ - 1);
        const bf16_t* r0 = U0 + (size_t)t * NIN0 + c; const bf16_t* r1 = r0 - (s >= 1 ? NIN0 : 0); const bf16_t* r2 = r0 - (s >= 2 ? 2 * NIN0 : 0);
        const u32x4 qx0 = *(const u32x4*)r0, qg0 = *(const u32x4*)(r0 + 3072), qb = *(const u32x4*)(r0 + 1536), qx1 = *(const u32x4*)r1, qg1 = *(const u32x4*)(r1 + 3072), qx2 = *(const u32x4*)r2, qg2 = *(const u32x4*)(r2 + 3072);
        const f32x4 w2a = *(const f32x4*)(cw + 2 * 1536 + c), w2b = *(const f32x4*)(cw + 2 * 1536 + c + 4), w1a = *(const f32x4*)(cw + 1536 + c), w1b = *(const f32x4*)(cw + 1536 + c + 4), w0a = *(const f32x4*)(cw + c), w0b = *(const f32x4*)(cw + c + 4);
        const float m1 = s >= 1 ? 1.0f : 0.0f, m2 = s >= 2 ? 1.0f : 0.0f;
        float xin[8], gc[8], gb[8], y[8];
        unpack8(qx0, xin); unpack8(qg0, gc); unpack8(qb, gb);
#pragma unroll
        for (int i = 0; i < 8; ++i) y[i] = (i < 4 ? w2a[i] : w2b[i - 4]) * (gc[i] * xin[i]);
        unpack8(qx1, xin); unpack8(qg1, gc);
#pragma unroll
        for (int i = 0; i < 8; ++i) y[i] += (m1 * (i < 4 ? w1a[i] : w1b[i - 4])) * (gc[i] * xin[i]);
        unpack8(qx2, xin); unpack8(qg2, gc);
#pragma unroll
        for (int i = 0; i < 8; ++i) y[i] += (m2 * (i < 4 ? w0a[i] : w0b[i - 4])) * (gc[i] * xin[i]);
        u32x4 o; o.x = cvt_pk_bf16(gb[0] * y[0], gb[1] * y[1]); o.y = cvt_pk_bf16(gb[2] * y[2], gb[3] * y[3]); o.z = cvt_pk_bf16(gb[4] * y[4], gb[5] * y[5]); o.w = cvt_pk_bf16(gb[6] * y[6], gb[7] * y[7]);
        *(u32x4*)(CAT + (size_t)t * DM + c) = o;
    }
}
constexpr float CMEM = 0.08838834764831845f * LOG2E;
constexpr float CMLA = 0.07216878364870323f * LOG2E;
__device__ __forceinline__ int crow(int r, int hi) { return (r & 3) + 8 * (r >> 2) + 4 * hi; }
template <int NK16, bool CAUSAL, bool OUT8 = false>
__device__ __forceinline__ void attn_wave(const bf16_t* Qp, const bf16_t* Kp, const bf16_t* Vt, int ldv, int ntiles, bf16_t* Op, int ldo, int lane, int kt0 = 0, LAS float* xch = nullptr, int xrole = -1, const float* qgain = nullptr, int ldq = 0, float qscale = 0.f) {
    constexpr int DQK = NK16 * 16;
    const int r32 = lane & 31, hi = lane >> 5;
    bf16x8 qf[NK16];
    if (qgain) { u32x4 raw[NK16]; float ss = 0.f;
#pragma unroll
        for (int d0 = 0; d0 < NK16; ++d0) raw[d0] = *(const u32x4*)(Qp + (size_t)r32 * ldq + d0 * 16 + hi * 8);
#pragma unroll
        for (int d0 = 0; d0 < NK16; ++d0) { float a[8]; unpack8(raw[d0], a);
#pragma unroll
            for (int e = 0; e < 8; ++e) ss += a[e] * a[e]; }
        ss += other_half(ss, lane);
        const float r = qscale * __builtin_amdgcn_rsqf(ss * (1.0f / DQK) + EPS);
#pragma unroll
        for (int d0 = 0; d0 < NK16; ++d0) { float a[8]; unpack8(raw[d0], a); const f32x4 g0 = *(const f32x4*)(qgain + d0 * 16 + hi * 8), g1 = *(const f32x4*)(qgain + d0 * 16 + hi * 8 + 4);
            u32x4 wv; wv.x = cvt_pk_bf16(a[0] * r * g0[0], a[1] * r * g0[1]); wv.y = cvt_pk_bf16(a[2] * r * g0[2], a[3] * r * g0[3]); wv.z = cvt_pk_bf16(a[4] * r * g1[0], a[5] * r * g1[1]); wv.w = cvt_pk_bf16(a[6] * r * g1[2], a[7] * r * g1[3]);
            qf[d0] = __builtin_bit_cast(bf16x8, wv); } }
    else {
#pragma unroll
        for (int d0 = 0; d0 < NK16; ++d0) qf[d0] = *(const bf16x8*)(Qp + (size_t)r32 * DQK + d0 * 16 + hi * 8); }
    f32x16 o[4]; float m = -1e30f, l = 0.f;
#pragma unroll
    for (int db = 0; db < 4; ++db)
#pragma unroll
        for (int r = 0; r < 16; ++r) o[db][r] = 0.f;
    bf16x8 kf[NK16], vf[4][2];
    auto ldk = [&](int kt) { const bf16_t* kr = Kp + (size_t)(kt * 32 + r32) * DQK + hi * 8;
#pragma unroll
        for (int d0 = 0; d0 < NK16; ++d0) kf[d0] = *(const bf16x8*)(kr + d0 * 16); };
    auto ldvt = [&](int kt) { const bf16_t* vr0 = Vt + (size_t)r32 * ldv + kt * 32 + hi * 8;
#pragma unroll
        for (int db = 0; db < 4; ++db)
#pragma unroll
            for (int ks = 0; ks < 2; ++ks) vf[db][ks] = *(const bf16x8*)(vr0 + (size_t)(db * 32) * ldv + ks * 16); };
    ldk(kt0); ldvt(kt0);
    for (int kt = kt0; kt < ntiles; ++kt) {
        const int ktn = kt + 1 < ntiles ? kt + 1 : kt;
        f32x16 p;
#pragma unroll
        for (int r = 0; r < 16; ++r) p[r] = 0.f;
        __builtin_amdgcn_sched_barrier(0);
#pragma unroll
        for (int d0 = 0; d0 < NK16; ++d0) p = __builtin_amdgcn_mfma_f32_32x32x16_bf16(kf[d0], qf[d0], p, 0, 0, 0);
        __builtin_amdgcn_sched_barrier(0);
        ldk(ktn);
        __builtin_amdgcn_sched_barrier(0);
        if (CAUSAL && kt == ntiles - 1) {
#pragma unroll
            for (int r = 0; r < 16; ++r) if (crow(r, hi) > r32) p[r] = -__builtin_inff();
        }
        float pm = p[0];
#pragma unroll
        for (int r = 1; r < 16; ++r) pm = fmaxf(pm, p[r]);
        pm = half_max(pm);
        const float mn = fmaxf(m, pm), alpha = __builtin_amdgcn_exp2f(m - mn); m = mn;
        float ps = 0.f;
#pragma unroll
        for (int r = 0; r < 16; ++r) { p[r] = __builtin_amdgcn_exp2f(p[r] - mn); ps += p[r]; }
        ps = half_sum(ps); l = l * alpha + ps;
        if (!__all(alpha == 1.0f)) {
#pragma unroll
            for (int db = 0; db < 4; ++db)
#pragma unroll
                for (int r = 0; r < 16; ++r) o[db][r] *= alpha;
        }
        bf16x8 pa[2];
#pragma unroll
        for (int ks = 0; ks < 2; ++ks) { const unsigned a0 = cvt_pk_bf16(p[8 * ks + 0], p[8 * ks + 1]), a1 = cvt_pk_bf16(p[8 * ks + 2], p[8 * ks + 3]), b0 = cvt_pk_bf16(p[8 * ks + 4], p[8 * ks + 5]), b1 = cvt_pk_bf16(p[8 * ks + 6], p[8 * ks + 7]);
            auto r0 = __builtin_amdgcn_permlane32_swap(a0, b0, false, false); auto r1 = __builtin_amdgcn_permlane32_swap(a1, b1, false, false);
            u32x4 w = {r0[0], r1[0], r0[1], r1[1]}; pa[ks] = __builtin_bit_cast(bf16x8, w); }
#pragma unroll
        for (int ks = 0; ks < 2; ++ks)
#pragma unroll
            for (int db = 0; db < 4; ++db) o[db] = __builtin_amdgcn_mfma_f32_32x32x16_bf16(vf[db][ks], pa[ks], o[db], 0, 0, 0);
        __builtin_amdgcn_sched_barrier(0);
        ldvt(ktn);
    }
    if (xrole >= 0) {
        if (xrole == 1) {
#pragma unroll
            for (int db = 0; db < 4; ++db)
#pragma unroll
                for (int r = 0; r < 16; ++r) xch[(db * 16 + r) * 64 + lane] = o[db][r];
            xch[64 * 64 + lane] = m; xch[65 * 64 + lane] = l; }
        asm volatile("s_waitcnt lgkmcnt(0)" ::: "memory"); __builtin_amdgcn_s_barrier(); asm volatile("" ::: "memory");
        if (xrole == 1) return;
        const float mb = xch[64 * 64 + lane], lb = xch[65 * 64 + lane], M = fmaxf(m, mb), fa = __builtin_amdgcn_exp2f(m - M), fb = __builtin_amdgcn_exp2f(mb - M);
        l = l * fa + lb * fb;
#pragma unroll
        for (int db = 0; db < 4; ++db)
#pragma unroll
            for (int r = 0; r < 16; ++r) o[db][r] = o[db][r] * fa + xch[(db * 16 + r) * 64 + lane] * fb; }
    if constexpr (OUT8) { const float inv = 16.0f / l; unsigned char* orow = (unsigned char*)Op + (size_t)r32 * ldo + 4 * hi;
#pragma unroll
        for (int db = 0; db < 4; ++db)
#pragma unroll
            for (int g = 0; g < 4; ++g) *(unsigned*)(orow + db * 32 + 8 * g) = pk4_fp8(o[db][4 * g] * inv, o[db][4 * g + 1] * inv, o[db][4 * g + 2] * inv, o[db][4 * g + 3] * inv);
        return; }
    const float inv = 1.0f / l;
    bf16_t* orow = Op + (size_t)r32 * ldo + 4 * hi;
#pragma unroll
    for (int db = 0; db < 4; ++db)
#pragma unroll
        for (int g = 0; g < 4; ++g) { u32x2 w; w.x = cvt_pk_bf16(o[db][4 * g] * inv, o[db][4 * g + 1] * inv); w.y = cvt_pk_bf16(o[db][4 * g + 2] * inv, o[db][4 * g + 3] * inv);
            *(u32x2*)(orow + db * 32 + 8 * g) = w; }
}
__device__ __forceinline__ void mem_attn_unit(Frame& F, int l, int uid) {
    const int bh = uid >> 7, qb = uid & 127, b = bh >> 2, h = bh & 3;
    const bf16_t* Qp = WSP(bf16_t, WS_QM) + ((size_t)bh * SEQ + qb * 32) * 128; const bf16_t* Kp = WSP(bf16_t, WS_MEMKF) + (size_t)((l * 2 + b) * 4 + h) * 256 * 128;
    const bf16_t* Vp = WSP(bf16_t, WS_MEMVT) + (size_t)(l * 512 + h * 128) * 512 + b * 256;
    if (l == 0) { const int half = F.wave >> 2;
        attn_wave<8, false, false>(WSP(bf16_t, WS_U0) + (size_t)(b * SEQ + qb * 32) * NIN0 + 4608 + h * 128, Kp, Vp, 512, 4 * half + 4, WSP(bf16_t, WS_CAT) + (size_t)(b * SEQ + qb * 32) * DM + 1536 + h * 128, DM, lane_now(),
                                   4 * half, (LAS float*)F.lds + (F.wave & 3) * (66 * 64), half, inp(F, 7), NIN0, CMEM); }
    else attn_wave<8, false, true>(Qp, Kp, Vp, 512, 8, (bf16_t*)(F.ws + WS_CAT + (size_t)(b * SEQ + qb * 32) * DM + 1536 + h * 128), DM, lane_now());
}

__device__ __forceinline__ void p6b_latents(Frame& F) {
    const int gw = F.vcu * 8 + F.wave, NGW = F.G * 8, lane = lane_now();
    const float* U1F = WSP(float, WS_U1F); const float* g_mq1 = inp(F, 7) + 128;
    for (int t = gw; t < NTOK; t += NGW) { const float* row = U1F + (size_t)t * N1; const int b = t >> 12, s = t & (SEQ - 1);
        { const f32x4 v = *(const f32x4*)(row + 4 * lane); const float r = 1.0f * __builtin_amdgcn_rsqf(wave_sum((v[0] * v[0] + v[1] * v[1]) + (v[2] * v[2] + v[3] * v[3])) * (1.0f / 256.0f) + EPS);
          u32x2 w; w.x = cvt_pk_bf16(v[0] * r, v[1] * r); w.y = cvt_pk_bf16(v[2] * r, v[3] * r); *(u32x2*)(WSP(bf16_t, WS_CKV) + (size_t)t * 256 + 4 * lane) = w; }
        { const f32x4 v0 = *(const f32x4*)(row + 512 + 8 * lane), v1 = *(const f32x4*)(row + 512 + 8 * lane + 4);
          const float r = 1.0f * __builtin_amdgcn_rsqf(wave_sum((v0[0] * v0[0] + v0[1] * v0[1]) + (v0[2] * v0[2] + v0[3] * v0[3]) + (v1[0] * v1[0] + v1[1] * v1[1]) + (v1[2] * v1[2] + v1[3] * v1[3])) * (1.0f / 512.0f) + EPS);
          u32x4 w; w.x = cvt_pk_bf16(v0[0] * r, v0[1] * r); w.y = cvt_pk_bf16(v0[2] * r, v0[3] * r); w.z = cvt_pk_bf16(v1[0] * r, v1[1] * r); w.w = cvt_pk_bf16(v1[2] * r, v1[3] * r);
          *(u32x4*)(WSP(bf16_t, WS_CQ) + (size_t)t * 512 + 8 * lane) = w; }
        { const f32x4 v0 = *(const f32x4*)(row + 1024 + 8 * lane), v1 = *(const f32x4*)(row + 1024 + 8 * lane + 4);
          float ss = (v0[0] * v0[0] + v0[1] * v0[1]) + (v0[2] * v0[2] + v0[3] * v0[3]) + (v1[0] * v1[0] + v1[1] * v1[1]) + (v1[2] * v1[2] + v1[3] * v1[3]);
          ss = row16_sum(ss);
          const float r = CMEM * __builtin_amdgcn_rsqf(ss * (1.0f / 128.0f) + EPS); const int h = lane >> 4, d = (lane & 15) * 8;
          const f32x4 g0 = *(const f32x4*)(g_mq1 + d), g1 = *(const f32x4*)(g_mq1 + d + 4);
          u32x4 w; w.x = cvt_pk_bf16(v0[0] * r * g0[0], v0[1] * r * g0[1]); w.y = cvt_pk_bf16(v0[2] * r * g0[2], v0[3] * r * g0[3]); w.z = cvt_pk_bf16(v1[0] * r * g1[0], v1[1] * r * g1[1]); w.w = cvt_pk_bf16(v1[2] * r * g1[2], v1[3] * r * g1[3]);
          *(u32x4*)(WSP(bf16_t, WS_QM) + ((size_t)(b * 4 + h) * SEQ + s) * 128 + d) = w; }
    }
}
struct EpiFp8Plain {
    static constexpr bool PERM = true, AFTER_DRAIN = false;
    unsigned char* O; int ldc;
    __device__ __forceinline__ void operator()(const f32x4 (&acc)[2][2][4][2], const pg8::Unit& u, int wr, int wc, int fr, int fq) const {
        using pg8::BM; using pg8::HALF;
        const int row0 = u.pm * BM + wr * 64 + fr, col0 = u.pn * BM + wc * 32 + 8 * fq;
#pragma unroll
        for (int ai = 0; ai < 2; ++ai)
#pragma unroll
            for (int m = 0; m < 4; ++m) { unsigned char* rowp = O + (size_t)(row0 + ai * HALF + m * 16) * ldc + col0;
#pragma unroll
                for (int bj = 0; bj < 2; ++bj) { const f32x4 v0 = acc[ai][bj][m][0], v1 = acc[ai][bj][m][1];
                    u32x2 w; w.x = pk4_fp8(v0[0], v0[1], v0[2], v0[3]); w.y = pk4_fp8(v1[0], v1[1], v1[2], v1[3]);
                    *(u32x2*)(rowp + bj * HALF) = w; } }
    }
};
struct EpiMemKFinal {
    static constexpr bool PERM = true, AFTER_DRAIN = false;
    bf16_t* KF; const float* g_mk; LAS float* P;
    __device__ __forceinline__ void operator()(const f32x4 (&acc)[2][2][4][2], const pg8::Unit& u, int wr, int wc, int fr, int fq) const {
        using pg8::HALF;
#pragma unroll
        for (int ai = 0; ai < 2; ++ai)
#pragma unroll
            for (int m = 0; m < 4; ++m) { const int rl = ai * HALF + wr * 64 + m * 16 + fr;
#pragma unroll
                for (int bj = 0; bj < 2; ++bj) { const f32x4 a = acc[ai][bj][m][0], b = acc[ai][bj][m][1];
                    float s = (a[0] * a[0] + a[1] * a[1]) + (a[2] * a[2] + a[3] * a[3]) + (b[0] * b[0] + b[1] * b[1]) + (b[2] * b[2] + b[3] * b[3]);
                    s = rows4_sum(s);
                    if (fq == 0) P[(rl * 2 + bj) * 4 + wc] = s; } }
        asm volatile("s_waitcnt lgkmcnt(0)" ::: "memory"); __builtin_amdgcn_s_barrier(); asm volatile("" ::: "memory");
        const int cl = wc * 32 + 8 * fq, ly = u.pn >> 1;
        const f32x4 gk0 = *(const f32x4*)(g_mk + ly * 128 + cl), gk1 = *(const f32x4*)(g_mk + ly * 128 + cl + 4);
#pragma unroll
        for (int ai = 0; ai < 2; ++ai)
#pragma unroll
            for (int m = 0; m < 4; ++m) { const int rl = ai * HALF + wr * 64 + m * 16 + fr;
#pragma unroll
                for (int bj = 0; bj < 2; ++bj) { const int h = 2 * (u.pn & 1) + bj; const f32x4 p4 = *(const LAS f32x4*)(P + (rl * 2 + bj) * 4);
                    const float r = __builtin_amdgcn_rsqf(((p4[0] + p4[1]) + (p4[2] + p4[3])) * (1.0f / 128.0f) + EPS);
                    const f32x4 v0 = acc[ai][bj][m][0] * r * gk0, v1 = acc[ai][bj][m][1] * r * gk1;
                    u32x4 w; w.x = cvt_pk_bf16(v0[0], v0[1]); w.y = cvt_pk_bf16(v0[2], v0[3]); w.z = cvt_pk_bf16(v1[0], v1[1]); w.w = cvt_pk_bf16(v1[2], v1[3]);
                    *(u32x4*)(KF + ((size_t)((ly * 2 + u.pm) * 4 + h) * 256 + rl) * 128 + cl) = w; } }
    }
};
struct EpiKnFinal {
    static constexpr bool PERM = true, AFTER_DRAIN = false;
    bf16_t* KF; const float* kpe; const float* kss; const int* positions; const float* g_kn; LAS float* P;
    __device__ __forceinline__ void operator()(const f32x4 (&acc)[2][2][4][2], const pg8::Unit& u, int wr, int wc, int fr, int fq) const {
        using pg8::BM; using pg8::HALF;
#pragma unroll
        for (int ai = 0; ai < 2; ++ai)
#pragma unroll
            for (int m = 0; m < 4; ++m) { const int rl = ai * HALF + wr * 64 + m * 16 + fr;
#pragma unroll
                for (int bj = 0; bj < 2; ++bj) { const f32x4 a = acc[ai][bj][m][0], b = acc[ai][bj][m][1];
                    float s = (a[0] * a[0] + a[1] * a[1]) + (a[2] * a[2] + a[3] * a[3]) + (b[0] * b[0] + b[1] * b[1]) + (b[2] * b[2] + b[3] * b[3]);
                    s = rows4_sum(s);
                    if (fq == 0) P[(rl * 2 + bj) * 4 + wc] = s; } }
        asm volatile("s_waitcnt lgkmcnt(0)" ::: "memory"); __builtin_amdgcn_s_barrier(); asm volatile("" ::: "memory");
        const int cl = wc * 32 + 8 * fq, i0 = 8 * wc + 2 * fq;
        const f32x4 gk0 = *(const f32x4*)(g_kn + cl), gk1 = *(const f32x4*)(g_kn + cl + 4);
        const float glo0 = g_kn[128 + i0], glo1 = g_kn[128 + i0 + 1], ghi0 = g_kn[160 + i0], ghi1 = g_kn[160 + i0 + 1];
        const double if0 = INVF_REV[i0], if1 = INVF_REV[i0 + 1];
#pragma unroll
        for (int ai = 0; ai < 2; ++ai)
#pragma unroll
            for (int m = 0; m < 4; ++m) { const int rl = ai * HALF + wr * 64 + m * 16 + fr, row = u.pm * BM + rl, b = row >> 12, sq = row & (SEQ - 1);
                const float kssv = kss[row]; const double pos = (double)positions[row];
                typedef float f32x2_t __attribute__((ext_vector_type(2)));
                const f32x2_t klo = *(const f32x2_t*)(kpe + (size_t)row * 64 + i0), khi = *(const f32x2_t*)(kpe + (size_t)row * 64 + 32 + i0);
                const double r0 = pos * if0, r1 = pos * if1; const float f0 = (float)(r0 - __builtin_rint(r0)), f1 = (float)(r1 - __builtin_rint(r1));
                const float cs0 = __builtin_amdgcn_cosf(f0), sn0 = __builtin_amdgcn_sinf(f0), cs1 = __builtin_amdgcn_cosf(f1), sn1 = __builtin_amdgcn_sinf(f1);
#pragma unroll
                for (int bj = 0; bj < 2; ++bj) { const int h = 2 * u.pn + bj; const f32x4 p4 = *(const LAS f32x4*)(P + (rl * 2 + bj) * 4);
                    const float r = __builtin_amdgcn_rsqf(((p4[0] + p4[1]) + (p4[2] + p4[3]) + kssv) * (1.0f / 192.0f) + EPS);
                    unsigned char* dst = (unsigned char*)KF + ((size_t)(b * 12 + h) * SEQ + sq) * 192;
                    const f32x4 v0 = acc[ai][bj][m][0] * r * gk0, v1 = acc[ai][bj][m][1] * r * gk1;
                    u32x2 w; w.x = pk4_fp8(v0[0], v0[1], v0[2], v0[3]); w.y = pk4_fp8(v1[0], v1[1], v1[2], v1[3]);
                    *(u32x2*)(dst + cl) = w;
                    const float yl0 = klo[0] * r * glo0, yl1 = klo[1] * r * glo1, yh0 = khi[0] * r * ghi0, yh1 = khi[1] * r * ghi1;
                    *(unsigned short*)(dst + 128 + i0) = (unsigned short)__builtin_amdgcn_cvt_pk_fp8_f32(yl0 * cs0 - yh0 * sn0, yl1 * cs1 - yh1 * sn1, 0, false);
                    *(unsigned short*)(dst + 160 + i0) = (unsigned short)__builtin_amdgcn_cvt_pk_fp8_f32(yh0 * cs0 + yl0 * sn0, yh1 * cs1 + yl1 * sn1, 0, false); } }
    }
};
constexpr int AT_KROW = 400, AT_VROW = 144, AT_KBYTES = 64 * AT_KROW, AT_STAGE = AT_KBYTES + 128 * AT_VROW;
static_assert(AT_KBYTES == 25 * 1024 && AT_STAGE == 43 * 1024 && 3 * AT_STAGE <= LDSCTL_OFF && RSTAB_OFF + 1024 <= LDS_BYTES, "attention LDS stages");
__device__ __forceinline__ void causal_wg_unit(Frame& F, int bh, int QB) {
    const int lane = lane_now(), w = F.wave, r32 = lane & 31, hi = lane >> 5, b = bh / 12, h = bh % 12;
    const bf16_t* Qp = WSP(bf16_t, WS_QF) + ((size_t)bh * SEQ + QB * 256 + w * 32) * 192;
    const char* Kg = (const char*)(WSP(bf16_t, WS_KF) + (size_t)bh * SEQ * 192);
    const char* Vg = (const char*)(WSP(bf16_t, WS_VT) + (size_t)(h * 128) * NTOK + b * SEQ);
    unsigned goff[6];
#pragma unroll
    for (int i = 0; i < 6; ++i) { const int j = w + 8 * i;
        if (j < 25) { const int q = j * 64 + lane, row = q / 25, c = q % 25; goff[i] = (unsigned)(row * 384 + (c < 24 ? c : 23) * 16); }
        else { const int q = (j - 25) * 64 + lane, d = q / 9, c = q % 9; goff[i] = (unsigned)(d * (NTOK * 2) + (c < 8 ? c : 7) * 16); } }
    bf16x8 qf[12];
    {
      const int tq = b * SEQ + QB * 256 + w * 32 + r32;
      const bf16_t* qrow = WSP(bf16_t, WS_QRAW) + (size_t)tq * 2304 + h * 192 + hi * 8; const float* g_qn = inp(F, 15);
      u32x4 raw[12];
#pragma unroll
      for (int d0 = 0; d0 < 12; ++d0) raw[d0] = *(const u32x4*)(qrow + d0 * 16);
      const float* sq2 = WSP(float, WS_SSQQ) + 2 * tq; const float rq = __builtin_amdgcn_rsqf((sq2[0] + sq2[1]) * (1.0f / 512.0f) + EPS);
      const double pos = (double)((const int*)inp(F, 2))[tq];
      float ss = 0.f;
#pragma unroll
      for (int d0 = 0; d0 < 12; ++d0) { float a[8]; unpack8(raw[d0], a);
#pragma unroll
          for (int e = 0; e < 8; ++e) ss += a[e] * a[e]; }
      ss += other_half(ss, lane);
      const float r = CMLA * rq * __builtin_amdgcn_rsqf(ss * rq * rq * (1.0f / 192.0f) + EPS);
#pragma unroll
      for (int d0 = 0; d0 < 8; ++d0) { float a[8]; unpack8(raw[d0], a); const f32x4 g0 = *(const f32x4*)(g_qn + d0 * 16 + hi * 8), g1 = *(const f32x4*)(g_qn + d0 * 16 + hi * 8 + 4);
          u32x4 wv; wv.x = cvt_pk_bf16(a[0] * r * g0[0], a[1] * r * g0[1]); wv.y = cvt_pk_bf16(a[2] * r * g0[2], a[3] * r * g0[3]); wv.z = cvt_pk_bf16(a[4] * r * g1[0], a[5] * r * g1[1]); wv.w = cvt_pk_bf16(a[6] * r * g1[2], a[7] * r * g1[3]);
          qf[d0] = __builtin_bit_cast(bf16x8, wv); }
#pragma unroll
      for (int dd = 0; dd < 2; ++dd) { float lo[8], hv[8], ol[8], oh[8]; unpack8(raw[8 + dd], lo); unpack8(raw[10 + dd], hv); const int i0 = dd * 16 + hi * 8;
#pragma unroll
          for (int e = 0; e < 8; ++e) { const double rev = pos * INVF_REV[i0 + e]; const float fr = (float)(rev - __builtin_rint(rev)); const float cs = __builtin_amdgcn_cosf(fr), sn = __builtin_amdgcn_sinf(fr);
              const float yl = lo[e] * r * g_qn[128 + i0 + e], yh = hv[e] * r * g_qn[160 + i0 + e]; ol[e] = yl * cs - yh * sn; oh[e] = yh * cs + yl * sn; }
          u32x4 wl, wh; wl.x = cvt_pk_bf16(ol[0], ol[1]); wl.y = cvt_pk_bf16(ol[2], ol[3]); wl.z = cvt_pk_bf16(ol[4], ol[5]); wl.w = cvt_pk_bf16(ol[6], ol[7]);
          wh.x = cvt_pk_bf16(oh[0], oh[1]); wh.y = cvt_pk_bf16(oh[2], oh[3]); wh.z = cvt_pk_bf16(oh[4], oh[5]); wh.w = cvt_pk_bf16(oh[6], oh[7]);
          qf[8 + dd] = __builtin_bit_cast(bf16x8, wl); qf[10 + dd] = __builtin_bit_cast(bf16x8, wh); } }
    f32x16 o[4], negm; float l = 0.f;
#pragma unroll
    for (int r = 0; r < 16; ++r) negm[r] = 0.f;
#pragma unroll
    for (int db = 0; db < 4; ++db)
#pragma unroll
        for (int r = 0; r < 16; ++r) o[db][r] = 0.f;
    const int ntiles = 4 * QB + 4;
    LAS unsigned char* lds = F.lds;
#define AT_DMA(t_, st_) do { _Pragma("unroll") for (int i_ = 0; i_ < 6; ++i_) { const int j_ = w + 8 * i_; if (j_ < 43) { \
        const char* g_ = (j_ < 25 ? Kg + (size_t)(t_) * (64 * 384) : Vg + (size_t)(t_) * 128) + goff[i_]; \
        __builtin_amdgcn_global_load_lds((const unsigned*)g_, (LAS unsigned*)(lds + (st_) * AT_STAGE + j_ * 1024), 16, 0, 0); } } } while (0)
    asm volatile("s_waitcnt lgkmcnt(0)" ::: "memory"); __builtin_amdgcn_s_barrier(); asm volatile("" ::: "memory");
    AT_DMA(0, 0); AT_DMA(1, 1);
    const int kb0 = r32 * AT_KROW + hi * 16, vb0 = AT_KBYTES + r32 * AT_VROW + hi * 16;
    const bool np6 = w < 3;
    for (int t = 0; t < ntiles; ++t) {
        if (t + 1 < ntiles) { if (np6) asm volatile("s_waitcnt vmcnt(6)" ::: "memory"); else asm volatile("s_waitcnt vmcnt(5)" ::: "memory"); }
        else asm volatile("s_waitcnt vmcnt(0)" ::: "memory");
        __builtin_amdgcn_s_barrier(); asm volatile("" ::: "memory");
        if (t + 2 < ntiles) AT_DMA(t + 2, (t + 2) % 3);
        const int tp = t - 4 * QB;
        if (tp >= 0 && 2 * tp > w) continue;
        const int so = (t % 3) * AT_STAGE;
        const bool act1 = tp < 0 || 2 * tp + 1 <= w;
        f32x16 p0 = negm, p1 = negm;
        { const LAS unsigned char* kp = lds + so + kb0; bf16x8 ka[6], kb[6];
#define AT_KLD(dst, st, base) do { _Pragma("unroll") for (int i_ = 0; i_ < 6; ++i_) dst[i_] = *(const LAS bf16x8*)(kp + (st) * 32 * AT_KROW + ((base) + i_) * 32); } while (0)
          AT_KLD(ka, 0, 0); AT_KLD(kb, 0, 6); __builtin_amdgcn_sched_barrier(0); __builtin_amdgcn_s_setprio(1);
#pragma unroll
          for (int i = 0; i < 6; ++i) p0 = __builtin_amdgcn_mfma_f32_32x32x16_bf16(ka[i], qf[i], p0, 0, 0, 0);
          __builtin_amdgcn_sched_barrier(0); AT_KLD(ka, 1, 0); __builtin_amdgcn_sched_barrier(0);
#pragma unroll
          for (int i = 0; i < 6; ++i) p0 = __builtin_amdgcn_mfma_f32_32x32x16_bf16(kb[i], qf[6 + i], p0, 0, 0, 0);
          __builtin_amdgcn_sched_barrier(0); AT_KLD(kb, 1, 6); __builtin_amdgcn_sched_barrier(0);
#pragma unroll
          for (int i = 0; i < 6; ++i) p1 = __builtin_amdgcn_mfma_f32_32x32x16_bf16(ka[i], qf[i], p1, 0, 0, 0);
          __builtin_amdgcn_sched_barrier(0);
#pragma unroll
          for (int i = 0; i < 6; ++i) p1 = __builtin_amdgcn_mfma_f32_32x32x16_bf16(kb[i], qf[6 + i], p1, 0, 0, 0);
          __builtin_amdgcn_s_setprio(0);
#undef AT_KLD
        }
        bf16x8 vf[2][4], vg[2][4];
        const LAS unsigned char* vp = lds + so + vb0;
#pragma unroll
        for (int ks = 0; ks < 2; ++ks)
#pragma unroll
            for (int db = 0; db < 4; ++db) vf[ks][db] = *(const LAS bf16x8*)(vp + db * 32 * AT_VROW + ks * 32);
        __builtin_amdgcn_sched_barrier(0);
        if (tp >= 0) {
            if (2 * tp == w) {
#pragma unroll
                for (int r = 0; r < 16; ++r) if (crow(r, hi) > r32) p0[r] = -__builtin_inff(); }
            if (!act1) {
#pragma unroll
                for (int r = 0; r < 16; ++r) p1[r] = -__builtin_inff(); }
            else if (2 * tp + 1 == w) {
#pragma unroll
                for (int r = 0; r < 16; ++r) if (crow(r, hi) > r32) p1[r] = -__builtin_inff(); }
        }
        float pm = max3f(p0[0], p1[0], p0[1]);
        pm = max3f(pm, p1[1], p0[2]);
#pragma unroll
        for (int r = 2; r < 15; ++r) pm = max3f(pm, p1[r], p0[r + 1]);
        pm = max3f(pm, p1[15], pm);
        pm = half_max(pm);
        if (!__all(pm <= 8.0f)) {
            const float d = fmaxf(pm, 0.f), alpha = __builtin_amdgcn_exp2f(-d);
#pragma unroll
            for (int r = 0; r < 16; ++r) { p0[r] -= d; p1[r] -= d; negm[r] -= d; }
            l *= alpha;
#pragma unroll
            for (int db = 0; db < 4; ++db)
#pragma unroll
                for (int r = 0; r < 16; ++r) o[db][r] *= alpha;
        }
#pragma unroll
        for (int r = 0; r < 16; ++r) { p0[r] = __builtin_amdgcn_exp2f(p0[r]); p1[r] = __builtin_amdgcn_exp2f(p1[r]); }
        { typedef float f32x2 __attribute__((ext_vector_type(2))); f32x2 s2 = {0.f, 0.f};
#pragma unroll
          for (int r = 0; r < 16; r += 2) { s2 += (f32x2){p0[r], p0[r + 1]}; s2 += (f32x2){p1[r], p1[r + 1]}; }
          l += half_sum(s2[0] + s2[1]); }
        bf16x8 pa[4];
#define AT_PK(P, B_, OUT) do { const unsigned a0_ = cvt_pk_bf16(P[B_ + 0], P[B_ + 1]), a1_ = cvt_pk_bf16(P[B_ + 2], P[B_ + 3]), b0_ = cvt_pk_bf16(P[B_ + 4], P[B_ + 5]), b1_ = cvt_pk_bf16(P[B_ + 6], P[B_ + 7]); \
        auto r0_ = __builtin_amdgcn_permlane32_swap(a0_, b0_, false, false); auto r1_ = __builtin_amdgcn_permlane32_swap(a1_, b1_, false, false); \
        u32x4 w_ = {r0_[0], r1_[0], r0_[1], r1_[1]}; OUT = __builtin_bit_cast(bf16x8, w_); } while (0)
        AT_PK(p0, 0, pa[0]); AT_PK(p0, 8, pa[1]); AT_PK(p1, 0, pa[2]); AT_PK(p1, 8, pa[3]);
        __builtin_amdgcn_sched_barrier(0);
#pragma unroll
        for (int ks = 0; ks < 2; ++ks)
#pragma unroll
            for (int db = 0; db < 4; ++db) vg[ks][db] = *(const LAS bf16x8*)(vp + db * 32 * AT_VROW + (2 + ks) * 32);
        __builtin_amdgcn_sched_barrier(0); __builtin_amdgcn_s_setprio(1);
#pragma unroll
        for (int ks = 0; ks < 2; ++ks)
#pragma unroll
            for (int db = 0; db < 4; ++db) o[db] = __builtin_amdgcn_mfma_f32_32x32x16_bf16(vf[ks][db], pa[ks], o[db], 0, 0, 0);
        __builtin_amdgcn_sched_barrier(0);
#pragma unroll
        for (int ks = 0; ks < 2; ++ks)
#pragma unroll
            for (int db = 0; db < 4; ++db) o[db] = __builtin_amdgcn_mfma_f32_32x32x16_bf16(vg[ks][db], pa[2 + ks], o[db], 0, 0, 0);
        __builtin_amdgcn_s_setprio(0);
    }
#undef AT_PK
#undef AT_DMA
    const float inv = 16.0f / l;
    unsigned char* orow = F.ws + WS_CAT + (size_t)(b * SEQ + QB * 256 + w * 32 + r32) * DM + h * 128 + 4 * hi;
#pragma unroll
    for (int db = 0; db < 4; ++db)
#pragma unroll
        for (int g = 0; g < 4; ++g) *(unsigned*)(orow + db * 32 + 8 * g) = pk4_fp8(o[db][4 * g] * inv, o[db][4 * g + 1] * inv, o[db][4 * g + 2] * inv, o[db][4 * g + 3] * inv);
}
constexpr int A8_KROW = 208, A8_VROW = 80, A8_KBYTES = 64 * A8_KROW, A8_STAGE = A8_KBYTES + 128 * A8_VROW;
static_assert(A8_KBYTES == 13 * 1024 && A8_STAGE == 23 * 1024 && 3 * A8_STAGE <= LDSCTL_OFF, "fp8 attention LDS stages");
typedef int v8i_t __attribute__((ext_vector_type(8)));
__device__ __forceinline__ void causal_wg_unit8(Frame& F, int bh, int QB) {
    const int lane = lane_now(), w = F.wave, r32 = lane & 31, hi = lane >> 5, b = bh / 12, h = bh % 12;
    const char* Kg = (const char*)(F.ws + WS_KF) + (size_t)bh * SEQ * 192;
    const char* Vg = (const char*)(F.ws + WS_VT) + (size_t)(h * 128) * NTOK + b * SEQ;
    unsigned goff[3];
#pragma unroll
    for (int i = 0; i < 3; ++i) { const int j = w + 8 * i;
        if (j < 13) { const int q = j * 64 + lane, row = q / 13, c = q % 13; goff[i] = (unsigned)(row * 192 + (c < 12 ? c : 11) * 16); }
        else { const int q = (j - 13) * 64 + lane, d = q / 5, c = q % 5; goff[i] = (unsigned)(d * NTOK + (c < 4 ? c : 3) * 16); } }
    const int ntiles = 4 * QB + 4;
    LAS unsigned char* lds = F.lds;
#define A8_DMA(t_, st_) do { _Pragma("unroll") for (int i_ = 0; i_ < 3; ++i_) { const int j_ = w + 8 * i_; if (j_ < 23) { \
        const char* g_ = (j_ < 13 ? Kg + (size_t)(t_) * (64 * 192) : Vg + (size_t)(t_) * 64) + goff[i_]; \
        __builtin_amdgcn_global_load_lds((const unsigned*)g_, (LAS unsigned*)(lds + (st_) * A8_STAGE + j_ * 1024), 16, 0, 0); } } } while (0)
    v8i_t qf8[3];
    {
      const int tq = b * SEQ + QB * 256 + w * 32 + r32;
      const bf16_t* qrow = WSP(bf16_t, WS_QRAW) + (size_t)tq * 2304 + h * 192 + hi * 32; const float* g_qn = inp(F, 15);
      u32x4 raw[3][4];
#pragma unroll
      for (int c = 0; c < 3; ++c)
#pragma unroll
          for (int k = 0; k < 4; ++k) raw[c][k] = *(const u32x4*)(qrow + c * 64 + k * 8);
      const float* sq2 = WSP(float, WS_SSQQ) + 2 * tq; const float sqa = sq2[0], sqb = sq2[1]; const int posi = ((const int*)inp(F, 2))[tq];
      __builtin_amdgcn_sched_barrier(0);
      asm volatile("s_waitcnt lgkmcnt(0)" ::: "memory"); __builtin_amdgcn_s_barrier(); asm volatile("" ::: "memory");
      A8_DMA(0, 0); A8_DMA(1, 1);
      __builtin_amdgcn_sched_barrier(0);
      const float rq = __builtin_amdgcn_rsqf((sqa + sqb) * (1.0f / 512.0f) + EPS); const double pos = (double)posi;
      float ss = 0.f;
#pragma unroll
      for (int c = 0; c < 3; ++c)
#pragma unroll
          for (int k = 0; k < 4; ++k) { float a[8]; unpack8(raw[c][k], a);
#pragma unroll
              for (int e = 0; e < 8; ++e) ss += a[e] * a[e]; }
      ss += other_half(ss, lane);
      const float r = 16.0f * CMLA * rq * __builtin_amdgcn_rsqf(ss * rq * rq * (1.0f / 192.0f) + EPS);
#pragma unroll
      for (int c = 0; c < 2; ++c)
#pragma unroll
          for (int k = 0; k < 4; ++k) { float a[8]; unpack8(raw[c][k], a); const f32x4 g0 = *(const f32x4*)(g_qn + c * 64 + hi * 32 + k * 8), g1 = *(const f32x4*)(g_qn + c * 64 + hi * 32 + k * 8 + 4);
              qf8[c][2 * k] = (int)pk4_fp8(a[0] * r * g0[0], a[1] * r * g0[1], a[2] * r * g0[2], a[3] * r * g0[3]); qf8[c][2 * k + 1] = (int)pk4_fp8(a[4] * r * g1[0], a[5] * r * g1[1], a[6] * r * g1[2], a[7] * r * g1[3]); }
#pragma unroll
      for (int k = 0; k < 4; ++k) { float a[8], ov[8]; unpack8(raw[2][k], a);
#pragma unroll
          for (int e = 0; e < 8; ++e) { const int i = 8 * k + e;
              const double rev = pos * INVF_REV[i]; const float fr = (float)(rev - __builtin_rint(rev)); const float cs = __builtin_amdgcn_cosf(fr), sn = __builtin_amdgcn_sinf(fr);
              const float y = a[e] * r * g_qn[128 + hi * 32 + i], yo = other_half(y, lane); ov[e] = hi ? y * cs + yo * sn : y * cs - yo * sn; }
          qf8[2][2 * k] = (int)pk4_fp8(ov[0], ov[1], ov[2], ov[3]); qf8[2][2 * k + 1] = (int)pk4_fp8(ov[4], ov[5], ov[6], ov[7]); } }
    f32x16 o[4], negm; float l = 0.f;
#pragma unroll
    for (int r = 0; r < 16; ++r) negm[r] = 0.f;
#pragma unroll
    for (int db = 0; db < 4; ++db)
#pragma unroll
        for (int r = 0; r < 16; ++r) o[db][r] = 0.f;
    const int kb0 = r32 * A8_KROW + hi * 32, vb0 = A8_KBYTES + r32 * A8_VROW + hi * 16;
    const bool np3 = w < 7;
    constexpr int S1 = 0x7f7f7f7f, SQ = 0x7b7b7b7b;
    typedef int v4i_l __attribute__((ext_vector_type(4)));
#define A8_LD32(ptr) __builtin_shufflevector(*(const LAS v4i_l*)(ptr), *(const LAS v4i_l*)((ptr) + 16), 0, 1, 2, 3, 4, 5, 6, 7)
    for (int t = 0; t < ntiles; ++t) {
        if (t + 1 < ntiles) { if (np3) asm volatile("s_waitcnt vmcnt(3)" ::: "memory"); else asm volatile("s_waitcnt vmcnt(2)" ::: "memory"); }
        else asm volatile("s_waitcnt vmcnt(0)" ::: "memory");
        __builtin_amdgcn_s_barrier(); asm volatile("" ::: "memory");
        if (t + 2 < ntiles) A8_DMA(t + 2, (t + 2) % 3);
        const int tp = t - 4 * QB;
        if (tp >= 0 && 2 * tp > w) continue;
        const int so = (t % 3) * A8_STAGE;
        const bool act1 = tp < 0 || 2 * tp + 1 <= w;
        f32x16 p0 = negm, p1 = negm;
        { const LAS unsigned char* kp = lds + so + kb0; v8i_t k0f[3], k1f[3];
#pragma unroll
          for (int c = 0; c < 3; ++c) k0f[c] = A8_LD32(kp + c * 64);
#pragma unroll
          for (int c = 0; c < 3; ++c) k1f[c] = A8_LD32(kp + 32 * A8_KROW + c * 64);
          __builtin_amdgcn_sched_barrier(0); __builtin_amdgcn_s_setprio(1);
#pragma unroll
          for (int c = 0; c < 3; ++c) p0 = __builtin_amdgcn_mfma_scale_f32_32x32x64_f8f6f4(k0f[c], qf8[c], p0, 0, 0, 0, S1, 0, SQ);
#pragma unroll
          for (int c = 0; c < 3; ++c) p1 = __builtin_amdgcn_mfma_scale_f32_32x32x64_f8f6f4(k1f[c], qf8[c], p1, 0, 0, 0, S1, 0, SQ);
          __builtin_amdgcn_s_setprio(0); }
        v8i_t vf[4];
        { const LAS unsigned char* vp = lds + so + vb0;
#pragma unroll
          for (int db = 0; db < 4; ++db) { const LAS unsigned char* q = vp + db * 32 * A8_VROW; vf[db] = __builtin_shufflevector(*(const LAS v4i_l*)q, *(const LAS v4i_l*)(q + 32), 0, 1, 2, 3, 4, 5, 6, 7); } }
        __builtin_amdgcn_sched_barrier(0);
        if (tp >= 0) {
            if (2 * tp == w) {
#pragma unroll
                for (int r = 0; r < 16; ++r) if (crow(r, hi) > r32) p0[r] = -__builtin_inff(); }
            if (!act1) {
#pragma unroll
                for (int r = 0; r < 16; ++r) p1[r] = -__builtin_inff(); }
            else if (2 * tp + 1 == w) {
#pragma unroll
                for (int r = 0; r < 16; ++r) if (crow(r, hi) > r32) p1[r] = -__builtin_inff(); }
        }
        float pm = max3f(p0[0], p1[0], p0[1]);
        pm = max3f(pm, p1[1], p0[2]);
#pragma unroll
        for (int r = 2; r < 15; ++r) pm = max3f(pm, p1[r], p0[r + 1]);
        pm = max3f(pm, p1[15], pm);
        pm = half_max(pm);
        if (!__all(pm <= 8.0f)) {
            const float d = fmaxf(pm, 0.f), alpha = __builtin_amdgcn_exp2f(-d);
#pragma unroll
            for (int r = 0; r < 16; ++r) { p0[r] -= d; p1[r] -= d; negm[r] -= d; }
            l *= alpha;
#pragma unroll
            for (int db = 0; db < 4; ++db)
#pragma unroll
                for (int r = 0; r < 16; ++r) o[db][r] *= alpha;
        }
#pragma unroll
        for (int r = 0; r < 16; ++r) { p0[r] = __builtin_amdgcn_exp2f(p0[r]); p1[r] = __builtin_amdgcn_exp2f(p1[r]); }
        { typedef float f32x2 __attribute__((ext_vector_type(2))); f32x2 s2 = {0.f, 0.f};
#pragma unroll
          for (int r = 0; r < 16; r += 2) { s2 += (f32x2){p0[r], p0[r + 1]}; s2 += (f32x2){p1[r], p1[r + 1]}; }
          l += half_sum(s2[0] + s2[1]); }
        v8i_t pb;
#define A8_PK(P, B_) do { const unsigned d0_ = pk4_fp8(P[0], P[1], P[2], P[3]), d1_ = pk4_fp8(P[4], P[5], P[6], P[7]), d2_ = pk4_fp8(P[8], P[9], P[10], P[11]), d3_ = pk4_fp8(P[12], P[13], P[14], P[15]); \
        auto r02_ = __builtin_amdgcn_permlane32_swap(d0_, d2_, false, false); auto r13_ = __builtin_amdgcn_permlane32_swap(d1_, d3_, false, false); \
        pb[B_ + 0] = (int)r02_[0]; pb[B_ + 1] = (int)r02_[1]; pb[B_ + 2] = (int)r13_[0]; pb[B_ + 3] = (int)r13_[1]; } while (0)
        A8_PK(p0, 0); A8_PK(p1, 4);
        __builtin_amdgcn_sched_barrier(0); __builtin_amdgcn_s_setprio(1);
#pragma unroll
        for (int db = 0; db < 4; ++db) o[db] = __builtin_amdgcn_mfma_scale_f32_32x32x64_f8f6f4(vf[db], pb, o[db], 0, 0, 0, S1, 0, S1);
        __builtin_amdgcn_s_setprio(0);
    }
#undef A8_PK
#undef A8_LD32
#undef A8_DMA
    const float inv = 16.0f / l;
    unsigned char* orow = F.ws + WS_CAT + (size_t)(b * SEQ + QB * 256 + w * 32 + r32) * DM + h * 128 + 4 * hi;
#pragma unroll
    for (int db = 0; db < 4; ++db)
#pragma unroll
        for (int g = 0; g < 4; ++g) *(unsigned*)(orow + db * 32 + 8 * g) = pk4_fp8(o[db][4 * g] * inv, o[db][4 * g + 1] * inv, o[db][4 * g + 2] * inv, o[db][4 * g + 3] * inv);
}
__device__ __forceinline__ void p11_attention(Frame& F) {
    const int xcd = F.vcu >> 5, j = F.vcu & 31;
    causal_wg_unit8(F, 3 * xcd + j % 3, 15 - j / 3);
    if (j >= 16) { const int v = 63 - j; causal_wg_unit8(F, 3 * xcd + v % 3, 15 - v / 3);
        mem_attn_unit(F, 1, ((xcd * 16 + (j - 16)) * 8 + F.wave)); }
    asm volatile("s_waitcnt vmcnt(0) lgkmcnt(0)" ::: "memory"); __builtin_amdgcn_s_barrier(); asm volatile("" ::: "memory");
}

__device__ __forceinline__ void p11_router(Frame& F) {
    const int lane = lane_now(), wg = blockIdx.x, tid = F.wave * 64 + lane;
    const bf16_t* X3 = WSP(bf16_t, WS_XB); const float* WR = WSP(float, WS_WR);
    int* tok_e = (int*)(F.ws + WS_META + MT_TOKE); float* tok_w = (float*)(F.ws + WS_META + MT_TOKW); float* tok_r = (float*)(F.ws + WS_META + MT_TOKR); int* cnt = (int*)(F.ws + WS_META + MT_CNT);
    LAS int* le = (LAS int*)F.lds;
    f32x4 v[4][8]; float r[4], l1[4], l2[4]; int i1[4], i2[4];
#pragma unroll
    for (int j = 0; j < 4; ++j) { const int t = wg * 32 + F.wave * 4 + j; const u32x2* xr = (const u32x2*)(X3 + (size_t)t * DM) + lane; float s = 0.f;
#pragma unroll
        for (int q = 0; q < 8; ++q) { const u32x2 w = xr[64 * q]; v[j][q] = (f32x4){bf_lo(w.x), bf_hi(w.x), bf_lo(w.y), bf_hi(w.y)}; s += (v[j][q][0] * v[j][q][0] + v[j][q][1] * v[j][q][1]) + (v[j][q][2] * v[j][q][2] + v[j][q][3] * v[j][q][3]); }
        r[j] = s; l1[j] = -__builtin_inff(); l2[j] = -__builtin_inff(); i1[j] = -1; i2[j] = -1; }
#pragma unroll
    for (int j = 0; j < 4; ++j) r[j] = wave_sum(r[j]);
#pragma unroll
    for (int j = 0; j < 4; ++j) r[j] = 1.0f * __builtin_amdgcn_rsqf(r[j] * (1.0f / 2048.0f) + EPS);
    f32x4 wn[8];
#pragma unroll
    for (int q = 0; q < 8; ++q) wn[q] = ((const f32x4*)WR + lane)[64 * q];
#pragma unroll 1
    for (int e = 0; e < 8; ++e) { f32x4 w[8]; float d[4];
#pragma unroll
        for (int q = 0; q < 8; ++q) w[q] = wn[q];
        { const f32x4* wr = (const f32x4*)(WR + (e < 7 ? e + 1 : 7) * DM) + lane;
#pragma unroll
          for (int q = 0; q < 8; ++q) wn[q] = wr[64 * q]; }
#pragma unroll
        for (int j = 0; j < 4; ++j) { d[j] = 0.f;
#pragma unroll
            for (int q = 0; q < 8; ++q) d[j] += (v[j][q][0] * w[q][0] + v[j][q][1] * w[q][1]) + (v[j][q][2] * w[q][2] + v[j][q][3] * w[q][3]); }
#pragma unroll
        for (int j = 0; j < 4; ++j) d[j] = wave_sum(d[j]);
#pragma unroll
        for (int j = 0; j < 4; ++j) { const float x = d[j] * r[j];
            if (x > l1[j]) { l2[j] = l1[j]; i2[j] = i1[j]; l1[j] = x; i1[j] = e; } else if (x > l2[j]) { l2[j] = x; i2[j] = e; } } }
#pragma unroll
    for (int j = 0; j < 4; ++j) { const int tl = F.wave * 4 + j, t = wg * 32 + tl;
        const float w1 = 1.0f / (1.0f + __expf(l2[j] - l1[j])), w2 = 1.0f - w1;
        if (lane == 0) { tok_e[2 * t] = i1[j]; tok_e[2 * t + 1] = i2[j]; tok_w[2 * t] = w1; tok_w[2 * t + 1] = w2; tok_r[t] = r[j]; le[2 * tl] = i1[j]; le[2 * tl + 1] = i2[j]; } }
    LDS_WAIT(); __syncthreads();
    if (tid < 8) { int c = 0; for (int i = 0; i < 64; ++i) c += (le[i] == tid) ? 1 : 0; cnt[wg * 8 + tid] = c; }
    __syncthreads();
}
__device__ __forceinline__ void p12_scatter(Frame& F) {
    const int lane = lane_now(), wg = blockIdx.x, tid = F.wave * 64 + lane;
    const int* tok_e = (const int*)(F.ws + WS_META + MT_TOKE); const float* tok_w = (const float*)(F.ws + WS_META + MT_TOKW); const float* tok_r = (const float*)(F.ws + WS_META + MT_TOKR); const int* cnt = (const int*)(F.ws + WS_META + MT_CNT);
    int* tok_pos = (int*)(F.ws + WS_META + MT_TOKPOS); int* mte = (int*)(F.ws + WS_META + MT_MTE); int* nmt = (int*)(F.ws + WS_META + MT_NMT);
    LAS int* L = (LAS int*)F.lds;
    if (tid < 16) L[tid] = 0;
    LDS_WAIT(); __syncthreads();
    { const int e = tid & 7, wq = tid >> 3; int c[4], tot = 0, mine = 0;
#pragma unroll
      for (int k = 0; k < 4; ++k) c[k] = cnt[(wq * 4 + k) * 8 + e];
#pragma unroll
      for (int k = 0; k < 4; ++k) { tot += c[k]; mine += (wq * 4 + k < wg) ? c[k] : 0; }
      __hip_atomic_fetch_add(L + e, tot, __ATOMIC_RELAXED, __HIP_MEMORY_SCOPE_WORKGROUP); __hip_atomic_fetch_add(L + 8 + e, mine, __ATOMIC_RELAXED, __HIP_MEMORY_SCOPE_WORKGROUP); }
    LDS_WAIT(); __syncthreads();
    if (tid == 0) { int seg = 0; for (int e = 0; e < 8; ++e) { L[16 + e] = seg + L[8 + e]; const int nt = (L[e] + 255) >> 8; if (wg == 0) for (int q = 0; q < nt; ++q) mte[(seg >> 8) + q] = e; seg += nt << 8; } if (wg == 0) nmt[0] = seg >> 8; }
    LDS_WAIT(); __syncthreads();
    if (F.wave == 0) { const int e = tok_e[wg * 64 + lane]; int pos = 0;
#pragma unroll
        for (int k = 0; k < 8; ++k) { const unsigned long long m = __ballot(e == k); if (e == k) pos = L[16 + k] + __popcll(m & ((1ull << lane) - 1ull)); }
        L[32 + lane] = pos; }
    LDS_WAIT(); __syncthreads();
    unsigned char* HS = F.ws + WS_HS;
    for (int i0 = F.wave; i0 < 64; i0 += 32) {
        u32x2 w[4][8]; float rr[4]; int pos[4];
#pragma unroll
        for (int k = 0; k < 4; ++k) { const int i = i0 + 8 * k, t = wg * 32 + (i >> 1); pos[k] = L[32 + i]; rr[k] = tok_r[t];
            const u32x2* src = (const u32x2*)(WSP(bf16_t, WS_XB) + (size_t)t * DM) + lane;
#pragma unroll
            for (int q = 0; q < 8; ++q) w[k][q] = src[64 * q]; }
#pragma unroll
        for (int k = 0; k < 4; ++k) { unsigned* dst = (unsigned*)(HS + (size_t)pos[k] * DM) + lane; const float r = rr[k] * QH;
#pragma unroll
            for (int q = 0; q < 8; ++q) dst[64 * q] = pk4_i8s(bf_lo(w[k][q].x), bf_hi(w[k][q].x), bf_lo(w[k][q].y), bf_hi(w[k][q].y), r);
            if (lane == 0) tok_pos[wg * 64 + i0 + 8 * k] = pos[k]; } }
    __syncthreads();
}
__device__ __forceinline__ void p15_combine(Frame& F) {
    const int gw = F.vcu * 8 + F.wave, NGW = F.G * 8, lane = lane_now();
    const int* tok_pos = (const int*)(F.ws + WS_META + MT_TOKPOS); const float* tok_w = (const float*)(F.ws + WS_META + MT_TOKW);
    const bf16_t* Y = WSP(bf16_t, WS_Y); const bf16_t* YP = WSP(bf16_t, WS_YP);
    for (int t = gw; t < NTOK; t += NGW) {
        f32x4* o = (f32x4*)(F.out + (size_t)t * DM) + lane; const u32x2* xs = (const u32x2*)(WSP(bf16_t, WS_XB) + (size_t)t * DM) + lane; f32x4 acc[8];
        const int p0 = tok_pos[2 * t], p1 = tok_pos[2 * t + 1]; const float g0 = tok_w[2 * t], g1 = tok_w[2 * t + 1];
        if (p0 < 16384 && p1 < 16384) {
            const u32x2* y0 = (const u32x2*)(Y + (size_t)p0 * DM) + lane; const u32x2* y1 = (const u32x2*)(Y + (size_t)p1 * DM) + lane; u32x2 wx[8], wa[8], wb[8];
#pragma unroll
            for (int q = 0; q < 8; ++q) { wx[q] = xs[64 * q]; wa[q] = y0[64 * q]; wb[q] = y1[64 * q]; }
#pragma unroll
            for (int q = 0; q < 8; ++q) o[64 * q] = (f32x4){bf_lo(wx[q].x), bf_hi(wx[q].x), bf_lo(wx[q].y), bf_hi(wx[q].y)} + (f32x4){bf_lo(wa[q].x), bf_hi(wa[q].x), bf_lo(wa[q].y), bf_hi(wa[q].y)} * g0
                                                   + (f32x4){bf_lo(wb[q].x), bf_hi(wb[q].x), bf_lo(wb[q].y), bf_hi(wb[q].y)} * g1;
            continue; }
#pragma unroll
        for (int q = 0; q < 8; ++q) { const u32x2 w = xs[64 * q]; acc[q] = (f32x4){bf_lo(w.x), bf_hi(w.x), bf_lo(w.y), bf_hi(w.y)}; }
        for (int s = 0; s < 2; ++s) { const int p = s ? p1 : p0; const float gwt = s ? g1 : g0;
            if (p < 16384) { const u32x2* y = (const u32x2*)(Y + (size_t)p * DM) + lane;
#pragma unroll
                for (int q = 0; q < 8; ++q) { const u32x2 w = y[64 * q]; acc[q] = acc[q] + (f32x4){bf_lo(w.x), bf_hi(w.x), bf_lo(w.y), bf_hi(w.y)} * gwt; } }
            else { f32x4 ys[8];
#pragma unroll
                for (int q = 0; q < 8; ++q) ys[q] = (f32x4){0.f, 0.f, 0.f, 0.f};
#pragma unroll
                for (int k0 = 0; k0 < 7; k0 += 4) { u32x2 wv[4][8];
#pragma unroll
                    for (int kk = 0; kk < 4; ++kk) if (k0 + kk < 7) { const u32x2* y = (const u32x2*)(YP + ((size_t)(k0 + kk) * 2048 + (p - 16384)) * DM) + lane;
#pragma unroll
                        for (int q = 0; q < 8; ++q) wv[kk][q] = y[64 * q]; }
#pragma unroll
                    for (int kk = 0; kk < 4; ++kk) if (k0 + kk < 7) {
#pragma unroll
                        for (int q = 0; q < 8; ++q) { const u32x2 w = wv[kk][q]; ys[q] = ys[q] + (f32x4){bf_lo(w.x), bf_hi(w.x), bf_lo(w.y), bf_hi(w.y)}; } } }
#pragma unroll
                for (int q = 0; q < 8; ++q) acc[q] = acc[q] + ys[q] * gwt; } }
#pragma unroll
        for (int q = 0; q < 8; ++q) o[64 * q] = acc[q]; }
}

constexpr int NPHASE = 17;
struct Args { const void* in[28]; float* out; unsigned char* ws; int ph_lo, ph_hi; };
__global__ void __launch_bounds__(512, 2) yoco_fwd(Args args) {
    extern __shared__ __attribute__((aligned(16))) unsigned char lds_raw[];
    Frame F;
    F.lds = (LAS unsigned char*)lds_raw;
    F.wave = __builtin_amdgcn_readfirstlane(threadIdx.x >> 6);
    F.G = gridDim.x; { const int bx = blockIdx.x; F.vcu = (F.G % 8 == 0) ? (bx % 8) * (F.G / 8) + bx / 8 : bx; }
    F.kp = (kptr_t)__builtin_amdgcn_kernarg_segment_ptr();
    F.out = args.out; F.ws = args.ws;
    for (int u = F.wave * 64 + lane_now(); u < (LDS_BYTES - LDSCTL_OFF) / 4; u += 512) ((LAS unsigned*)(F.lds + LDSCTL_OFF))[u] = 0u;
    __syncthreads();
    unsigned* ctl = (unsigned*)(F.ws + WS_CTL);
    XcdBarrier bar; bar.bar = ctl + CW_BAR; bar.x = 0; bar.st = nullptr; bar.wave = F.wave;
    if (!MK_SPLIT) bar = xcd_barrier_post(ctl + CW_BAR, (volatile LAS unsigned*)(F.lds + MISC_OFF) + 8, F.wave);
    const int lo = args.ph_lo, hi = args.ph_hi;
#define IN(k) (lo <= (k) && (k) < hi)
#define SEAM(k) do { if (!MK_SPLIT && IN((k) + 1)) xcd_barrier(bar); } while (0)
    LAS unsigned char* ring = F.lds;
    const int bx = blockIdx.x, G = F.G;
    using pg8::Gemm; using pg8::StaticOrder; using pg8::MoeOrder;

#define PHASE(k, ...) do { if (IN(k)) { { __VA_ARGS__ } if constexpr (((REPMASK) >> (k)) & 1) { if (!MK_SPLIT) xcd_barrier(bar); { __VA_ARGS__ } } SEAM(k); } } while (0)
    PHASE(0, p0_prologue(F););
    PHASE(1,
        { Gemm g{WSP(bf16_t, WS_XB), WSP(bf16_t, WS_W_IN0), DM, DM}; StaticOrder S; S.init(32, 20, G, bx);
          LAS float* rl = (LAS float*)(F.lds + RSTAB_OFF);
          { pg8::Unit u0; if (S.next(0, u0)) { const int t = F.wave * 64 + lane_now(); if (t < 256) rl[t] = WSP(float, WS_RS0)[u0.pm * 256 + t]; } }
          LDS_WAIT(); __syncthreads();
          pg8::EpiBf16Plain E{WSP(bf16_t, WS_U0), NIN0, rl};
          pg8::gemm_phase<pg8::EpiBf16Plain, StaticOrder, true, true>(ring, F.wave, g, S, E); }
        { Gemm g{WSP(bf16_t, WS_MEMN), WSP(bf16_t, WS_W_MK), DM, DM}; StaticOrder S; S.init(2, 4, G, (bx + 128) % G); EpiMemKFinal E{WSP(bf16_t, WS_MEMKF), inp(F, 8), (LAS float*)(F.lds + RSTAB_OFF + 1024)};
          pg8::gemm_phase<EpiMemKFinal, StaticOrder, true, true>(ring, F.wave, g, S, E); }
        { Gemm g{WSP(bf16_t, WS_W_MV), WSP(bf16_t, WS_MEMN), DM, DM}; StaticOrder S; S.init(4, 2, G, (bx + 120) % G); pg8::EpiBf16Plain E{WSP(bf16_t, WS_MEMVT), 512, nullptr};
          pg8::gemm_phase<pg8::EpiBf16Plain, StaticOrder, true, true>(ring, F.wave, g, S, E); });
    PHASE(2, p2_conv(F); mem_attn_unit(F, 0, (F.wave & 3) * 256 + F.vcu););
    PHASE(4,
        Gemm g{WSP(bf16_t, WS_CAT), WSP(bf16_t, WS_W_OUT0), DM, DM}; StaticOrder S; S.init(32, 8, G, bx);
        pg8::EpiStream E{WSP(bf16_t, WS_XB), WSP(float, WS_SSQ), F.ws + WS_XB8, QX1, 1.0f};
        pg8::gemm_phase<pg8::EpiStream, StaticOrder, false, true>(ring, F.wave, g, S, E););
    PHASE(5,
        Gemm g{WSP(bf16_t, WS_XB8), WSP(bf16_t, WS_W_GU0), DM / 2, DM / 2}; StaticOrder S; S.init(32, 56, G, bx);
        LAS float* rl = (LAS float*)(F.lds + RSTAB_OFF);
        { pg8::Unit u0; if (S.next(0, u0)) { const int t = F.wave * 64 + lane_now(); if (t < 256) { const float* q = WSP(float, WS_SSQ) + (size_t)(u0.pm * 256 + t) * 8; const f32x4 a = *(const f32x4*)q, b = *(const f32x4*)(q + 4);
              rl[t] = (1.0f / (QX1 * QWGU)) * __builtin_amdgcn_rsqf(((a[0] + a[1]) + (a[2] + a[3]) + (b[0] + b[1]) + (b[2] + b[3])) * (1.0f / 2048.0f) + EPS); } } }
        LDS_WAIT(); __syncthreads();
        pg8::EpiSwiGLU8<3> E{F.ws + WS_HID, DFF, nullptr, rl, 1.0f, QHID};
        pg8::gemm_phase<pg8::EpiSwiGLU8<3>, StaticOrder, true, true, false, true>(ring, F.wave, g, S, E););
    PHASE(6,
        Gemm g{WSP(bf16_t, WS_HID), WSP(bf16_t, WS_W_D0), DFF / 2, DFF / 2}; StaticOrder S; S.init(32, 8, G, bx);
        pg8::EpiStream E{WSP(bf16_t, WS_XB), WSP(float, WS_SSQ) + NTOK * 8, F.ws + WS_XB8, 0.f, 1.0f / (QHID * QWD)};
        pg8::gemm_phase<pg8::EpiStream, StaticOrder, false, true, false, true>(ring, F.wave, g, S, E););
    PHASE(7,
        Gemm g{WSP(bf16_t, WS_XB8), WSP(bf16_t, WS_W_1), DM / 2, DM / 2}; StaticOrder S; S.init(32, 6, G, bx);
        pg8::EpiL1In E{WSP(float, WS_SSQ) + NTOK * 8, WSP(bf16_t, WS_CKV), WSP(float, WS_KPE), WSP(float, WS_KSS), WSP(bf16_t, WS_CQ), WSP(float, WS_SSQQ), WSP(bf16_t, WS_QM), inp(F, 7) + 128, CMEM};
        pg8::gemm_phase<pg8::EpiL1In, StaticOrder, false, true, true>(ring, F.wave, g, S, E, 0x7f7f7f79););
    PHASE(8,
        { Gemm g{WSP(bf16_t, WS_CKV), WSP(bf16_t, WS_W_KN), 256, 256}; StaticOrder S; S.init(32, 6, G, bx); EpiKnFinal E{WSP(bf16_t, WS_KF), WSP(float, WS_KPE), WSP(float, WS_KSS), (const int*)inp(F, 2), inp(F, 20), (LAS float*)(F.lds + RSTAB_OFF + 1024)};
          pg8::gemm_phase<EpiKnFinal, StaticOrder, true, true>(ring, F.wave, g, S, E); }
        { Gemm g{WSP(bf16_t, WS_W_V), WSP(bf16_t, WS_CKV), 256, 256}; StaticOrder S; S.init(6, 32, G, (bx + 64) % G); EpiFp8Plain E{F.ws + WS_VT, NTOK};
          pg8::gemm_phase<EpiFp8Plain, StaticOrder, true, true>(ring, F.wave, g, S, E); }
        { Gemm g{WSP(bf16_t, WS_CQ), WSP(bf16_t, WS_W_QB), 512, 512}; StaticOrder S; S.init(32, 9, G, (bx + 128) % G); pg8::EpiBf16Plain E{WSP(bf16_t, WS_QRAW), 2304, nullptr};
          pg8::gemm_phase<pg8::EpiBf16Plain, StaticOrder, true, true>(ring, F.wave, g, S, E); });
    PHASE(10,
        p11_attention(F););
    PHASE(11,
        Gemm g{WSP(bf16_t, WS_CAT), WSP(bf16_t, WS_W_OUT1), DM / 2, DM / 2}; StaticOrder S; S.init(32, 8, G, bx);
        pg8::EpiStream E{WSP(bf16_t, WS_XB), WSP(float, WS_SSQ) + 2 * NTOK * 8, nullptr, 0.f, 1.0f};
        pg8::gemm_phase<pg8::EpiStream, StaticOrder, false, true, true>(ring, F.wave, g, S, E, 0x7f7f7b79););
    PHASE(12, p11_router(F););
    PHASE(13, p12_scatter(F););
    PHASE(14,
        const int* mte = (const int*)(F.ws + WS_META + MT_MTE); const int nmt = *(const int*)(F.ws + WS_META + MT_NMT);
        Gemm g{WSP(bf16_t, WS_HS), WSP(bf16_t, WS_W_MGU), DM / 2, DM / 2}; MoeOrder S; S.init(nmt, 56, G, bx); S.mte = mte; S.ntpe = 56;
        pg8::EpiSwiGLU8<2> E{F.ws + WS_HID2, DFF, nullptr, nullptr, 1.0f / (QH * QWGU), QHID};
        pg8::gemm_phase<pg8::EpiSwiGLU8<2>, MoeOrder, true, true, false, true>(ring, F.wave, g, S, E););
    PHASE(15,
        const int* mte = (const int*)(F.ws + WS_META + MT_MTE); const int nmt = *(const int*)(F.ws + WS_META + MT_NMT);
        { Gemm g{WSP(bf16_t, WS_HID2), WSP(bf16_t, WS_W_MD), DFF / 2, DFF / 2}; MoeOrder S; S.init(64, 8, G, bx); S.mte = mte; S.ntpe = 8;
          pg8::EpiMoeDown E{WSP(bf16_t, WS_Y), 1.0f / (QHID * QWD)};
          pg8::gemm_phase<pg8::EpiMoeDown, MoeOrder, true, true, false, true>(ring, F.wave, g, S, E); }
        { Gemm g{WSP(bf16_t, WS_HID2), WSP(bf16_t, WS_W_MD), 512, DFF / 2}; pg8::MoeTailOrder S{nmt - 64, G, bx, mte};
          pg8::EpiMoeDownPart E{WSP(bf16_t, WS_YP), 1.0f / (QHID * QWD)};
          pg8::gemm_phase<pg8::EpiMoeDownPart, pg8::MoeTailOrder, true, true, false, true>(ring, F.wave, g, S, E); });
    if (IN(16)) { p15_combine(F); }
#undef PHASE
#undef IN
#undef SEAM
}

extern "C" void kernel_launch(void* const* d_in, const int* in_sizes, int n_in, void* d_out, int out_size, void* d_ws, size_t ws_size, hipStream_t stream) {
    static int ready = 0;
    if (ready == 0) {
        ready = -1;
        if (n_in != 28 || in_sizes[0] != NTOK * DM || out_size != NTOK * DM || ws_size < WS_END) { fprintf(stderr, "kernel_launch: unexpected shapes (n_in %d, out %d, ws %zu < %zu)\n", n_in, out_size, ws_size, (size_t)WS_END); return; }
        if (hipFuncSetAttribute((const void*)yoco_fwd, hipFuncAttributeMaxDynamicSharedMemorySize, LDS_BYTES) != hipSuccess) { fprintf(stderr, "kernel_launch: hipFuncSetAttribute failed\n"); return; }
        int per_cu = 0; if (hipOccupancyMaxActiveBlocksPerMultiprocessor(&per_cu, (const void*)yoco_fwd, 512, LDS_BYTES) != hipSuccess || per_cu < 1) fprintf(stderr, "kernel_launch: occupancy query reports %d\n", per_cu);
        (void)hipGetLastError();
        ready = 1;
    }
    if (ready < 0) return;
    (void)hipMemsetAsync((char*)d_ws + WS_CTL, 0, CTL_ZERO_BYTES, stream);
    Args a{};
    for (int i = 0; i < 28; ++i) a.in[i] = d_in[i];
    a.out = (float*)d_out; a.ws = (unsigned char*)d_ws;
#if MK_SPLIT
    for (int p = 0; p < NPHASE; ++p) { a.ph_lo = p; a.ph_hi = p + 1; hipLaunchKernelGGL(yoco_fwd, dim3(256), dim3(512), LDS_BYTES, stream, a); }
#else
    a.ph_lo = 0; a.ph_hi = NPHASE;
    hipLaunchKernelGGL(yoco_fwd, dim3(256), dim3(512), LDS_BYTES, stream, a);
#endif
    const hipError_t le = hipPeekAtLastError();
    if (le != hipSuccess) fprintf(stderr, "kernel_launch: launch failed: %s\n", hipGetErrorName(le));
}
```

```cpp
#include <hip/hip_runtime.h>
#include <cstdio>
#include <cstdint>

#ifndef REPMASK
#define REPMASK 0
#endif
#ifndef MK_SPLIT
#define MK_SPLIT 0
#endif

#define GAS __attribute__((address_space(1)))
#define LAS __attribute__((address_space(3)))
typedef unsigned short bf16_t;
typedef short bf16x8 __attribute__((ext_vector_type(8)));
typedef float f32x4 __attribute__((ext_vector_type(4)));
typedef float f32x16 __attribute__((ext_vector_type(16)));
typedef unsigned u32x4 __attribute__((ext_vector_type(4)));
typedef unsigned u32x2 __attribute__((ext_vector_type(2)));
typedef int v4i_t __attribute__((ext_vector_type(4)));
typedef int v8i_t __attribute__((ext_vector_type(8)));

constexpr int NTOK = 8192, DM = 2048, SEQ = 4096;
constexpr int DFF = 7168, NEXP = 8;
constexpr int NIN0 = 5120;
constexpr int N1 = 1536;
constexpr int MAXPAIR = 18432;
constexpr float EPS = 1e-6f;
constexpr float LOG2E = 1.4426950408889634f;
constexpr float QX1 = 127.0f / 6.5f;
constexpr float QWGU = 127.0f / 0.12f;
constexpr float QHID = 127.0f / 8.0f;
constexpr float QWD = 127.0f / 0.064f;
constexpr float QH = 127.0f / 5.5f;

constexpr size_t MiB = 1u << 20;
constexpr size_t WS_CTL = 0, CTL_ZERO_BYTES = 64 * 1024;
constexpr size_t WS_META = 1 * MiB;
constexpr size_t WS_SSQ = 2 * MiB;
constexpr size_t WS_WR = 3 * MiB;
constexpr size_t WS_MEMN = 4 * MiB;
constexpr size_t WS_MEMKR = 6 * MiB;
constexpr size_t WS_MEMKF = 7 * MiB;
constexpr size_t WS_MEMVT = 8 * MiB;
constexpr size_t WS_QM = 10 * MiB;
constexpr size_t WS_W_IN0 = 20 * MiB, WS_W_OUT0 = 40 * MiB, WS_W_OUT1 = 48 * MiB, WS_W_GU0 = 56 * MiB, WS_W_D0 = 112 * MiB, WS_W_1 = 140 * MiB;
constexpr size_t WS_W_KN = 146 * MiB, WS_W_V = 147 * MiB, WS_W_QB = 148 * MiB, WS_W_MK = 151 * MiB, WS_W_MV = 155 * MiB;
constexpr size_t WS_W_MGU = 160 * MiB, WS_W_MD = 608 * MiB;
constexpr size_t WS_XB = 832 * MiB, WS_CAT = 864 * MiB, WS_H0 = 896 * MiB, WS_HS = 960 * MiB;
constexpr size_t WS_U0 = 1032 * MiB, WS_HID = 1112 * MiB, WS_U1F = 1224 * MiB, WS_CKV = 1272 * MiB, WS_CQ = 1276 * MiB;
constexpr size_t WS_HID2 = 1032 * MiB;
constexpr size_t WS_KNRAW = 1284 * MiB, WS_VT = 1308 * MiB, WS_QRAW = 1332 * MiB, WS_KF = 1368 * MiB, WS_QF = 1404 * MiB;
constexpr size_t WS_Y = 1284 * MiB;
constexpr size_t WS_KPE = WS_U1F;
constexpr size_t WS_KSS = WS_SSQ + 768 * 1024, WS_SSQQ = WS_SSQ + 832 * 1024, WS_RS0 = WS_SSQ + 896 * 1024;
constexpr size_t WS_XB8 = 928 * MiB;
constexpr size_t WS_YP = 384 * MiB;
constexpr size_t WS_END = 1440 * MiB;
constexpr size_t MT_TOKE = 0, MT_TOKW = 64 * 1024, MT_TOKR = 128 * 1024, MT_CNT = 160 * 1024, MT_TOKPOS = 192 * 1024, MT_PAIRW = 256 * 1024, MT_PAIRR = 328 * 1024, MT_MTE = 512 * 1024, MT_NMT = 513 * 1024;
constexpr int CW_BAR = 4096;

constexpr int RING_BYTES = 131072;
constexpr int LDSCTL_OFF = 132096  , MISC_OFF = LDSCTL_OFF + 320, RSTAB_OFF = LDSCTL_OFF + 1024;
constexpr int LDS_BYTES = 147456;

#define LDS_WAIT() asm volatile("s_waitcnt lgkmcnt(0)" ::: "memory")
#define VM_WAIT() asm volatile("s_waitcnt vmcnt(0)" ::: "memory")
__device__ __forceinline__ unsigned cvt_pk_bf16(float lo, float hi) { unsigned r; asm volatile("v_cvt_pk_bf16_f32 %0, %1, %2" : "=v"(r) : "v"(lo), "v"(hi)); return r; }
__device__ __forceinline__ unsigned pk4_fp8(float a, float b, float c, float d) { int w = 0; w = __builtin_amdgcn_cvt_pk_fp8_f32(a, b, w, false); w = __builtin_amdgcn_cvt_pk_fp8_f32(c, d, w, true); return (unsigned)w; }
__device__ __forceinline__ unsigned pk4_i8(float a, float b, float c, float d) {
    unsigned w = 0;
    w = __builtin_amdgcn_cvt_pk_u8_f32(a + 128.0f, 0, w); w = __builtin_amdgcn_cvt_pk_u8_f32(b + 128.0f, 1, w);
    w = __builtin_amdgcn_cvt_pk_u8_f32(c + 128.0f, 2, w); w = __builtin_amdgcn_cvt_pk_u8_f32(d + 128.0f, 3, w);
    return w ^ 0x80808080u; }
__device__ __forceinline__ unsigned pk4_i8s(float a, float b, float c, float d, float q) {
    unsigned w = 0;
    w = __builtin_amdgcn_cvt_pk_u8_f32(__builtin_fmaf(a, q, 128.0f), 0, w); w = __builtin_amdgcn_cvt_pk_u8_f32(__builtin_fmaf(b, q, 128.0f), 1, w);
    w = __builtin_amdgcn_cvt_pk_u8_f32(__builtin_fmaf(c, q, 128.0f), 2, w); w = __builtin_amdgcn_cvt_pk_u8_f32(__builtin_fmaf(d, q, 128.0f), 3, w);
    return w ^ 0x80808080u; }
__device__ __forceinline__ float bf_lo(unsigned w) { return __uint_as_float(w << 16); }
__device__ __forceinline__ float bf_hi(unsigned w) { return __uint_as_float(w & 0xffff0000u); }
template <int CTRL, int ROWS = 0xf> __device__ __forceinline__ float dpp_f(float v) { return __builtin_bit_cast(float, __builtin_amdgcn_update_dpp(0, __builtin_bit_cast(int, v), CTRL, ROWS, 0xf, false)); }
__device__ __forceinline__ float row16_sum(float v) {
    v += dpp_f<0xB1>(v); v += dpp_f<0x4E>(v);
    v += dpp_f<0x141>(v); v += dpp_f<0x140>(v);
    return v; }
__device__ __forceinline__ float wave_sum(float v) {
    v = row16_sum(v);
    v += dpp_f<0x142, 0xA>(v);
    v += dpp_f<0x143, 0xC>(v);
    return __builtin_bit_cast(float, __builtin_amdgcn_readlane(__builtin_bit_cast(int, v), 63)); }
__device__ __forceinline__ int lane_now() { int l; asm volatile("v_mbcnt_lo_u32_b32 %0, -1, 0\n\tv_mbcnt_hi_u32_b32 %0, -1, %0" : "=v"(l)); return l; }
__device__ __forceinline__ float max3f(float a, float b, float c) { float r; asm("v_max3_f32 %0, %1, %2, %3" : "=v"(r) : "v"(a), "v"(b), "v"(c)); return r; }
__device__ __forceinline__ float half_max(float x) { const unsigned u = __float_as_uint(x); auto r = __builtin_amdgcn_permlane32_swap(u, u, false, false); return fmaxf(__uint_as_float(r[0]), __uint_as_float(r[1])); }
__device__ __forceinline__ float other_half(float x, int lane) { const unsigned u = __float_as_uint(x); auto r = __builtin_amdgcn_permlane32_swap(u, u, false, false); return __uint_as_float(lane < 32 ? r[1] : r[0]); }
__device__ __forceinline__ float rows4_sum(float x) { const unsigned u = __float_as_uint(x); auto r = __builtin_amdgcn_permlane16_swap(u, u, false, false); const float y = __uint_as_float(r[0]) + __uint_as_float(r[1]);
    const unsigned v = __float_as_uint(y); auto q = __builtin_amdgcn_permlane32_swap(v, v, false, false); return __uint_as_float(q[0]) + __uint_as_float(q[1]); }
__device__ __forceinline__ float half_sum(float x) { const unsigned u = __float_as_uint(x); auto r = __builtin_amdgcn_permlane32_swap(u, u, false, false); return __uint_as_float(r[0]) + __uint_as_float(r[1]); }
__device__ __forceinline__ float silu_f(float x) { return x * __builtin_amdgcn_rcpf(1.0f + __builtin_amdgcn_exp2f(-x * LOG2E)); }

namespace pg8 {
constexpr int BM = 256, BK = 64, HALF = 128, HTB = HALF * BK * 2, STAGE_BYTES = 8 * HTB, NXCD = 8, WGM = 8;
__host__ __device__ __forceinline__ int lds_byte(int r, int c) { const int st = (r >> 4) * 2 + (c >> 5), rr = r & 15, cc = c & 31, ob = rr * 64 + cc * 2; return st * 1024 + (ob ^ (((ob >> 9) & 1) << 5)); }
__host__ __device__ __forceinline__ void stage_rc(int b, int& R, int& C) { const int st = b / 1024, sb = b % 1024, swz = sb ^ (((sb >> 9) & 1) << 5); R = (st >> 1) * 16 + swz / 64; C = (st & 1) * 32 + (swz % 64) / 2; }
__host__ __device__ __forceinline__ int perm32(int rho) { const int n = rho >> 4, i = rho & 15; return 8 * (i >> 2) + 4 * n + (i & 3); }

struct Unit { int pm, pn, am, bn, koff, ks; };
struct Gemm { const bf16_t* A; const bf16_t* Bt; int K, ld; };

struct StaticOrder {
    int nM, nN, nwg, G, c;
    __device__ __forceinline__ void init(int nM_, int nN_, int G_, int c_) { nM = nM_; nN = nN_; nwg = nM * nN; G = G_; c = c_; }
    __device__ __forceinline__ bool map(int i, Unit& u) const {
        const long L = (long)i * G + c; if (L >= nwg) return false;
        int wgid = (int)L; { const int q = nwg / NXCD, r = nwg % NXCD, xcd = wgid % NXCD, off = wgid / NXCD; wgid = (xcd < r ? xcd * (q + 1) : r * (q + 1) + (xcd - r) * q) + off; }
        const int nig = WGM * nN, gid = wgid / nig, fm = gid * WGM, gsz = (nM - fm) < WGM ? (nM - fm) : WGM;
        u.pm = fm + ((wgid % nig) % gsz); u.pn = (wgid % nig) / gsz; return true;
    }
    __device__ __forceinline__ bool next(int i, Unit& u) const { if (!map(i, u)) return false; u.am = u.pm; u.bn = u.pn; u.koff = 0; u.ks = 0; return true; }
};
struct MoeOrder : StaticOrder {
    const int* mte; int ntpe;
    __device__ __forceinline__ bool next(int i, Unit& u) const { if (!map(i, u)) return false; u.am = u.pm; u.bn = mte[u.pm] * ntpe + u.pn; u.koff = 0; u.ks = 0; return true; }
};
struct MoeTailOrder {
    int nL, G, c; const int* mte;
    __device__ __forceinline__ bool next(int i, Unit& u) const {
        const int L = i * G + c; if (L >= nL * 56) return false;
        u.pn = L & 7; const int t = L >> 3; u.pm = t % nL; u.ks = t / nL; u.am = 64 + u.pm; u.bn = mte[64 + u.pm] * 8 + u.pn; u.koff = u.ks * 1024; return true; }
};

struct EpiBf16Plain {
    static constexpr bool PERM = true, AFTER_DRAIN = false;
    bf16_t* O; int ldc; const LAS float* rl;
    __device__ __forceinline__ void operator()(const f32x4 (&acc)[2][2][4][2], const Unit& u, int wr, int wc, int fr, int fq) const {
        const int row0 = u.pm * BM + wr * 64 + fr, col0 = u.pn * BM + wc * 32 + 8 * fq;
#pragma unroll
        for (int ai = 0; ai < 2; ++ai)
#pragma unroll
            for (int m = 0; m < 4; ++m) { bf16_t* rowp = O + (size_t)(row0 + ai * HALF + m * 16) * ldc + col0; const float r = rl ? rl[wr * 64 + fr + ai * HALF + m * 16] : 1.0f;
#pragma unroll
                for (int bj = 0; bj < 2; ++bj) { const f32x4 v0 = acc[ai][bj][m][0] * r, v1 = acc[ai][bj][m][1] * r;
                    u32x4 w; w.x = cvt_pk_bf16(v0[0], v0[1]); w.y = cvt_pk_bf16(v0[2], v0[3]); w.z = cvt_pk_bf16(v1[0], v1[1]); w.w = cvt_pk_bf16(v1[2], v1[3]);
                    *(u32x4*)(rowp + bj * HALF) = w; } }
    }
};
template <int MODE> struct EpiSwiGLU {
    static constexpr bool PERM = true, AFTER_DRAIN = false;
    bf16_t* H; int ldh; const float* rs;
    __device__ __forceinline__ void operator()(const f32x4 (&acc)[2][2][4][2], const Unit& u, int wr, int wc, int fr, int fq) const {
        const int row0 = u.pm * BM + wr * 64 + fr, col0 = u.pn * HALF + wc * 32 + 8 * fq;
#pragma unroll
        for (int ai = 0; ai < 2; ++ai)
#pragma unroll
            for (int m = 0; m < 4; ++m) { const int row = row0 + ai * HALF + m * 16; float r;
                if (MODE == 0) { const f32x4 a = *(const f32x4*)(rs + (size_t)row * 8), b = *(const f32x4*)(rs + (size_t)row * 8 + 4);
                    r = 1.0f * __builtin_amdgcn_rsqf(((a[0] + a[1]) + (a[2] + a[3]) + (b[0] + b[1]) + (b[2] + b[3])) * (1.0f / 2048.0f) + EPS); }
                else r = rs[row];
                const f32x4 g0 = acc[ai][0][m][0] * r, g1 = acc[ai][0][m][1] * r, u0 = acc[ai][1][m][0] * r, u1 = acc[ai][1][m][1] * r;
                u32x4 w; w.x = cvt_pk_bf16(silu_f(g0[0]) * u0[0], silu_f(g0[1]) * u0[1]); w.y = cvt_pk_bf16(silu_f(g0[2]) * u0[2], silu_f(g0[3]) * u0[3]);
                w.z = cvt_pk_bf16(silu_f(g1[0]) * u1[0], silu_f(g1[1]) * u1[1]); w.w = cvt_pk_bf16(silu_f(g1[2]) * u1[2], silu_f(g1[3]) * u1[3]);
                *(u32x4*)(H + (size_t)row * ldh + col0) = w; }
    }
};
template <int MODE> struct EpiSwiGLU8 {
    static constexpr bool PERM = true, AFTER_DRAIN = false;
    unsigned char* H; int ldh; const float* rs; const LAS float* rl; float cs, qo;
    __device__ __forceinline__ void operator()(const f32x4 (&acc)[2][2][4][2], const Unit& u, int wr, int wc, int fr, int fq) const {
        const int row0 = u.pm * BM + wr * 64 + fr, col0 = u.pn * HALF + wc * 32 + 8 * fq;
#pragma unroll
        for (int ai = 0; ai < 2; ++ai)
#pragma unroll
            for (int m = 0; m < 4; ++m) { const int row = row0 + ai * HALF + m * 16; float r;
                if (MODE == 3) r = rl[wr * 64 + fr + ai * HALF + m * 16];
                else if (MODE == 0) { const f32x4 a = *(const f32x4*)(rs + (size_t)row * 8), b = *(const f32x4*)(rs + (size_t)row * 8 + 4);
                    r = 1.0f * __builtin_amdgcn_rsqf(((a[0] + a[1]) + (a[2] + a[3]) + (b[0] + b[1]) + (b[2] + b[3])) * (1.0f / 2048.0f) + EPS); }
                else if (MODE == 1) r = rs[row]; else r = cs;
                const f32x4 ag0 = acc[ai][0][m][0], ag1 = acc[ai][0][m][1], au0 = acc[ai][1][m][0], au1 = acc[ai][1][m][1];
                const float c1 = -LOG2E * r, c2 = r * r * (qo != 0.f ? qo : 1.0f);
                f32x4 e0 = ag0 * c1, e1 = ag1 * c1;
#pragma unroll
                for (int i = 0; i < 4; ++i) { e0[i] = __builtin_amdgcn_exp2f(e0[i]); e1[i] = __builtin_amdgcn_exp2f(e1[i]); }
                f32x4 d0 = e0 + 1.0f, d1 = e1 + 1.0f;
#pragma unroll
                for (int i = 0; i < 4; ++i) { d0[i] = __builtin_amdgcn_rcpf(d0[i]); d1[i] = __builtin_amdgcn_rcpf(d1[i]); }
                const f32x4 t0 = (ag0 * au0) * d0, t1 = (ag1 * au1) * d1;
                u32x2 w;
                if (qo != 0.f) { const f32x4 y0 = __builtin_elementwise_fma(t0, (f32x4){c2, c2, c2, c2}, (f32x4){128.0f, 128.0f, 128.0f, 128.0f}), y1 = __builtin_elementwise_fma(t1, (f32x4){c2, c2, c2, c2}, (f32x4){128.0f, 128.0f, 128.0f, 128.0f}); unsigned a = 0, c = 0;
#pragma unroll
                    for (int i = 0; i < 4; ++i) { a = __builtin_amdgcn_cvt_pk_u8_f32(y0[i], i, a); c = __builtin_amdgcn_cvt_pk_u8_f32(y1[i], i, c); }
                    w.x = a ^ 0x80808080u; w.y = c ^ 0x80808080u; }
                else { const f32x4 h0 = t0 * c2, h1 = t1 * c2; w.x = pk4_fp8(h0[0], h0[1], h0[2], h0[3]); w.y = pk4_fp8(h1[0], h1[1], h1[2], h1[3]); }
                *(u32x2*)(H + (size_t)row * ldh + col0) = w; }
    }
};
struct EpiRowScaleF32 {
    static constexpr bool PERM = false, AFTER_DRAIN = false;
    float* O; int ldc; const float* ssq;
    __device__ __forceinline__ void operator()(const f32x4 (&acc)[2][2][4][2], const Unit& u, int wr, int wc, int fr, int fq) const {
        const int row0 = u.pm * BM + wr * 64 + fr, col0 = u.pn * BM + wc * 32 + 4 * fq;
#pragma unroll
        for (int ai = 0; ai < 2; ++ai)
#pragma unroll
            for (int m = 0; m < 4; ++m) { const int row = row0 + ai * HALF + m * 16;
                const f32x4 a = *(const f32x4*)(ssq + (size_t)row * 8), b = *(const f32x4*)(ssq + (size_t)row * 8 + 4);
                const float r = 1.0f * __builtin_amdgcn_rsqf(((a[0] + a[1]) + (a[2] + a[3]) + (b[0] + b[1]) + (b[2] + b[3])) * (1.0f / 2048.0f) + EPS);
                float* rowp = O + (size_t)row * ldc + col0;
#pragma unroll
                for (int bj = 0; bj < 2; ++bj)
#pragma unroll
                    for (int n = 0; n < 2; ++n) *(f32x4*)(rowp + bj * HALF + n * 16) = acc[ai][bj][m][n] * r; }
    }
};
struct EpiMoeDown {
    static constexpr bool PERM = true, AFTER_DRAIN = false;
    bf16_t* Y; float ds;
    __device__ __forceinline__ void operator()(const f32x4 (&acc)[2][2][4][2], const Unit& u, int wr, int wc, int fr, int fq) const {
        const int row0 = u.pm * BM + wr * 64 + fr, col0 = u.pn * BM + wc * 32 + 8 * fq;
#pragma unroll
        for (int ai = 0; ai < 2; ++ai)
#pragma unroll
            for (int m = 0; m < 4; ++m) { bf16_t* rowp = Y + (size_t)(row0 + ai * HALF + m * 16) * DM + col0;
#pragma unroll
                for (int bj = 0; bj < 2; ++bj) { const f32x4 v0 = acc[ai][bj][m][0] * ds, v1 = acc[ai][bj][m][1] * ds;
                    u32x4 w; w.x = cvt_pk_bf16(v0[0], v0[1]); w.y = cvt_pk_bf16(v0[2], v0[3]); w.z = cvt_pk_bf16(v1[0], v1[1]); w.w = cvt_pk_bf16(v1[2], v1[3]);
                    *(u32x4*)(rowp + bj * HALF) = w; } }
    }
};
struct EpiMoeDownPart {
    static constexpr bool PERM = true, AFTER_DRAIN = false;
    bf16_t* YP; float ds;
    __device__ __forceinline__ void operator()(const f32x4 (&acc)[2][2][4][2], const Unit& u, int wr, int wc, int fr, int fq) const {
        const int row0 = u.pm * BM + wr * 64 + fr, col0 = u.pn * BM + wc * 32 + 8 * fq;
#pragma unroll
        for (int ai = 0; ai < 2; ++ai)
#pragma unroll
            for (int m = 0; m < 4; ++m) { bf16_t* rowp = YP + ((size_t)u.ks * 2048 + row0 + ai * HALF + m * 16) * DM + col0;
#pragma unroll
                for (int bj = 0; bj < 2; ++bj) { const f32x4 v0 = acc[ai][bj][m][0] * ds, v1 = acc[ai][bj][m][1] * ds;
                    u32x4 w; w.x = cvt_pk_bf16(v0[0], v0[1]); w.y = cvt_pk_bf16(v0[2], v0[3]); w.z = cvt_pk_bf16(v1[0], v1[1]); w.w = cvt_pk_bf16(v1[2], v1[3]);
                    *(u32x4*)(rowp + bj * HALF) = w; } }
    }
};
struct EpiStream {
    static constexpr bool PERM = false, AFTER_DRAIN = true;
    bf16_t* xb; float* ssq; unsigned char* x8; float q8, ds;
    __device__ __forceinline__ void fused(f32x4 (&acc)[2][2][4][2], const Unit& u, int wr, int wc, int fr, int fq, LAS unsigned char* lds, int wid, int lane) const {
        LAS float* P = (LAS float*)lds;
        const int col0 = u.pn * BM + wc * 32 + 4 * fq;
#pragma unroll
        for (int ai = 0; ai < 2; ++ai) {
            u32x2 rv[4][2][2];
#pragma unroll
            for (int m = 0; m < 4; ++m) { const size_t off = (size_t)(u.pm * BM + ai * HALF + wr * 64 + m * 16 + fr) * DM + col0;
#pragma unroll
                for (int bj = 0; bj < 2; ++bj)
#pragma unroll
                    for (int n = 0; n < 2; ++n) rv[m][bj][n] = *(const u32x2*)(xb + off + bj * HALF + n * 16); }
#pragma unroll
            for (int m = 0; m < 4; ++m) { const int rl = ai * HALF + wr * 64 + m * 16 + fr; const size_t off = (size_t)(u.pm * BM + rl) * DM + col0; float s = 0.f;
#pragma unroll
                for (int bj = 0; bj < 2; ++bj)
#pragma unroll
                    for (int n = 0; n < 2; ++n) { const f32x4 a = acc[ai][bj][m][n] * ds; const u32x2 r = rv[m][bj][n];
                        const float v0 = bf_lo(r.x) + a[0], v1 = bf_hi(r.x) + a[1], v2 = bf_lo(r.y) + a[2], v3 = bf_hi(r.y) + a[3];
                        u32x2 w; w.x = cvt_pk_bf16(v0, v1); w.y = cvt_pk_bf16(v2, v3);
                        *(u32x2*)(xb + off + bj * HALF + n * 16) = w; s += (v0 * v0 + v1 * v1) + (v2 * v2 + v3 * v3);
                        if (x8) *(unsigned*)(x8 + off + bj * HALF + n * 16) = q8 == 0.f ? pk4_fp8(v0, v1, v2, v3) : pk4_i8s(v0, v1, v2, v3, q8); }
                s = rows4_sum(s);
                if (fq == 0) P[rl * 4 + wc] = s; }
            asm volatile("" ::: "memory"); }
        asm volatile("s_waitcnt lgkmcnt(0)" ::: "memory"); __builtin_amdgcn_s_barrier(); asm volatile("" ::: "memory");
        const int t = wid * 64 + lane;
        if (t < 256) { const f32x4 p = *(const LAS f32x4*)(P + t * 4); ssq[(size_t)(u.pm * BM + t) * 8 + u.pn] = (p[0] + p[1]) + (p[2] + p[3]); }
        asm volatile("s_waitcnt lgkmcnt(0)" ::: "memory"); __builtin_amdgcn_s_barrier(); asm volatile("" ::: "memory");
    }
};

struct EpiL1In {
    static constexpr bool PERM = false, AFTER_DRAIN = true;
    const float* ssq2; bf16_t* ckv; float* kpe; float* kss; bf16_t* cq; float* ssqq; bf16_t* qm; const float* g_mq1; float cmem;
    __device__ __forceinline__ void fused(f32x4 (&acc)[2][2][4][2], const Unit& u, int wr, int wc, int fr, int fq, LAS unsigned char* lds, int wid, int lane) const {
        LAS float* P = (LAS float*)lds;
#pragma unroll
        for (int ai = 0; ai < 2; ++ai)
#pragma unroll
            for (int m = 0; m < 4; ++m) { const int rl = ai * HALF + wr * 64 + m * 16 + fr;
#pragma unroll
                for (int bj = 0; bj < 2; ++bj) { const f32x4 a = acc[ai][bj][m][0], b = acc[ai][bj][m][1];
                    float s = (a[0] * a[0] + a[1] * a[1]) + (a[2] * a[2] + a[3] * a[3]) + (b[0] * b[0] + b[1] * b[1]) + (b[2] * b[2] + b[3] * b[3]);
                    s = rows4_sum(s);
                    if (fq == 0) P[(rl * 2 + bj) * 4 + wc] = s; } }
        asm volatile("s_waitcnt lgkmcnt(0)" ::: "memory"); __builtin_amdgcn_s_barrier(); asm volatile("" ::: "memory");
        const int pn = u.pn;
        float r2s[2][4];
        { f32x4 qa[2][4], qb[2][4];
#pragma unroll
          for (int ai = 0; ai < 2; ++ai)
#pragma unroll
              for (int m = 0; m < 4; ++m) { const int row = u.pm * BM + ai * HALF + wr * 64 + m * 16 + fr; qa[ai][m] = *(const f32x4*)(ssq2 + (size_t)row * 8); qb[ai][m] = *(const f32x4*)(ssq2 + (size_t)row * 8 + 4); }
#pragma unroll
          for (int ai = 0; ai < 2; ++ai)
#pragma unroll
              for (int m = 0; m < 4; ++m) r2s[ai][m] = __builtin_amdgcn_rsqf(((qa[ai][m][0] + qa[ai][m][1]) + (qa[ai][m][2] + qa[ai][m][3]) + (qb[ai][m][0] + qb[ai][m][1]) + (qb[ai][m][2] + qb[ai][m][3])) * (1.0f / 2048.0f) + EPS); }
#pragma unroll
        for (int ai = 0; ai < 2; ++ai)
#pragma unroll
            for (int m = 0; m < 4; ++m) { const int rl = ai * HALF + wr * 64 + m * 16 + fr, row = u.pm * BM + rl;
                const float r2 = r2s[ai][m];
                const f32x4 p0 = *(const LAS f32x4*)(P + (rl * 2 + 0) * 4), p1 = *(const LAS f32x4*)(P + (rl * 2 + 1) * 4);
                const float ss0 = (p0[0] + p0[1]) + (p0[2] + p0[3]), ss1 = (p1[0] + p1[1]) + (p1[2] + p1[3]);
                const int cl = wc * 32 + 4 * fq;
                if (pn == 0) { const float sc = r2 * __builtin_amdgcn_rsqf(r2 * r2 * (ss0 + ss1) * (1.0f / 256.0f) + EPS);
#pragma unroll
                    for (int bj = 0; bj < 2; ++bj)
#pragma unroll
                        for (int n = 0; n < 2; ++n) { const f32x4 v = acc[ai][bj][m][n] * sc; u32x2 w; w.x = cvt_pk_bf16(v[0], v[1]); w.y = cvt_pk_bf16(v[2], v[3]);
                            *(u32x2*)(ckv + (size_t)row * 256 + bj * HALF + cl + n * 16) = w; } }
                else if (pn == 1) { if (wc < 2) {
#pragma unroll
                        for (int n = 0; n < 2; ++n) *(f32x4*)(kpe + (size_t)row * 64 + cl + n * 16) = acc[ai][0][m][n] * r2; }
                    if (wc == 0 && fq == 0) kss[row] = r2 * r2 * ss0; }
                else if (pn < 4) {
#pragma unroll
                    for (int bj = 0; bj < 2; ++bj)
#pragma unroll
                        for (int n = 0; n < 2; ++n) { const f32x4 v = acc[ai][bj][m][n] * r2; u32x2 w; w.x = cvt_pk_bf16(v[0], v[1]); w.y = cvt_pk_bf16(v[2], v[3]);
                            *(u32x2*)(cq + (size_t)row * 512 + (pn - 2) * 256 + bj * HALF + cl + n * 16) = w; }
                    if (wc == 0 && fq == 0) ssqq[row * 2 + (pn - 2)] = r2 * r2 * (ss0 + ss1); }
                else { const int b = row >> 12, s = row & (SEQ - 1);
#pragma unroll
                    for (int bj = 0; bj < 2; ++bj) { const int head = (pn - 4) * 2 + bj; const float rr = cmem * r2 * __builtin_amdgcn_rsqf(r2 * r2 * (bj ? ss1 : ss0) * (1.0f / 128.0f) + EPS);
#pragma unroll
                        for (int n = 0; n < 2; ++n) { const f32x4 g = *(const f32x4*)(g_mq1 + cl + n * 16); const f32x4 v = acc[ai][bj][m][n] * rr * g; u32x2 w; w.x = cvt_pk_bf16(v[0], v[1]); w.y = cvt_pk_bf16(v[2], v[3]);
                            *(u32x2*)(qm + ((size_t)(b * 4 + head) * SEQ + s) * 128 + cl + n * 16) = w; } } }
                asm volatile("" ::: "memory"); }
    }
};

template <class Epi, class Sched, bool ALIGN_EPI = false, bool SP2 = false, bool F8 = false, bool I8 = false>
__device__ __forceinline__ void gemm_phase(LAS unsigned char* lds, const int wid, const Gemm g, const Sched& S, const Epi& E, const int f8s = 0x7f7f7f7f) {
    const int lane = lane_now(), tid = wid * 64 + lane, wr = wid >> 2, wc = wid & 3, fr = lane & 15, fq = lane >> 4;
    const int K = g.ld, nt = g.K / BK;
    unsigned voffA, voffB;
    { int R, C; stage_rc(tid * 16, R, C); const int Rb = Epi::PERM ? ((R & ~31) + perm32(R & 31)) : R;
      voffA = (unsigned)(R * K + C) * 2u; voffB = (unsigned)(Rb * K + C) * 2u; }
    const unsigned qstep = 64u * (unsigned)K * 2u;
    const unsigned kstep = (unsigned)(BK * 2);
    const unsigned hstep = (unsigned)HALF * K * 2;
    const unsigned tstep = 2 * hstep;
    const __amdgpu_buffer_rsrc_t rA = __builtin_amdgcn_make_buffer_rsrc((void*)g.A, 0, 0xffffffffu, 0x00020000), rB = __builtin_amdgcn_make_buffer_rsrc((void*)g.Bt, 0, 0xffffffffu, 0x00020000);
    const unsigned ldsw = (unsigned)wid * 1024u;
    const int aoff = lds_byte(wr * 64 + fr, fq * 8), boff = lds_byte(wc * 32 + fr, fq * 8);
#define PG8_SA(b, h) (((b) * 2 + (h)) * HTB)
#define PG8_SB(b, h) ((4 + (b) * 2 + (h)) * HTB)
#define PG8_STAGE(bufoff, rs, so, voff) do { _Pragma("unroll") for (int _i = 0; _i < 2; ++_i) \
        __builtin_amdgcn_raw_ptr_buffer_load_lds(rs, (LAS unsigned*)(lds + (bufoff) + ldsw + _i * 8192), 16, (int)(voff), (int)((so) + _i * qstep), 0, 0); } while (0)
#define PG8_LDA(dst, b, h) do { _Pragma("unroll") for (int m = 0; m < 4; ++m) _Pragma("unroll") for (int k = 0; k < 2; ++k) dst[m][k] = *(const LAS bf16x8*)(lds + PG8_SA(b, h) + aoff + m * 2048 + k * 1024); } while (0)
#define PG8_LDB(dst, b, h) do { _Pragma("unroll") for (int n = 0; n < 2; ++n) _Pragma("unroll") for (int k = 0; k < 2; ++k) dst[n][k] = *(const LAS bf16x8*)(lds + PG8_SB(b, h) + boff + n * 2048 + k * 1024); } while (0)
#define PG8_CAT(x0, x1) __builtin_shufflevector(__builtin_bit_cast(v4i_t, x0), __builtin_bit_cast(v4i_t, x1), 0, 1, 2, 3, 4, 5, 6, 7)
#define PG8_MMA(ai, bj, At, Bt) do { __builtin_amdgcn_s_setprio(1); _Pragma("unroll") for (int m = 0; m < 4; ++m) _Pragma("unroll") for (int n = 0; n < 2; ++n) { \
        if constexpr (F8) acc[ai][bj][m][n] = __builtin_amdgcn_mfma_scale_f32_16x16x128_f8f6f4(PG8_CAT(Bt[n][0], Bt[n][1]), PG8_CAT(At[m][0], At[m][1]), acc[ai][bj][m][n], 0, 0, 0, f8s, 1, f8s); \
        else if constexpr (I8) { _Pragma("unroll") for (int k = 0; k < 2; ++k) acc[ai][bj][m][n] = __builtin_bit_cast(f32x4, __builtin_amdgcn_mfma_i32_16x16x64_i8(__builtin_bit_cast(v4i_t, Bt[n][k]), __builtin_bit_cast(v4i_t, At[m][k]), __builtin_bit_cast(v4i_t, acc[ai][bj][m][n]), 0, 0, 0)); } \
        else { _Pragma("unroll") for (int k = 0; k < 2; ++k) acc[ai][bj][m][n] = __builtin_amdgcn_mfma_f32_16x16x32_bf16(Bt[n][k], At[m][k], acc[ai][bj][m][n], 0, 0, 0); } } \
        __builtin_amdgcn_s_setprio(0); } while (0)
#define PG8_WAIT_V(n) asm volatile("s_waitcnt vmcnt(" #n ")" ::: "memory")
#define PG8_WAIT_L(n) asm volatile("s_waitcnt lgkmcnt(" #n ")" ::: "memory")
#define PG8_BAR __builtin_amdgcn_s_barrier()
#define PG8_SCHED __builtin_amdgcn_sched_barrier(0)
    Unit cur, nxt; int ui = 0;
    if (!S.next(0, cur)) return;
    f32x4 acc[2][2][4][2];
#pragma unroll
    for (int a = 0; a < 2; ++a)
#pragma unroll
        for (int b = 0; b < 2; ++b)
#pragma unroll
            for (int m = 0; m < 4; ++m)
#pragma unroll
                for (int n = 0; n < 2; ++n) acc[a][b][m][n] = (f32x4){0.f, 0.f, 0.f, 0.f};
    bf16x8 At[4][2], B0[2][2], B1[2][2];
    unsigned cA = (unsigned)cur.am * tstep + (unsigned)cur.koff, cB = (unsigned)cur.bn * tstep + (unsigned)cur.koff;
    if constexpr (SP2) {
        PG8_STAGE(PG8_SB(0, 0), rB, cB, voffB); PG8_STAGE(PG8_SB(0, 1), rB, cB + hstep, voffB); PG8_STAGE(PG8_SA(0, 0), rA, cA, voffA); PG8_STAGE(PG8_SA(0, 1), rA, cA + hstep, voffA);
        if (wr == 1) PG8_BAR;
        PG8_WAIT_V(2); PG8_BAR;
        PG8_STAGE(PG8_SB(1, 0), rB, cB + kstep, voffB); PG8_STAGE(PG8_SA(1, 0), rA, cA + kstep, voffA); PG8_STAGE(PG8_SB(1, 1), rB, cB + hstep + kstep, voffB);
        PG8_WAIT_V(6); PG8_BAR;
    } else {
        PG8_STAGE(PG8_SB(0, 0), rB, cB, voffB); PG8_STAGE(PG8_SA(0, 0), rA, cA, voffA); PG8_STAGE(PG8_SB(0, 1), rB, cB + hstep, voffB); PG8_STAGE(PG8_SA(0, 1), rA, cA + hstep, voffA);
        if (wr == 1) PG8_BAR;
        PG8_WAIT_V(4); PG8_BAR;
        PG8_STAGE(PG8_SB(1, 0), rB, cB + kstep, voffB); PG8_STAGE(PG8_SA(1, 0), rA, cA + kstep, voffA); PG8_STAGE(PG8_SB(1, 1), rB, cB + hstep + kstep, voffB);
        PG8_WAIT_V(6); PG8_BAR;
    }
    for (;;) {
        const bool has_next = S.next(ui + 1, nxt);
        const unsigned nA = has_next ? (unsigned)nxt.am * tstep + (unsigned)nxt.koff : cA, nB = has_next ? (unsigned)nxt.bn * tstep + (unsigned)nxt.koff : cB;
#pragma unroll 1
        for (int t = 0; t < nt; t += 2) {
            const bool last = (t == nt - 2);
            const unsigned a1 = cA + (unsigned)(t + 1) * kstep;
            const unsigned a2 = last ? nA : cA + (unsigned)(t + 2) * kstep, b2 = last ? nB : cB + (unsigned)(t + 2) * kstep;
            const unsigned a3 = a2 + kstep, b3 = b2 + kstep;
            if constexpr (SP2) {
            PG8_LDB(B0, 0, 0); PG8_LDB(B1, 0, 1); PG8_SCHED; PG8_LDA(At, 0, 0); PG8_STAGE(PG8_SA(1, 1), rA, a1 + hstep, voffA);
            PG8_WAIT_V(8); PG8_WAIT_L(0); PG8_BAR; PG8_MMA(0, 0, At, B0); PG8_MMA(0, 1, At, B1); PG8_BAR; PG8_SCHED;
            PG8_LDA(At, 0, 1); PG8_STAGE(PG8_SB(0, 0), rB, b2, voffB); PG8_STAGE(PG8_SB(0, 1), rB, b2 + hstep, voffB); PG8_STAGE(PG8_SA(0, 0), rA, a2, voffA);
            PG8_WAIT_V(8); PG8_WAIT_L(0); PG8_BAR; PG8_MMA(1, 0, At, B0); PG8_MMA(1, 1, At, B1); PG8_BAR; PG8_SCHED;
            PG8_LDB(B0, 1, 0); PG8_LDB(B1, 1, 1); PG8_SCHED; PG8_LDA(At, 1, 0); PG8_STAGE(PG8_SA(0, 1), rA, a2 + hstep, voffA);
            PG8_WAIT_V(8); PG8_WAIT_L(0); PG8_BAR; PG8_MMA(0, 0, At, B0); PG8_MMA(0, 1, At, B1); PG8_BAR; PG8_SCHED;
            PG8_LDA(At, 1, 1); PG8_STAGE(PG8_SB(1, 0), rB, b3, voffB); PG8_STAGE(PG8_SB(1, 1), rB, b3 + hstep, voffB); PG8_STAGE(PG8_SA(1, 0), rA, a3, voffA);
            PG8_WAIT_V(8); PG8_WAIT_L(0); PG8_BAR; PG8_MMA(1, 0, At, B0); PG8_MMA(1, 1, At, B1); PG8_BAR; PG8_SCHED;
            } else {
            PG8_LDB(B0, 0, 0); PG8_SCHED; PG8_LDA(At, 0, 0); PG8_STAGE(PG8_SA(1, 1), rA, a1 + hstep, voffA);
            PG8_WAIT_L(8); PG8_BAR; PG8_WAIT_L(0); PG8_MMA(0, 0, At, B0); PG8_BAR; PG8_SCHED;
            PG8_LDB(B1, 0, 1); PG8_STAGE(PG8_SB(0, 0), rB, b2, voffB);
            PG8_BAR; PG8_WAIT_L(0); PG8_MMA(0, 1, At, B1); PG8_BAR;
            PG8_LDA(At, 0, 1); PG8_STAGE(PG8_SA(0, 0), rA, a2, voffA);
            PG8_BAR; PG8_WAIT_L(0); PG8_MMA(1, 0, At, B0); PG8_BAR; PG8_SCHED;
            PG8_STAGE(PG8_SB(0, 1), rB, b2 + hstep, voffB);
            PG8_WAIT_V(6); PG8_BAR; PG8_MMA(1, 1, At, B1); PG8_BAR;
            PG8_LDB(B0, 1, 0); PG8_SCHED; PG8_LDA(At, 1, 0); PG8_STAGE(PG8_SA(0, 1), rA, a2 + hstep, voffA);
            PG8_WAIT_L(8); PG8_BAR; PG8_WAIT_L(0); PG8_MMA(0, 0, At, B0); PG8_BAR; PG8_SCHED;
            PG8_LDB(B1, 1, 1); PG8_STAGE(PG8_SB(1, 0), rB, b3, voffB);
            PG8_BAR; PG8_WAIT_L(0); PG8_MMA(0, 1, At, B1); PG8_BAR;
            PG8_LDA(At, 1, 1); PG8_STAGE(PG8_SA(1, 0), rA, a3, voffA);
            PG8_BAR; PG8_WAIT_L(0); PG8_MMA(1, 0, At, B0); PG8_BAR; PG8_SCHED;
            PG8_STAGE(PG8_SB(1, 1), rB, b3 + hstep, voffB);
            PG8_WAIT_V(6); PG8_BAR; PG8_MMA(1, 1, At, B1); PG8_BAR;
            }
        }
        if constexpr (ALIGN_EPI) { if (wr == 0) PG8_BAR; }
        if constexpr (I8) {
#pragma unroll
            for (int a = 0; a < 2; ++a)
#pragma unroll
                for (int b = 0; b < 2; ++b)
#pragma unroll
                    for (int m = 0; m < 4; ++m)
#pragma unroll
                        for (int n = 0; n < 2; ++n) acc[a][b][m][n] = __builtin_convertvector(__builtin_bit_cast(v4i_t, acc[a][b][m][n]), f32x4); }
        if constexpr (!Epi::AFTER_DRAIN) { E(acc, cur, wr, wc, fr, fq); }
        if (!has_next) break;
#pragma unroll
        for (int a = 0; a < 2; ++a)
#pragma unroll
            for (int b = 0; b < 2; ++b)
#pragma unroll
                for (int m = 0; m < 4; ++m)
#pragma unroll
                    for (int n = 0; n < 2; ++n) acc[a][b][m][n] = (f32x4){0.f, 0.f, 0.f, 0.f};
        cur = nxt; cA = nA; cB = nB; ++ui;
        if constexpr (ALIGN_EPI) { if (wr == 1) PG8_BAR; }
    }
    PG8_WAIT_V(0);
    if constexpr (!ALIGN_EPI) { if (wr == 0) PG8_BAR; }
    PG8_BAR;
    if constexpr (Epi::AFTER_DRAIN) { E.fused(acc, cur, wr, wc, fr, fq, lds, wid, lane); }
#undef PG8_SA
#undef PG8_SB
#undef PG8_STAGE
#undef PG8_LDA
#undef PG8_LDB
#undef PG8_MMA
#undef PG8_CAT
#undef PG8_WAIT_V
#undef PG8_WAIT_L
#undef PG8_BAR
#undef PG8_SCHED
}
}

#define XB_TMO      128
#define XB_XCNT(j)  (256  + 64 * (j))
#define XB_XSUB(j)  (1280 + 64 * (j))
#define XB_XGEN(j)  (2304 + 64 * (j))
#define XB_TOP      3328
#define XB_TOPGEN   3392
#define XCD_BAR_WORDS 3456
#define XB_SPIN_CAP (1u << 18)
__device__ __forceinline__ unsigned xb_ld(unsigned* p)              { return __hip_atomic_load(p, __ATOMIC_RELAXED, __HIP_MEMORY_SCOPE_AGENT); }
__device__ __forceinline__ unsigned xb_add(unsigned* p, unsigned v) { return __hip_atomic_fetch_add(p, v, __ATOMIC_RELAXED, __HIP_MEMORY_SCOPE_AGENT); }
__device__ __forceinline__ unsigned xb_xcc_id() { return (unsigned)__builtin_amdgcn_s_getreg((3 << 11) | 20) & 0xFu; }
#define XB_SPIN(cond, bar) do { unsigned _sp = 0; while (cond) { __builtin_amdgcn_s_sleep(1); \
    if ((++_sp & 255u) == 0u) { if (xb_ld(&(bar)[XB_TMO])) break; if (_sp > XB_SPIN_CAP) { atomicAdd(&(bar)[XB_TMO], 1u); break; } } } } while (0)
struct XcdBarrier { unsigned* bar; unsigned x; volatile LAS unsigned* st; int wave; };
__device__ __forceinline__ XcdBarrier xcd_barrier_post(unsigned* bar, volatile LAS unsigned* st, int wave) {
    XcdBarrier b; b.bar = bar; b.x = xb_xcc_id(); b.st = st; b.wave = wave;
    if (wave == 0 && lane_now() == 0) (void)xb_add(&bar[XB_XCNT(b.x)], 1u);
    return b;
}
__device__ __forceinline__ void xcd_barrier_complete(unsigned* bar, unsigned x, unsigned& nloc, unsigned& nx) {
    const unsigned G = gridDim.x * gridDim.y * gridDim.z;
    unsigned sum, cnt, mine, sp = 0u;
    for (;;) {
        sum = 0u; cnt = 0u; mine = 0u;
#pragma unroll
        for (unsigned j = 0; j < 16; ++j) { const unsigned c = xb_ld(&bar[XB_XCNT(j)]); sum += c; cnt += (c > 0u) ? 1u : 0u; mine = (j == x) ? c : mine; }
        if (sum == G) break;
        __builtin_amdgcn_s_sleep(1);
        if ((++sp & 255u) == 0u) { if (xb_ld(&bar[XB_TMO])) break; if (sp > XB_SPIN_CAP) { atomicAdd(&bar[XB_TMO], 1u); break; } }
    }
    nloc = mine > 0u ? mine : 1u; nx = cnt > 0u ? cnt : 1u;
}
__device__ __forceinline__ void xcd_barrier(const XcdBarrier& b) {
    asm volatile("s_waitcnt vmcnt(0)" ::: "memory");
    __syncthreads();
    if (b.wave == 0 && lane_now() == 0) {
        unsigned* bar = b.bar;
        __builtin_amdgcn_s_waitcnt(0);
        unsigned nloc = b.st[0], nx = b.st[1];
        if (nloc == 0u) { xcd_barrier_complete(bar, b.x, nloc, nx); b.st[0] = nloc; b.st[1] = nx; }
        const unsigned old = xb_add(&bar[XB_XSUB(b.x)], 1u);
        const unsigned gen = old / nloc;
        if (old + 1u == (gen + 1u) * nloc) {
            __builtin_amdgcn_fence(__ATOMIC_RELEASE, "agent");
            asm volatile("s_waitcnt vmcnt(0)" ::: "memory");
            const unsigned og = xb_add(&bar[XB_TOP], 1u);
            const unsigned tg = og / nx;
            if (og + 1u == (tg + 1u) * nx) xb_add(&bar[XB_TOPGEN], 1u);
            else XB_SPIN(xb_ld(&bar[XB_TOPGEN]) == tg, bar);
            __builtin_amdgcn_fence(__ATOMIC_ACQUIRE, "agent");
            xb_add(&bar[XB_XGEN(b.x)], 1u);
            asm volatile("s_waitcnt vmcnt(0)" ::: "memory");
        } else {
            XB_SPIN(xb_ld(&bar[XB_XGEN(b.x)]) == gen, bar);
            __builtin_amdgcn_fence(__ATOMIC_ACQUIRE, "agent");
            asm volatile("s_waitcnt vmcnt(0)" ::: "memory");
        }
    }
    __syncthreads();
}

typedef const __attribute__((address_space(4))) unsigned char* kptr_t;
struct Frame {
    LAS unsigned char* lds;
    int wave, vcu, G;
    kptr_t kp;
    float* out; unsigned char* ws;
};
__device__ __forceinline__ const float* inp(const Frame& F, int i) { kptr_t p = F.kp; asm volatile("" : "+s"(p)); return *(const float* const __attribute__((address_space(4)))*)(p + 8 * i); }
#define WSP(T, off) ((T*)(F.ws + (off)))

__device__ const double INVF_REV[32] = {0.15915494309189535, 0.11934937021124886, 0.089499401608891013, 0.067115083005227255, 0.050329212104487035, 0.037741584717419778, 0.028302195830623399, 0.02122365276477766,
    0.015915494309189534, 0.011934937021124886, 0.0089499401608891006, 0.0067115083005227253, 0.0050329212104487037, 0.0037741584717419768, 0.0028302195830623399, 0.0021223652764777662,
    0.0015915494309189536, 0.0011934937021124887, 0.00089499401608891024, 0.0006711508300522726, 0.00050329212104487043, 0.00037741584717419774, 0.00028302195830623401, 0.00021223652764777661,
    0.00015915494309189535, 0.00011934937021124886, 8.9499401608891018e-05, 6.7115083005227268e-05, 5.0329212104487035e-05, 3.7741584717419777e-05, 2.8302195830623399e-05, 2.1223652764777659e-05};

template <bool F8 = false>
__device__ __forceinline__ void tr_tile64(const float* W, int N, const float* gain, bf16_t* WT, int ldt, int drow, int k0, int ncol, int rg, float sc = 1.0f) {
    const float* src = W + (size_t)(k0 + rg * 16) * N + ncol;
    f32x4 v[16];
#pragma unroll
    for (int i = 0; i < 16; ++i) v[i] = __builtin_nontemporal_load((const f32x4*)(src + (size_t)i * N));
    if (gain) { f32x4 g[4];
#pragma unroll
        for (int q = 0; q < 4; ++q) g[q] = *(const f32x4*)(gain + k0 + rg * 16 + 4 * q);
#pragma unroll
        for (int i = 0; i < 16; ++i) v[i] = v[i] * g[i >> 2][i & 3]; }
    if constexpr (F8) {
#pragma unroll
        for (int j = 0; j < 4; ++j) { u32x4 a;
            a.x = pk4_fp8(v[0][j] * sc, v[1][j] * sc, v[2][j] * sc, v[3][j] * sc); a.y = pk4_fp8(v[4][j] * sc, v[5][j] * sc, v[6][j] * sc, v[7][j] * sc);
            a.z = pk4_fp8(v[8][j] * sc, v[9][j] * sc, v[10][j] * sc, v[11][j] * sc); a.w = pk4_fp8(v[12][j] * sc, v[13][j] * sc, v[14][j] * sc, v[15][j] * sc);
            *(u32x4*)((unsigned char*)WT + (size_t)(drow + j) * ldt + k0 + rg * 16) = a; }
        return; }
#pragma unroll
    for (int j = 0; j < 4; ++j) { u32x4 a, b;
        a.x = cvt_pk_bf16(v[0][j], v[1][j]); a.y = cvt_pk_bf16(v[2][j], v[3][j]); a.z = cvt_pk_bf16(v[4][j], v[5][j]); a.w = cvt_pk_bf16(v[6][j], v[7][j]);
        b.x = cvt_pk_bf16(v[8][j], v[9][j]); b.y = cvt_pk_bf16(v[10][j], v[11][j]); b.z = cvt_pk_bf16(v[12][j], v[13][j]); b.w = cvt_pk_bf16(v[14][j], v[15][j]);
        bf16_t* d = WT + (size_t)(drow + j) * ldt + k0 + rg * 16; *(u32x4*)d = a; *(u32x4*)(d + 8) = b; }
}
template <bool F8>
__device__ __forceinline__ void tr_tile128(const float* W, int N, const float* gain, unsigned char* WT  , int ldt  , int k0, int ncol, int rg, float sc) {
    f32x4 v[16];
    if constexpr (F8) { const float* src = W + (size_t)(k0 + rg * 16) * N + ncol;
#pragma unroll
        for (int i = 0; i < 16; ++i) v[i] = __builtin_nontemporal_load((const f32x4*)(src + (size_t)i * N));
        if (gain) { f32x4 g[4];
#pragma unroll
            for (int q = 0; q < 4; ++q) g[q] = *(const f32x4*)(gain + k0 + rg * 16 + 4 * q);
#pragma unroll
            for (int i = 0; i < 16; ++i) v[i] = v[i] * (g[i >> 2][i & 3] * sc); }
        else {
#pragma unroll
            for (int i = 0; i < 16; ++i) v[i] = v[i] * sc; }
#pragma unroll
        for (int j = 0; j < 4; ++j) { u32x4 a;
            a.x = pk4_fp8(v[0][j], v[1][j], v[2][j], v[3][j]); a.y = pk4_fp8(v[4][j], v[5][j], v[6][j], v[7][j]);
            a.z = pk4_fp8(v[8][j], v[9][j], v[10][j], v[11][j]); a.w = pk4_fp8(v[12][j], v[13][j], v[14][j], v[15][j]);
            *(u32x4*)(WT + (size_t)j * ldt + rg * 16) = a; } }
    else { const float* src = W + (size_t)(k0 + rg * 8) * N + ncol;
#pragma unroll
        for (int i = 0; i < 8; ++i) { v[i] = __builtin_nontemporal_load((const f32x4*)(src + (size_t)i * N)); v[8 + i] = __builtin_nontemporal_load((const f32x4*)(src + (size_t)(64 + i) * N)); }
        if (gain) { f32x4 g[4];
#pragma unroll
            for (int q = 0; q < 2; ++q) { g[q] = *(const f32x4*)(gain + k0 + rg * 8 + 4 * q); g[2 + q] = *(const f32x4*)(gain + k0 + 64 + rg * 8 + 4 * q); }
#pragma unroll
            for (int i = 0; i < 16; ++i) v[i] = v[i] * g[i >> 2][i & 3]; }
#pragma unroll
        for (int j = 0; j < 4; ++j) { u32x4 a, b;
            a.x = cvt_pk_bf16(v[0][j], v[1][j]); a.y = cvt_pk_bf16(v[2][j], v[3][j]); a.z = cvt_pk_bf16(v[4][j], v[5][j]); a.w = cvt_pk_bf16(v[6][j], v[7][j]);
            b.x = cvt_pk_bf16(v[8][j], v[9][j]); b.y = cvt_pk_bf16(v[10][j], v[11][j]); b.z = cvt_pk_bf16(v[12][j], v[13][j]); b.w = cvt_pk_bf16(v[14][j], v[15][j]);
            *(u32x4*)(WT + (size_t)j * ldt + rg * 16) = a; *(u32x4*)(WT + (size_t)j * ldt + 128 + rg * 16) = b; } }
}
__device__ __forceinline__ void norm_row_bf16(const float* xrow, bf16_t* orow, bf16_t* raw, float* rs, int lane) {
    const f32x4* xr = (const f32x4*)xrow + lane; f32x4 v[8]; float s = 0.f;
#pragma unroll
    for (int j = 0; j < 8; ++j) { v[j] = xr[64 * j]; s += (v[j][0] * v[j][0] + v[j][1] * v[j][1]) + (v[j][2] * v[j][2] + v[j][3] * v[j][3]); }
    const float r = 1.0f * __builtin_amdgcn_rsqf(wave_sum(s) * (1.0f / 2048.0f) + EPS);
    if (orow) { u32x2* o8 = (u32x2*)orow + lane;
#pragma unroll
        for (int j = 0; j < 8; ++j) { u32x2 w; w.x = cvt_pk_bf16(v[j][0] * r, v[j][1] * r); w.y = cvt_pk_bf16(v[j][2] * r, v[j][3] * r); o8[64 * j] = w; } }
    if (raw) { u32x2* r8 = (u32x2*)raw + lane;
#pragma unroll
        for (int j = 0; j < 8; ++j) { u32x2 w; w.x = cvt_pk_bf16(v[j][0], v[j][1]); w.y = cvt_pk_bf16(v[j][2], v[j][3]); r8[64 * j] = w; } }
    if (rs && lane == 0) *rs = r;
}
struct TrItem { const float* src; const float* gain; unsigned char* dst; int N, ldt, hi_rows, g_hi; float sc; int f8, useg; };
__device__ __forceinline__ void tr_load16(f32x4 (&v)[16], f32x4 (&g)[4], const TrItem& it) {
#pragma unroll
    for (int i = 0; i < 8; ++i) { v[i] = __builtin_nontemporal_load((const f32x4*)(it.src + (size_t)i * it.N)); v[8 + i] = __builtin_nontemporal_load((const f32x4*)(it.src + (size_t)(it.hi_rows + i) * it.N)); }
#pragma unroll
    for (int q = 0; q < 2; ++q) { const f32x4 a = *(const f32x4*)(it.gain + 4 * q), b = *(const f32x4*)(it.gain + it.g_hi + 4 * q);
        g[q] = it.useg ? a : (f32x4){1.f, 1.f, 1.f, 1.f}; g[2 + q] = it.useg ? b : (f32x4){1.f, 1.f, 1.f, 1.f}; }
}
__device__ __forceinline__ void tr_store16(f32x4 (&v)[16], const f32x4 (&g)[4], const TrItem& it) {
#pragma unroll
    for (int i = 0; i < 16; ++i) v[i] = v[i] * (g[i >> 2][i & 3] * it.sc);
    if (it.f8 == 2) {
#pragma unroll
        for (int j = 0; j < 4; ++j) { u32x4 a;
            a.x = pk4_i8(v[0][j], v[1][j], v[2][j], v[3][j]); a.y = pk4_i8(v[4][j], v[5][j], v[6][j], v[7][j]);
            a.z = pk4_i8(v[8][j], v[9][j], v[10][j], v[11][j]); a.w = pk4_i8(v[12][j], v[13][j], v[14][j], v[15][j]);
            __builtin_nontemporal_store(a, (u32x4*)(it.dst + (size_t)j * it.ldt)); } }
    else if (it.f8) {
#pragma unroll
        for (int j = 0; j < 4; ++j) { u32x4 a;
            a.x = pk4_fp8(v[0][j], v[1][j], v[2][j], v[3][j]); a.y = pk4_fp8(v[4][j], v[5][j], v[6][j], v[7][j]);
            a.z = pk4_fp8(v[8][j], v[9][j], v[10][j], v[11][j]); a.w = pk4_fp8(v[12][j], v[13][j], v[14][j], v[15][j]);
            __builtin_nontemporal_store(a, (u32x4*)(it.dst + (size_t)j * it.ldt)); } }
    else {
#pragma unroll
        for (int j = 0; j < 4; ++j) { u32x4 a, b;
            a.x = cvt_pk_bf16(v[0][j], v[1][j]); a.y = cvt_pk_bf16(v[2][j], v[3][j]); a.z = cvt_pk_bf16(v[4][j], v[5][j]); a.w = cvt_pk_bf16(v[6][j], v[7][j]);
            b.x = cvt_pk_bf16(v[8][j], v[9][j]); b.y = cvt_pk_bf16(v[10][j], v[11][j]); b.z = cvt_pk_bf16(v[12][j], v[13][j]); b.w = cvt_pk_bf16(v[14][j], v[15][j]);
            __builtin_nontemporal_store(a, (u32x4*)(it.dst + (size_t)j * it.ldt)); __builtin_nontemporal_store(b, (u32x4*)(it.dst + (size_t)j * it.ldt + 128)); } }
}
__device__ __forceinline__ void p0_prologue(Frame& F) {
    const int gw = F.vcu * 8 + F.wave, NGW = F.G * 8, lane = lane_now(), c4 = (lane & 15) * 4, rg = lane >> 4;
    const float* g_mix = inp(F, 3); const float* g_ffn = inp(F, 4); const float* g_mem = inp(F, 5);
    constexpr int IT_E = 3584;
    constexpr int I_MOE = 24 * IT_E, I_FFN = 3 * IT_E, I_IN0 = 32 * 80, I_OUT = 32 * 32, I_KVA = 32 * 5, I_BIN = 32 * 16, I_KVB = 4 * 48, I_QB = 8 * 36, I_MEM = 32 * 16;
    constexpr int NITEMS = I_MOE + I_FFN + I_IN0 + 2 * I_OUT + I_KVA + I_BIN + I_KVB + I_QB + 2 * I_MEM;
    {
      const int rg8 = lane & 7, c8 = (lane >> 3) * 4;
      auto decode = [&](int r) -> TrItem { TrItem t;
          const int e = r / (3 * IT_E), q = r % (3 * IT_E), kind = q / IT_E, j = q % IT_E; const bool moe = e < 8;
          if (kind < 2) { const float* W = moe ? inp(F, kind == 0 ? 25 : 26) + (size_t)e * DM * DFF : inp(F, kind == 0 ? 21 : 22);
              const int kb = j / 224, nb = j % 224, n = nb * 32 + c8, drow = (n >> 7) * 256 + (n & 127) + (kind ? 128 : 0), k0 = kb * 128, kl = k0 + 16 * rg8;
              t.src = W + (size_t)kl * DFF + n; t.N = DFF; t.hi_rows = 8; t.g_hi = 8; t.gain = g_ffn + (moe ? DM : 0) + kl; t.useg = 1; t.f8 = 2; t.sc = QWGU;
              t.ldt = DM; t.dst = (moe ? F.ws + WS_W_MGU + (size_t)e * 2 * DFF * DM : F.ws + WS_W_GU0) + (size_t)drow * DM + k0 + rg8 * 16; }
          else { const float* W = moe ? inp(F, 27) + (size_t)e * DFF * DM : inp(F, 23);
              const int kb = j / 64, nb = j % 64, n = nb * 32 + c8, k0 = kb * 128, kl = k0 + 16 * rg8;
              t.src = W + (size_t)kl * DM + n; t.N = DM; t.hi_rows = 8; t.g_hi = 8; t.gain = g_ffn; t.useg = 0; t.f8 = 2; t.sc = QWD;
              t.ldt = DFF; t.dst = (moe ? F.ws + WS_W_MD + (size_t)e * DM * DFF : F.ws + WS_W_D0) + (size_t)n * DFF + k0 + rg8 * 16; }
          return t; };
      constexpr int NBIG = I_MOE + I_FFN, NIT = 2 * ((NBIG + 2 * 2048 - 1) / (2 * 2048));
      auto item_of = [&](int k) -> int { const int kk = k < NIT - 1 ? k : NIT - 1; const int r = gw * 2 + (kk & 1) + (kk >> 1) * (2 * NGW); return NBIG - 1 - (r < NBIG ? r : r - 2 * NGW); };
      TrItem ia = decode(item_of(0)), ib; f32x4 va[16], ga[4], vb[16], gb[4]; tr_load16(va, ga, ia);
      for (int k = 0; k < NIT; k += 2) {
          ib = decode(item_of(k + 1)); tr_load16(vb, gb, ib);
          tr_store16(va, ga, ia);
          ia = decode(item_of(k + 2)); tr_load16(va, ga, ia);
          tr_store16(vb, gb, ib); } }
    for (int it = (I_MOE + I_FFN) + gw; it < NITEMS; it += NGW) {
        int r = it;
        r -= I_MOE + I_FFN;
        { const int rg8 = lane & 7, c8 = (lane >> 3) * 4;
        if (r < I_IN0) { const int k0 = (r / 160) * 128, n = (r % 160) * 32 + c8; tr_tile128<false>(inp(F, 10), NIN0, g_mix, F.ws + WS_W_IN0 + ((size_t)n * DM + k0) * 2, DM * 2, k0, n, rg8, 1.0f); continue; } r -= I_IN0;
        if (r < 2 * I_OUT) { const int l = r / I_OUT, j = r % I_OUT, k0 = (j / 64) * 128, n = (j % 64) * 32 + c8;
            if (l) tr_tile128<true>(inp(F, 9) + (size_t)DM * DM, DM, nullptr, F.ws + WS_W_OUT1 + (size_t)n * DM + k0, DM, k0, n, rg8, 64.0f);
            else tr_tile128<false>(inp(F, 9), DM, nullptr, F.ws + WS_W_OUT0 + ((size_t)n * DM + k0) * 2, DM * 2, k0, n, rg8, 1.0f); continue; } r -= 2 * I_OUT;
        if (r < I_KVA) { const int k0 = (r / 10) * 128, n = (r % 10) * 32 + c8; tr_tile128<true>(inp(F, 17), 320, inp(F, 16), F.ws + WS_W_1 + (size_t)n * DM + k0, DM, k0, n, rg8, 64.0f); continue; } r -= I_KVA;
        if (r < I_BIN) { const int k0 = (r / 32) * 128, n = (r % 32) * 32 + c8; tr_tile128<true>(inp(F, 12), 1024, g_mix + DM, F.ws + WS_W_1 + (size_t)(512 + n) * DM + k0, DM, k0, n, rg8, 64.0f); continue; } r -= I_BIN;
        if (r < I_KVB) { const int k0 = (r / 96) * 128, n = (r % 96) * 32 + c8, h = n >> 8, j = n & 255;
            tr_tile128<false>(inp(F, 19), 3072, inp(F, 18), F.ws + (j < 128 ? WS_W_KN : WS_W_V) + ((size_t)(h * 128 + (j & 127)) * 256 + k0) * 2, 512, k0, n, rg8, 1.0f); continue; } r -= I_KVB;
        if (r < I_QB) { const int k0 = (r / 72) * 128, n = (r % 72) * 32 + c8; tr_tile128<false>(inp(F, 14), 2304, inp(F, 13), F.ws + WS_W_QB + ((size_t)n * 512 + k0) * 2, 1024, k0, n, rg8, 1.0f); continue; } r -= I_QB;
        { const int l = r / I_MEM, j = r % I_MEM, k0 = (j / 32) * 128, n = (j % 32) * 32 + c8;
            tr_tile128<false>(inp(F, 6) + (size_t)l * DM * 1024, 1024, g_mem + l * DM, F.ws + (n < 512 ? WS_W_MK : WS_W_MV) + ((size_t)(l * 512 + (n & 511)) * DM + k0) * 2, DM * 2, k0, n, rg8, 1.0f); } }
    }
    for (int m = gw; m < NTOK; m += 2 * NGW) {
        const f32x4* xa = (const f32x4*)(inp(F, 0) + (size_t)m * DM) + lane; const f32x4* xc = xa + (size_t)NGW * (DM / 4); f32x4 va[8], vc[8]; float sa = 0.f, sc = 0.f;
#pragma unroll
        for (int j = 0; j < 8; ++j) { va[j] = xa[64 * j]; vc[j] = xc[64 * j]; }
#pragma unroll
        for (int j = 0; j < 8; ++j) { sa += (va[j][0] * va[j][0] + va[j][1] * va[j][1]) + (va[j][2] * va[j][2] + va[j][3] * va[j][3]); sc += (vc[j][0] * vc[j][0] + vc[j][1] * vc[j][1]) + (vc[j][2] * vc[j][2] + vc[j][3] * vc[j][3]); }
        sa = wave_sum(sa); sc = wave_sum(sc);
        u32x2* ra = (u32x2*)(WSP(bf16_t, WS_XB) + (size_t)m * DM) + lane; u32x2* rc = ra + (size_t)NGW * (DM / 4);
#pragma unroll
        for (int j = 0; j < 8; ++j) { u32x2 w; w.x = cvt_pk_bf16(va[j][0], va[j][1]); w.y = cvt_pk_bf16(va[j][2], va[j][3]); ra[64 * j] = w; w.x = cvt_pk_bf16(vc[j][0], vc[j][1]); w.y = cvt_pk_bf16(vc[j][2], vc[j][3]); rc[64 * j] = w; }
        if (lane == 0) { WSP(float, WS_RS0)[m] = 1.0f * __builtin_amdgcn_rsqf(sa * (1.0f / 2048.0f) + EPS); WSP(float, WS_RS0)[m + NGW] = 1.0f * __builtin_amdgcn_rsqf(sc * (1.0f / 2048.0f) + EPS); } }
    for (int m = gw; m < 512; m += NGW) norm_row_bf16(inp(F, 1) + (size_t)m * DM, WSP(bf16_t, WS_MEMN) + (size_t)m * DM, nullptr, nullptr, lane);
    const int gt = F.vcu * 512 + F.wave * 64 + lane_now(), NGT = F.G * 512;
    for (int i = gt; i < 8 * DM; i += NGT) { const int e = i / DM, k = i % DM; WSP(float, WS_WR)[i] = g_ffn[DM + k] * inp(F, 24)[k * 8 + e]; }
    for (int i = gt; i < 192 * DM / 16; i += NGT) ((u32x4*)(F.ws + WS_W_1 + (size_t)320 * DM))[i] = (u32x4){0u, 0u, 0u, 0u};
}

__device__ __forceinline__ void unpack8(const u32x4 w, float (&f)[8]) { f[0] = bf_lo(w.x); f[1] = bf_hi(w.x); f[2] = bf_lo(w.y); f[3] = bf_hi(w.y); f[4] = bf_lo(w.z); f[5] = bf_hi(w.z); f[6] = bf_lo(w.w); f[7] = bf_hi(w.w); }
__device__ __forceinline__ void p2_conv(Frame& F) {
    const bf16_t* U0 = WSP(bf16_t, WS_U0); bf16_t* CAT = WSP(bf16_t, WS_CAT); const float* cw = inp(F, 11);
    const int gt = F.vcu * 512 + F.wave * 64 + lane_now(), NGT = F.G * 512;
    for (int idx = gt; idx < NTOK * 192; idx += NGT) {
        const int t = idx / 192, c = (idx % 192) * 8, s = t & (SEQ - 1);
        const bf16_t* r0 = U0 + (size_t)t * NIN0 + c; const bf16_t* r1 = r0 - (s >= 1 ? NIN0 : 0); const bf16_t* r2 = r0 - (s >= 2 ? 2 * NIN0 : 0);
        const u32x4 qx0 = *(const u32x4*)r0, qg0 = *(const u32x4*)(r0 + 3072), qb = *(const u32x4*)(r0 + 1536), qx1 = *(const u32x4*)r1, qg1 = *(const u32x4*)(r1 + 3072), qx2 = *(const u32x4*)r2, qg2 = *(const u32x4*)(r2 + 3072);
        const f32x4 w2a = *(const f32x4*)(cw + 2 * 1536 + c), w2b = *(const f32x4*)(cw + 2 * 1536 + c + 4), w1a = *(const f32x4*)(cw + 1536 + c), w1b = *(const f32x4*)(cw + 1536 + c + 4), w0a = *(const f32x4*)(cw + c), w0b = *(const f32x4*)(cw + c + 4);
        const float m1 = s >= 1 ? 1.0f : 0.0f, m2 = s >= 2 ? 1.0f : 0.0f;
        float xin[8], gc[8], gb[8], y[8];
        unpack8(qx0, xin); unpack8(qg0, gc); unpack8(qb, gb);
#pragma unroll
        for (int i = 0; i < 8; ++i) y[i] = (i < 4 ? w2a[i] : w2b[i - 4]) * (gc[i] * xin[i]);
        unpack8(qx1, xin); unpack8(qg1, gc);
#pragma unroll
        for (int i = 0; i < 8; ++i) y[i] += (m1 * (i < 4 ? w1a[i] : w1b[i - 4])) * (gc[i] * xin[i]);
        unpack8(qx2, xin); unpack8(qg2, gc);
#pragma unroll
        for (int i = 0; i < 8; ++i) y[i] += (m2 * (i < 4 ? w0a[i] : w0b[i - 4])) * (gc[i] * xin[i]);
        u32x4 o; o.x = cvt_pk_bf16(gb[0] * y[0], gb[1] * y[1]); o.y = cvt_pk_bf16(gb[2] * y[2], gb[3] * y[3]); o.z = cvt_pk_bf16(gb[4] * y[4], gb[5] * y[5]); o.w = cvt_pk_bf16(gb[6] * y[6], gb[7] * y[7]);
        *(u32x4*)(CAT + (size_t)t * DM + c) = o;
    }
}
constexpr float CMEM = 0.08838834764831845f * LOG2E;
constexpr float CMLA = 0.07216878364870323f * LOG2E;
__device__ __forceinline__ int crow(int r, int hi) { return (r & 3) + 8 * (r >> 2) + 4 * hi; }
template <int NK16, bool CAUSAL, bool OUT8 = false>
__device__ __forceinline__ void attn_wave(const bf16_t* Qp, const bf16_t* Kp, const bf16_t* Vt, int ldv, int ntiles, bf16_t* Op, int ldo, int lane, int kt0 = 0, LAS float* xch = nullptr, int xrole = -1, const float* qgain = nullptr, int ldq = 0, float qscale = 0.f) {
    constexpr int DQK = NK16 * 16;
    const int r32 = lane & 31, hi = lane >> 5;
    bf16x8 qf[NK16];
    if (qgain) { u32x4 raw[NK16]; float ss = 0.f;
#pragma unroll
        for (int d0 = 0; d0 < NK16; ++d0) raw[d0] = *(const u32x4*)(Qp + (size_t)r32 * ldq + d0 * 16 + hi * 8);
#pragma unroll
        for (int d0 = 0; d0 < NK16; ++d0) { float a[8]; unpack8(raw[d0], a);
#pragma unroll
            for (int e = 0; e < 8; ++e) ss += a[e] * a[e]; }
        ss += other_half(ss, lane);
        const float r = qscale * __builtin_amdgcn_rsqf(ss * (1.0f / DQK) + EPS);
#pragma unroll
        for (int d0 = 0; d0 < NK16; ++d0) { float a[8]; unpack8(raw[d0], a); const f32x4 g0 = *(const f32x4*)(qgain + d0 * 16 + hi * 8), g1 = *(const f32x4*)(qgain + d0 * 16 + hi * 8 + 4);
            u32x4 wv; wv.x = cvt_pk_bf16(a[0] * r * g0[0], a[1] * r * g0[1]); wv.y = cvt_pk_bf16(a[2] * r * g0[2], a[3] * r * g0[3]); wv.z = cvt_pk_bf16(a[4] * r * g1[0], a[5] * r * g1[1]); wv.w = cvt_pk_bf16(a[6] * r * g1[2], a[7] * r * g1[3]);
            qf[d0] = __builtin_bit_cast(bf16x8, wv); } }
    else {
#pragma unroll
        for (int d0 = 0; d0 < NK16; ++d0) qf[d0] = *(const bf16x8*)(Qp + (size_t)r32 * DQK + d0 * 16 + hi * 8); }
    f32x16 o[4]; float m = -1e30f, l = 0.f;
#pragma unroll
    for (int db = 0; db < 4; ++db)
#pragma unroll
        for (int r = 0; r < 16; ++r) o[db][r] = 0.f;
    bf16x8 kf[NK16], vf[4][2];
    auto ldk = [&](int kt) { const bf16_t* kr = Kp + (size_t)(kt * 32 + r32) * DQK + hi * 8;
#pragma unroll
        for (int d0 = 0; d0 < NK16; ++d0) kf[d0] = *(const bf16x8*)(kr + d0 * 16); };
    auto ldvt = [&](int kt) { const bf16_t* vr0 = Vt + (size_t)r32 * ldv + kt * 32 + hi * 8;
#pragma unroll
        for (int db = 0; db < 4; ++db)
#pragma unroll
            for (int ks = 0; ks < 2; ++ks) vf[db][ks] = *(const bf16x8*)(vr0 + (size_t)(db * 32) * ldv + ks * 16); };
    ldk(kt0); ldvt(kt0);
    for (int kt = kt0; kt < ntiles; ++kt) {
        const int ktn = kt + 1 < ntiles ? kt + 1 : kt;
        f32x16 p;
#pragma unroll
        for (int r = 0; r < 16; ++r) p[r] = 0.f;
        __builtin_amdgcn_sched_barrier(0);
#pragma unroll
        for (int d0 = 0; d0 < NK16; ++d0) p = __builtin_amdgcn_mfma_f32_32x32x16_bf16(kf[d0], qf[d0], p, 0, 0, 0);
        __builtin_amdgcn_sched_barrier(0);
        ldk(ktn);
        __builtin_amdgcn_sched_barrier(0);
        if (CAUSAL && kt == ntiles - 1) {
#pragma unroll
            for (int r = 0; r < 16; ++r) if (crow(r, hi) > r32) p[r] = -__builtin_inff();
        }
        float pm = p[0];
#pragma unroll
        for (int r = 1; r < 16; ++r) pm = fmaxf(pm, p[r]);
        pm = half_max(pm);
        const float mn = fmaxf(m, pm), alpha = __builtin_amdgcn_exp2f(m - mn); m = mn;
        float ps = 0.f;
#pragma unroll
        for (int r = 0; r < 16; ++r) { p[r] = __builtin_amdgcn_exp2f(p[r] - mn); ps += p[r]; }
        ps = half_sum(ps); l = l * alpha + ps;
        if (!__all(alpha == 1.0f)) {
#pragma unroll
            for (int db = 0; db < 4; ++db)
#pragma unroll
                for (int r = 0; r < 16; ++r) o[db][r] *= alpha;
        }
        bf16x8 pa[2];
#pragma unroll
        for (int ks = 0; ks < 2; ++ks) { const unsigned a0 = cvt_pk_bf16(p[8 * ks + 0], p[8 * ks + 1]), a1 = cvt_pk_bf16(p[8 * ks + 2], p[8 * ks + 3]), b0 = cvt_pk_bf16(p[8 * ks + 4], p[8 * ks + 5]), b1 = cvt_pk_bf16(p[8 * ks + 6], p[8 * ks + 7]);
            auto r0 = __builtin_amdgcn_permlane32_swap(a0, b0, false, false); auto r1 = __builtin_amdgcn_permlane32_swap(a1, b1, false, false);
            u32x4 w = {r0[0], r1[0], r0[1], r1[1]}; pa[ks] = __builtin_bit_cast(bf16x8, w); }
#pragma unroll
        for (int ks = 0; ks < 2; ++ks)
#pragma unroll
            for (int db = 0; db < 4; ++db) o[db] = __builtin_amdgcn_mfma_f32_32x32x16_bf16(vf[db][ks], pa[ks], o[db], 0, 0, 0);
        __builtin_amdgcn_sched_barrier(0);
        ldvt(ktn);
    }
    if (xrole >= 0) {
        if (xrole == 1) {
#pragma unroll
            for (int db = 0; db < 4; ++db)
#pragma unroll
                for (int r = 0; r < 16; ++r) xch[(db * 16 + r) * 64 + lane] = o[db][r];
            xch[64 * 64 + lane] = m; xch[65 * 64 + lane] = l; }
        asm volatile("s_waitcnt lgkmcnt(0)" ::: "memory"); __builtin_amdgcn_s_barrier(); asm volatile("" ::: "memory");
        if (xrole == 1) return;
        const float mb = xch[64 * 64 + lane], lb = xch[65 * 64 + lane], M = fmaxf(m, mb), fa = __builtin_amdgcn_exp2f(m - M), fb = __builtin_amdgcn_exp2f(mb - M);
        l = l * fa + lb * fb;
#pragma unroll
        for (int db = 0; db < 4; ++db)
#pragma unroll
            for (int r = 0; r < 16; ++r) o[db][r] = o[db][r] * fa + xch[(db * 16 + r) * 64 + lane] * fb; }
    if constexpr (OUT8) { const float inv = 16.0f / l; unsigned char* orow = (unsigned char*)Op + (size_t)r32 * ldo + 4 * hi;
#pragma unroll
        for (int db = 0; db < 4; ++db)
#pragma unroll
            for (int g = 0; g < 4; ++g) *(unsigned*)(orow + db * 32 + 8 * g) = pk4_fp8(o[db][4 * g] * inv, o[db][4 * g + 1] * inv, o[db][4 * g + 2] * inv, o[db][4 * g + 3] * inv);
        return; }
    const float inv = 1.0f / l;
    bf16_t* orow = Op + (size_t)r32 * ldo + 4 * hi;
#pragma unroll
    for (int db = 0; db < 4; ++db)
#pragma unroll
        for (int g = 0; g < 4; ++g) { u32x2 w; w.x = cvt_pk_bf16(o[db][4 * g] * inv, o[db][4 * g + 1] * inv); w.y = cvt_pk_bf16(o[db][4 * g + 2] * inv, o[db][4 * g + 3] * inv);
            *(u32x2*)(orow + db * 32 + 8 * g) = w; }
}
__device__ __forceinline__ void mem_attn_unit(Frame& F, int l, int uid) {
    const int bh = uid >> 7, qb = uid & 127, b = bh >> 2, h = bh & 3;
    const bf16_t* Qp = WSP(bf16_t, WS_QM) + ((size_t)bh * SEQ + qb * 32) * 128; const bf16_t* Kp = WSP(bf16_t, WS_MEMKF) + (size_t)((l * 2 + b) * 4 + h) * 256 * 128;
    const bf16_t* Vp = WSP(bf16_t, WS_MEMVT) + (size_t)(l * 512 + h * 128) * 512 + b * 256;
    if (l == 0) { const int half = F.wave >> 2;
        attn_wave<8, false, false>(WSP(bf16_t, WS_U0) + (size_t)(b * SEQ + qb * 32) * NIN0 + 4608 + h * 128, Kp, Vp, 512, 4 * half + 4, WSP(bf16_t, WS_CAT) + (size_t)(b * SEQ + qb * 32) * DM + 1536 + h * 128, DM, lane_now(),
                                   4 * half, (LAS float*)F.lds + (F.wave & 3) * (66 * 64), half, inp(F, 7), NIN0, CMEM); }
    else attn_wave<8, false, true>(Qp, Kp, Vp, 512, 8, (bf16_t*)(F.ws + WS_CAT + (size_t)(b * SEQ + qb * 32) * DM + 1536 + h * 128), DM, lane_now());
}

__device__ __forceinline__ void p6b_latents(Frame& F) {
    const int gw = F.vcu * 8 + F.wave, NGW = F.G * 8, lane = lane_now();
    const float* U1F = WSP(float, WS_U1F); const float* g_mq1 = inp(F, 7) + 128;
    for (int t = gw; t < NTOK; t += NGW) { const float* row = U1F + (size_t)t * N1; const int b = t >> 12, s = t & (SEQ - 1);
        { const f32x4 v = *(const f32x4*)(row + 4 * lane); const float r = 1.0f * __builtin_amdgcn_rsqf(wave_sum((v[0] * v[0] + v[1] * v[1]) + (v[2] * v[2] + v[3] * v[3])) * (1.0f / 256.0f) + EPS);
          u32x2 w; w.x = cvt_pk_bf16(v[0] * r, v[1] * r); w.y = cvt_pk_bf16(v[2] * r, v[3] * r); *(u32x2*)(WSP(bf16_t, WS_CKV) + (size_t)t * 256 + 4 * lane) = w; }
        { const f32x4 v0 = *(const f32x4*)(row + 512 + 8 * lane), v1 = *(const f32x4*)(row + 512 + 8 * lane + 4);
          const float r = 1.0f * __builtin_amdgcn_rsqf(wave_sum((v0[0] * v0[0] + v0[1] * v0[1]) + (v0[2] * v0[2] + v0[3] * v0[3]) + (v1[0] * v1[0] + v1[1] * v1[1]) + (v1[2] * v1[2] + v1[3] * v1[3])) * (1.0f / 512.0f) + EPS);
          u32x4 w; w.x = cvt_pk_bf16(v0[0] * r, v0[1] * r); w.y = cvt_pk_bf16(v0[2] * r, v0[3] * r); w.z = cvt_pk_bf16(v1[0] * r, v1[1] * r); w.w = cvt_pk_bf16(v1[2] * r, v1[3] * r);
          *(u32x4*)(WSP(bf16_t, WS_CQ) + (size_t)t * 512 + 8 * lane) = w; }
        { const f32x4 v0 = *(const f32x4*)(row + 1024 + 8 * lane), v1 = *(const f32x4*)(row + 1024 + 8 * lane + 4);
          float ss = (v0[0] * v0[0] + v0[1] * v0[1]) + (v0[2] * v0[2] + v0[3] * v0[3]) + (v1[0] * v1[0] + v1[1] * v1[1]) + (v1[2] * v1[2] + v1[3] * v1[3]);
          ss = row16_sum(ss);
          const float r = CMEM * __builtin_amdgcn_rsqf(ss * (1.0f / 128.0f) + EPS); const int h = lane >> 4, d = (lane & 15) * 8;
          const f32x4 g0 = *(const f32x4*)(g_mq1 + d), g1 = *(const f32x4*)(g_mq1 + d + 4);
          u32x4 w; w.x = cvt_pk_bf16(v0[0] * r * g0[0], v0[1] * r * g0[1]); w.y = cvt_pk_bf16(v0[2] * r * g0[2], v0[3] * r * g0[3]); w.z = cvt_pk_bf16(v1[0] * r * g1[0], v1[1] * r * g1[1]); w.w = cvt_pk_bf16(v1[2] * r * g1[2], v1[3] * r * g1[3]);
          *(u32x4*)(WSP(bf16_t, WS_QM) + ((size_t)(b * 4 + h) * SEQ + s) * 128 + d) = w; }
    }
}
struct EpiFp8Plain {
    static constexpr bool PERM = true, AFTER_DRAIN = false;
    unsigned char* O; int ldc;
    __device__ __forceinline__ void operator()(const f32x4 (&acc)[2][2][4][2], const pg8::Unit& u, int wr, int wc, int fr, int fq) const {
        using pg8::BM; using pg8::HALF;
        const int row0 = u.pm * BM + wr * 64 + fr, col0 = u.pn * BM + wc * 32 + 8 * fq;
#pragma unroll
        for (int ai = 0; ai < 2; ++ai)
#pragma unroll
            for (int m = 0; m < 4; ++m) { unsigned char* rowp = O + (size_t)(row0 + ai * HALF + m * 16) * ldc + col0;
#pragma unroll
                for (int bj = 0; bj < 2; ++bj) { const f32x4 v0 = acc[ai][bj][m][0], v1 = acc[ai][bj][m][1];
                    u32x2 w; w.x = pk4_fp8(v0[0], v0[1], v0[2], v0[3]); w.y = pk4_fp8(v1[0], v1[1], v1[2], v1[3]);
                    *(u32x2*)(rowp + bj * HALF) = w; } }
    }
};
struct EpiMemKFinal {
    static constexpr bool PERM = true, AFTER_DRAIN = false;
    bf16_t* KF; const float* g_mk; LAS float* P;
    __device__ __forceinline__ void operator()(const f32x4 (&acc)[2][2][4][2], const pg8::Unit& u, int wr, int wc, int fr, int fq) const {
        using pg8::HALF;
#pragma unroll
        for (int ai = 0; ai < 2; ++ai)
#pragma unroll
            for (int m = 0; m < 4; ++m) { const int rl = ai * HALF + wr * 64 + m * 16 + fr;
#pragma unroll
                for (int bj = 0; bj < 2; ++bj) { const f32x4 a = acc[ai][bj][m][0], b = acc[ai][bj][m][1];
                    float s = (a[0] * a[0] + a[1] * a[1]) + (a[2] * a[2] + a[3] * a[3]) + (b[0] * b[0] + b[1] * b[1]) + (b[2] * b[2] + b[3] * b[3]);
                    s = rows4_sum(s);
                    if (fq == 0) P[(rl * 2 + bj) * 4 + wc] = s; } }
        asm volatile("s_waitcnt lgkmcnt(0)" ::: "memory"); __builtin_amdgcn_s_barrier(); asm volatile("" ::: "memory");
        const int cl = wc * 32 + 8 * fq, ly = u.pn >> 1;
        const f32x4 gk0 = *(const f32x4*)(g_mk + ly * 128 + cl), gk1 = *(const f32x4*)(g_mk + ly * 128 + cl + 4);
#pragma unroll
        for (int ai = 0; ai < 2; ++ai)
#pragma unroll
            for (int m = 0; m < 4; ++m) { const int rl = ai * HALF + wr * 64 + m * 16 + fr;
#pragma unroll
                for (int bj = 0; bj < 2; ++bj) { const int h = 2 * (u.pn & 1) + bj; const f32x4 p4 = *(const LAS f32x4*)(P + (rl * 2 + bj) * 4);
                    const float r = __builtin_amdgcn_rsqf(((p4[0] + p4[1]) + (p4[2] + p4[3])) * (1.0f / 128.0f) + EPS);
                    const f32x4 v0 = acc[ai][bj][m][0] * r * gk0, v1 = acc[ai][bj][m][1] * r * gk1;
                    u32x4 w; w.x = cvt_pk_bf16(v0[0], v0[1]); w.y = cvt_pk_bf16(v0[2], v0[3]); w.z = cvt_pk_bf16(v1[0], v1[1]); w.w = cvt_pk_bf16(v1[2], v1[3]);
                    *(u32x4*)(KF + ((size_t)((ly * 2 + u.pm) * 4 + h) * 256 + rl) * 128 + cl) = w; } }
    }
};
struct EpiKnFinal {
    static constexpr bool PERM = true, AFTER_DRAIN = false;
    bf16_t* KF; const float* kpe; const float* kss; const int* positions; const float* g_kn; LAS float* P;
    __device__ __forceinline__ void operator()(const f32x4 (&acc)[2][2][4][2], const pg8::Unit& u, int wr, int wc, int fr, int fq) const {
        using pg8::BM; using pg8::HALF;
#pragma unroll
        for (int ai = 0; ai < 2; ++ai)
#pragma unroll
            for (int m = 0; m < 4; ++m) { const int rl = ai * HALF + wr * 64 + m * 16 + fr;
#pragma unroll
                for (int bj = 0; bj < 2; ++bj) { const f32x4 a = acc[ai][bj][m][0], b = acc[ai][bj][m][1];
                    float s = (a[0] * a[0] + a[1] * a[1]) + (a[2] * a[2] + a[3] * a[3]) + (b[0] * b[0] + b[1] * b[1]) + (b[2] * b[2] + b[3] * b[3]);
                    s = rows4_sum(s);
                    if (fq == 0) P[(rl * 2 + bj) * 4 + wc] = s; } }
        asm volatile("s_waitcnt lgkmcnt(0)" ::: "memory"); __builtin_amdgcn_s_barrier(); asm volatile("" ::: "memory");
        const int cl = wc * 32 + 8 * fq, i0 = 8 * wc + 2 * fq;
        const f32x4 gk0 = *(const f32x4*)(g_kn + cl), gk1 = *(const f32x4*)(g_kn + cl + 4);
        const float glo0 = g_kn[128 + i0], glo1 = g_kn[128 + i0 + 1], ghi0 = g_kn[160 + i0], ghi1 = g_kn[160 + i0 + 1];
        const double if0 = INVF_REV[i0], if1 = INVF_REV[i0 + 1];
#pragma unroll
        for (int ai = 0; ai < 2; ++ai)
#pragma unroll
            for (int m = 0; m < 4; ++m) { const int rl = ai * HALF + wr * 64 + m * 16 + fr, row = u.pm * BM + rl, b = row >> 12, sq = row & (SEQ - 1);
                const float kssv = kss[row]; const double pos = (double)positions[row];
                typedef float f32x2_t __attribute__((ext_vector_type(2)));
                const f32x2_t klo = *(const f32x2_t*)(kpe + (size_t)row * 64 + i0), khi = *(const f32x2_t*)(kpe + (size_t)row * 64 + 32 + i0);
                const double r0 = pos * if0, r1 = pos * if1; const float f0 = (float)(r0 - __builtin_rint(r0)), f1 = (float)(r1 - __builtin_rint(r1));
                const float cs0 = __builtin_amdgcn_cosf(f0), sn0 = __builtin_amdgcn_sinf(f0), cs1 = __builtin_amdgcn_cosf(f1), sn1 = __builtin_amdgcn_sinf(f1);
#pragma unroll
                for (int bj = 0; bj < 2; ++bj) { const int h = 2 * u.pn + bj; const f32x4 p4 = *(const LAS f32x4*)(P + (rl * 2 + bj) * 4);
                    const float r = __builtin_amdgcn_rsqf(((p4[0] + p4[1]) + (p4[2] + p4[3]) + kssv) * (1.0f / 192.0f) + EPS);
                    unsigned char* dst = (unsigned char*)KF + ((size_t)(b * 12 + h) * SEQ + sq) * 192;
                    const f32x4 v0 = acc[ai][bj][m][0] * r * gk0, v1 = acc[ai][bj][m][1] * r * gk1;
                    u32x2 w; w.x = pk4_fp8(v0[0], v0[1], v0[2], v0[3]); w.y = pk4_fp8(v1[0], v1[1], v1[2], v1[3]);
                    *(u32x2*)(dst + cl) = w;
                    const float yl0 = klo[0] * r * glo0, yl1 = klo[1] * r * glo1, yh0 = khi[0] * r * ghi0, yh1 = khi[1] * r * ghi1;
                    *(unsigned short*)(dst + 128 + i0) = (unsigned short)__builtin_amdgcn_cvt_pk_fp8_f32(yl0 * cs0 - yh0 * sn0, yl1 * cs1 - yh1 * sn1, 0, false);
                    *(unsigned short*)(dst + 160 + i0) = (unsigned short)__builtin_amdgcn_cvt_pk_fp8_f32(yh0 * cs0 + yl0 * sn0, yh1 * cs1 + yl1 * sn1, 0, false); } }
    }
};
constexpr int AT_KROW = 400, AT_VROW = 144, AT_KBYTES = 64 * AT_KROW, AT_STAGE = AT_KBYTES + 128 * AT_VROW;
static_assert(AT_KBYTES == 25 * 1024 && AT_STAGE == 43 * 1024 && 3 * AT_STAGE <= LDSCTL_OFF && RSTAB_OFF + 1024 <= LDS_BYTES, "attention LDS stages");
__device__ __forceinline__ void causal_wg_unit(Frame& F, int bh, int QB) {
    const int lane = lane_now(), w = F.wave, r32 = lane & 31, hi = lane >> 5, b = bh / 12, h = bh % 12;
    const bf16_t* Qp = WSP(bf16_t, WS_QF) + ((size_t)bh * SEQ + QB * 256 + w * 32) * 192;
    const char* Kg = (const char*)(WSP(bf16_t, WS_KF) + (size_t)bh * SEQ * 192);
    const char* Vg = (const char*)(WSP(bf16_t, WS_VT) + (size_t)(h * 128) * NTOK + b * SEQ);
    unsigned goff[6];
#pragma unroll
    for (int i = 0; i < 6; ++i) { const int j = w + 8 * i;
        if (j < 25) { const int q = j * 64 + lane, row = q / 25, c = q % 25; goff[i] = (unsigned)(row * 384 + (c < 24 ? c : 23) * 16); }
        else { const int q = (j - 25) * 64 + lane, d = q / 9, c = q % 9; goff[i] = (unsigned)(d * (NTOK * 2) + (c < 8 ? c : 7) * 16); } }
    bf16x8 qf[12];
    {
      const int tq = b * SEQ + QB * 256 + w * 32 + r32;
      const bf16_t* qrow = WSP(bf16_t, WS_QRAW) + (size_t)tq * 2304 + h * 192 + hi * 8; const float* g_qn = inp(F, 15);
      u32x4 raw[12];
#pragma unroll
      for (int d0 = 0; d0 < 12; ++d0) raw[d0] = *(const u32x4*)(qrow + d0 * 16);
      const float* sq2 = WSP(float, WS_SSQQ) + 2 * tq; const float rq = __builtin_amdgcn_rsqf((sq2[0] + sq2[1]) * (1.0f / 512.0f) + EPS);
      const double pos = (double)((const int*)inp(F, 2))[tq];
      float ss = 0.f;
#pragma unroll
      for (int d0 = 0; d0 < 12; ++d0) { float a[8]; unpack8(raw[d0], a);
#pragma unroll
          for (int e = 0; e < 8; ++e) ss += a[e] * a[e]; }
      ss += other_half(ss, lane);
      const float r = CMLA * rq * __builtin_amdgcn_rsqf(ss * rq * rq * (1.0f / 192.0f) + EPS);
#pragma unroll
      for (int d0 = 0; d0 < 8; ++d0) { float a[8]; unpack8(raw[d0], a); const f32x4 g0 = *(const f32x4*)(g_qn + d0 * 16 + hi * 8), g1 = *(const f32x4*)(g_qn + d0 * 16 + hi * 8 + 4);
          u32x4 wv; wv.x = cvt_pk_bf16(a[0] * r * g0[0], a[1] * r * g0[1]); wv.y = cvt_pk_bf16(a[2] * r * g0[2], a[3] * r * g0[3]); wv.z = cvt_pk_bf16(a[4] * r * g1[0], a[5] * r * g1[1]); wv.w = cvt_pk_bf16(a[6] * r * g1[2], a[7] * r * g1[3]);
          qf[d0] = __builtin_bit_cast(bf16x8, wv); }
#pragma unroll
      for (int dd = 0; dd < 2; ++dd) { float lo[8], hv[8], ol[8], oh[8]; unpack8(raw[8 + dd], lo); unpack8(raw[10 + dd], hv); const int i0 = dd * 16 + hi * 8;
#pragma unroll
          for (int e = 0; e < 8; ++e) { const double rev = pos * INVF_REV[i0 + e]; const float fr = (float)(rev - __builtin_rint(rev)); const float cs = __builtin_amdgcn_cosf(fr), sn = __builtin_amdgcn_sinf(fr);
              const float yl = lo[e] * r * g_qn[128 + i0 + e], yh = hv[e] * r * g_qn[160 + i0 + e]; ol[e] = yl * cs - yh * sn; oh[e] = yh * cs + yl * sn; }
          u32x4 wl, wh; wl.x = cvt_pk_bf16(ol[0], ol[1]); wl.y = cvt_pk_bf16(ol[2], ol[3]); wl.z = cvt_pk_bf16(ol[4], ol[5]); wl.w = cvt_pk_bf16(ol[6], ol[7]);
          wh.x = cvt_pk_bf16(oh[0], oh[1]); wh.y = cvt_pk_bf16(oh[2], oh[3]); wh.z = cvt_pk_bf16(oh[4], oh[5]); wh.w = cvt_pk_bf16(oh[6], oh[7]);
          qf[8 + dd] = __builtin_bit_cast(bf16x8, wl); qf[10 + dd] = __builtin_bit_cast(bf16x8, wh); } }
    f32x16 o[4], negm; float l = 0.f;
#pragma unroll
    for (int r = 0; r < 16; ++r) negm[r] = 0.f;
#pragma unroll
    for (int db = 0; db < 4; ++db)
#pragma unroll
        for (int r = 0; r < 16; ++r) o[db][r] = 0.f;
    const int ntiles = 4 * QB + 4;
    LAS unsigned char* lds = F.lds;
#define AT_DMA(t_, st_) do { _Pragma("unroll") for (int i_ = 0; i_ < 6; ++i_) { const int j_ = w + 8 * i_; if (j_ < 43) { \
        const char* g_ = (j_ < 25 ? Kg + (size_t)(t_) * (64 * 384) : Vg + (size_t)(t_) * 128) + goff[i_]; \
        __builtin_amdgcn_global_load_lds((const unsigned*)g_, (LAS unsigned*)(lds + (st_) * AT_STAGE + j_ * 1024), 16, 0, 0); } } } while (0)
    asm volatile("s_waitcnt lgkmcnt(0)" ::: "memory"); __builtin_amdgcn_s_barrier(); asm volatile("" ::: "memory");
    AT_DMA(0, 0); AT_DMA(1, 1);
    const int kb0 = r32 * AT_KROW + hi * 16, vb0 = AT_KBYTES + r32 * AT_VROW + hi * 16;
    const bool np6 = w < 3;
    for (int t = 0; t < ntiles; ++t) {
        if (t + 1 < ntiles) { if (np6) asm volatile("s_waitcnt vmcnt(6)" ::: "memory"); else asm volatile("s_waitcnt vmcnt(5)" ::: "memory"); }
        else asm volatile("s_waitcnt vmcnt(0)" ::: "memory");
        __builtin_amdgcn_s_barrier(); asm volatile("" ::: "memory");
        if (t + 2 < ntiles) AT_DMA(t + 2, (t + 2) % 3);
        const int tp = t - 4 * QB;
        if (tp >= 0 && 2 * tp > w) continue;
        const int so = (t % 3) * AT_STAGE;
        const bool act1 = tp < 0 || 2 * tp + 1 <= w;
        f32x16 p0 = negm, p1 = negm;
        { const LAS unsigned char* kp = lds + so + kb0; bf16x8 ka[6], kb[6];
#define AT_KLD(dst, st, base) do { _Pragma("unroll") for (int i_ = 0; i_ < 6; ++i_) dst[i_] = *(const LAS bf16x8*)(kp + (st) * 32 * AT_KROW + ((base) + i_) * 32); } while (0)
          AT_KLD(ka, 0, 0); AT_KLD(kb, 0, 6); __builtin_amdgcn_sched_barrier(0); __builtin_amdgcn_s_setprio(1);
#pragma unroll
          for (int i = 0; i < 6; ++i) p0 = __builtin_amdgcn_mfma_f32_32x32x16_bf16(ka[i], qf[i], p0, 0, 0, 0);
          __builtin_amdgcn_sched_barrier(0); AT_KLD(ka, 1, 0); __builtin_amdgcn_sched_barrier(0);
#pragma unroll
          for (int i = 0; i < 6; ++i) p0 = __builtin_amdgcn_mfma_f32_32x32x16_bf16(kb[i], qf[6 + i], p0, 0, 0, 0);
          __builtin_amdgcn_sched_barrier(0); AT_KLD(kb, 1, 6); __builtin_amdgcn_sched_barrier(0);
#pragma unroll
          for (int i = 0; i < 6; ++i) p1 = __builtin_amdgcn_mfma_f32_32x32x16_bf16(ka[i], qf[i], p1, 0, 0, 0);
          __builtin_amdgcn_sched_barrier(0);
#pragma unroll
          for (int i = 0; i < 6; ++i) p1 = __builtin_amdgcn_mfma_f32_32x32x16_bf16(kb[i], qf[6 + i], p1, 0, 0, 0);
          __builtin_amdgcn_s_setprio(0);
#undef AT_KLD
        }
        bf16x8 vf[2][4], vg[2][4];
        const LAS unsigned char* vp = lds + so + vb0;
#pragma unroll
        for (int ks = 0; ks < 2; ++ks)
#pragma unroll
            for (int db = 0; db < 4; ++db) vf[ks][db] = *(const LAS bf16x8*)(vp + db * 32 * AT_VROW + ks * 32);
        __builtin_amdgcn_sched_barrier(0);
        if (tp >= 0) {
            if (2 * tp == w) {
#pragma unroll
                for (int r = 0; r < 16; ++r) if (crow(r, hi) > r32) p0[r] = -__builtin_inff(); }
            if (!act1) {
#pragma unroll
                for (int r = 0; r < 16; ++r) p1[r] = -__builtin_inff(); }
            else if (2 * tp + 1 == w) {
#pragma unroll
                for (int r = 0; r < 16; ++r) if (crow(r, hi) > r32) p1[r] = -__builtin_inff(); }
        }
        float pm = max3f(p0[0], p1[0], p0[1]);
        pm = max3f(pm, p1[1], p0[2]);
#pragma unroll
        for (int r = 2; r < 15; ++r) pm = max3f(pm, p1[r], p0[r + 1]);
        pm = max3f(pm, p1[15], pm);
        pm = half_max(pm);
        if (!__all(pm <= 8.0f)) {
            const float d = fmaxf(pm, 0.f), alpha = __builtin_amdgcn_exp2f(-d);
#pragma unroll
            for (int r = 0; r < 16; ++r) { p0[r] -= d; p1[r] -= d; negm[r] -= d; }
            l *= alpha;
#pragma unroll
            for (int db = 0; db < 4; ++db)
#pragma unroll
                for (int r = 0; r < 16; ++r) o[db][r] *= alpha;
        }
#pragma unroll
        for (int r = 0; r < 16; ++r) { p0[r] = __builtin_amdgcn_exp2f(p0[r]); p1[r] = __builtin_amdgcn_exp2f(p1[r]); }
        { typedef float f32x2 __attribute__((ext_vector_type(2))); f32x2 s2 = {0.f, 0.f};
#pragma unroll
          for (int r = 0; r < 16; r += 2) { s2 += (f32x2){p0[r], p0[r + 1]}; s2 += (f32x2){p1[r], p1[r + 1]}; }
          l += half_sum(s2[0] + s2[1]); }
        bf16x8 pa[4];
#define AT_PK(P, B_, OUT) do { const unsigned a0_ = cvt_pk_bf16(P[B_ + 0], P[B_ + 1]), a1_ = cvt_pk_bf16(P[B_ + 2], P[B_ + 3]), b0_ = cvt_pk_bf16(P[B_ + 4], P[B_ + 5]), b1_ = cvt_pk_bf16(P[B_ + 6], P[B_ + 7]); \
        auto r0_ = __builtin_amdgcn_permlane32_swap(a0_, b0_, false, false); auto r1_ = __builtin_amdgcn_permlane32_swap(a1_, b1_, false, false); \
        u32x4 w_ = {r0_[0], r1_[0], r0_[1], r1_[1]}; OUT = __builtin_bit_cast(bf16x8, w_); } while (0)
        AT_PK(p0, 0, pa[0]); AT_PK(p0, 8, pa[1]); AT_PK(p1, 0, pa[2]); AT_PK(p1, 8, pa[3]);
        __builtin_amdgcn_sched_barrier(0);
#pragma unroll
        for (int ks = 0; ks < 2; ++ks)
#pragma unroll
            for (int db = 0; db < 4; ++db) vg[ks][db] = *(const LAS bf16x8*)(vp + db * 32 * AT_VROW + (2 + ks) * 32);
        __builtin_amdgcn_sched_barrier(0); __builtin_amdgcn_s_setprio(1);
#pragma unroll
        for (int ks = 0; ks < 2; ++ks)
#pragma unroll
            for (int db = 0; db < 4; ++db) o[db] = __builtin_amdgcn_mfma_f32_32x32x16_bf16(vf[ks][db], pa[ks], o[db], 0, 0, 0);
        __builtin_amdgcn_sched_barrier(0);
#pragma unroll
        for (int ks = 0; ks < 2; ++ks)
#pragma unroll
            for (int db = 0; db < 4; ++db) o[db] = __builtin_amdgcn_mfma_f32_32x32x16_bf16(vg[ks][db], pa[2 + ks], o[db], 0, 0, 0);
        __builtin_amdgcn_s_setprio(0);
    }
#undef AT_PK
#undef AT_DMA
    const float inv = 16.0f / l;
    unsigned char* orow = F.ws + WS_CAT + (size_t)(b * SEQ + QB * 256 + w * 32 + r32) * DM + h * 128 + 4 * hi;
#pragma unroll
    for (int db = 0; db < 4; ++db)
#pragma unroll
        for (int g = 0; g < 4; ++g) *(unsigned*)(orow + db * 32 + 8 * g) = pk4_fp8(o[db][4 * g] * inv, o[db][4 * g + 1] * inv, o[db][4 * g + 2] * inv, o[db][4 * g + 3] * inv);
}
constexpr int A8_KROW = 208, A8_VROW = 80, A8_KBYTES = 64 * A8_KROW, A8_STAGE = A8_KBYTES + 128 * A8_VROW;
constexpr int A8_NST = 5;
static_assert(A8_KBYTES == 13 * 1024 && A8_STAGE == 23 * 1024 && A8_NST * A8_STAGE <= LDSCTL_OFF, "fp8 attention LDS stages");
typedef int v8i_t __attribute__((ext_vector_type(8)));
__device__ __forceinline__ void causal_wg_unit8(Frame& F, int bh, int QB) {
    const int lane = lane_now(), w = F.wave, r32 = lane & 31, hi = lane >> 5, b = bh / 12, h = bh % 12;
    const char* Kg = (const char*)(F.ws + WS_KF) + (size_t)bh * SEQ * 192;
    const char* Vg = (const char*)(F.ws + WS_VT) + (size_t)(h * 128) * NTOK + b * SEQ;
    unsigned goff[3];
#pragma unroll
    for (int i = 0; i < 3; ++i) { const int j = w + 8 * i;
        if (j < 13) { const int q = j * 64 + lane, row = q / 13, c = q % 13; goff[i] = (unsigned)(row * 192 + (c < 12 ? c : 11) * 16); }
        else { const int q = (j - 13) * 64 + lane, d = q / 5, c = q % 5; goff[i] = (unsigned)(d * NTOK + (c < 4 ? c : 3) * 16); } }
    const int ntiles = 4 * QB + 4;
    LAS unsigned char* lds = F.lds;
#define A8_DMA(t_, st_) do { _Pragma("unroll") for (int i_ = 0; i_ < 3; ++i_) { const int j_ = w + 8 * i_; if (j_ < 23) { \
        const char* g_ = (j_ < 13 ? Kg + (size_t)(t_) * (64 * 192) : Vg + (size_t)(t_) * 64) + goff[i_]; \
        __builtin_amdgcn_global_load_lds((const unsigned*)g_, (LAS unsigned*)(lds + (st_) * A8_STAGE + j_ * 1024), 16, 0, 0); } } } while (0)
    v8i_t qf8[3];
    {
      const int tq = b * SEQ + QB * 256 + w * 32 + r32;
      const bf16_t* qrow = WSP(bf16_t, WS_QRAW) + (size_t)tq * 2304 + h * 192 + hi * 32; const float* g_qn = inp(F, 15);
      u32x4 raw[3][4];
#pragma unroll
      for (int c = 0; c < 3; ++c)
#pragma unroll
          for (int k = 0; k < 4; ++k) raw[c][k] = *(const u32x4*)(qrow + c * 64 + k * 8);
      const float* sq2 = WSP(float, WS_SSQQ) + 2 * tq; const float sqa = sq2[0], sqb = sq2[1]; const int posi = ((const int*)inp(F, 2))[tq];
      __builtin_amdgcn_sched_barrier(0);
      asm volatile("s_waitcnt lgkmcnt(0)" ::: "memory"); __builtin_amdgcn_s_barrier(); asm volatile("" ::: "memory");
#pragma unroll
      for (int pt = 0; pt < A8_NST - 1; ++pt) if (pt < ntiles) A8_DMA(pt, pt);
      __builtin_amdgcn_sched_barrier(0);
      const float rq = __builtin_amdgcn_rsqf((sqa + sqb) * (1.0f / 512.0f) + EPS); const double pos = (double)posi;
      float ss = 0.f;
#pragma unroll
      for (int c = 0; c < 3; ++c)
#pragma unroll
          for (int k = 0; k < 4; ++k) { float a[8]; unpack8(raw[c][k], a);
#pragma unroll
              for (int e = 0; e < 8; ++e) ss += a[e] * a[e]; }
      ss += other_half(ss, lane);
      const float r = 16.0f * CMLA * rq * __builtin_amdgcn_rsqf(ss * rq * rq * (1.0f / 192.0f) + EPS);
#pragma unroll
      for (int c = 0; c < 2; ++c)
#pragma unroll
          for (int k = 0; k < 4; ++k) { float a[8]; unpack8(raw[c][k], a); const f32x4 g0 = *(const f32x4*)(g_qn + c * 64 + hi * 32 + k * 8), g1 = *(const f32x4*)(g_qn + c * 64 + hi * 32 + k * 8 + 4);
              qf8[c][2 * k] = (int)pk4_fp8(a[0] * r * g0[0], a[1] * r * g0[1], a[2] * r * g0[2], a[3] * r * g0[3]); qf8[c][2 * k + 1] = (int)pk4_fp8(a[4] * r * g1[0], a[5] * r * g1[1], a[6] * r * g1[2], a[7] * r * g1[3]); }
#pragma unroll
      for (int k = 0; k < 4; ++k) { float a[8], ov[8]; unpack8(raw[2][k], a);
#pragma unroll
          for (int e = 0; e < 8; ++e) { const int i = 8 * k + e;
              const double rev = pos * INVF_REV[i]; const float fr = (float)(rev - __builtin_rint(rev)); const float cs = __builtin_amdgcn_cosf(fr), sn = __builtin_amdgcn_sinf(fr);
              const float y = a[e] * r * g_qn[128 + hi * 32 + i], yo = other_half(y, lane); ov[e] = hi ? y * cs + yo * sn : y * cs - yo * sn; }
          qf8[2][2 * k] = (int)pk4_fp8(ov[0], ov[1], ov[2], ov[3]); qf8[2][2 * k + 1] = (int)pk4_fp8(ov[4], ov[5], ov[6], ov[7]); } }
    f32x16 o[4], negm; float l = 0.f;
#pragma unroll
    for (int r = 0; r < 16; ++r) negm[r] = 0.f;
#pragma unroll
    for (int db = 0; db < 4; ++db)
#pragma unroll
        for (int r = 0; r < 16; ++r) o[db][r] = 0.f;
    const int kb0 = r32 * A8_KROW + hi * 32, vb0 = A8_KBYTES + r32 * A8_VROW + hi * 16;
    const bool np3 = w < 7;
    constexpr int S1 = 0x7f7f7f7f, SQ = 0x7b7b7b7b;
    typedef int v4i_l __attribute__((ext_vector_type(4)));
#define A8_LD32(ptr) __builtin_shufflevector(*(const LAS v4i_l*)(ptr), *(const LAS v4i_l*)((ptr) + 16), 0, 1, 2, 3, 4, 5, 6, 7)
    for (int t = 0; t < ntiles; ++t) {
        { const int ahead = ntiles - 1 - t < A8_NST - 2 ? ntiles - 1 - t : A8_NST - 2;
          if (np3) { if (ahead >= 3) asm volatile("s_waitcnt vmcnt(9)" ::: "memory"); else if (ahead == 2) asm volatile("s_waitcnt vmcnt(6)" ::: "memory"); else if (ahead == 1) asm volatile("s_waitcnt vmcnt(3)" ::: "memory"); else asm volatile("s_waitcnt vmcnt(0)" ::: "memory"); }
          else { if (ahead >= 3) asm volatile("s_waitcnt vmcnt(6)" ::: "memory"); else if (ahead == 2) asm volatile("s_waitcnt vmcnt(4)" ::: "memory"); else if (ahead == 1) asm volatile("s_waitcnt vmcnt(2)" ::: "memory"); else asm volatile("s_waitcnt vmcnt(0)" ::: "memory"); } }
        __builtin_amdgcn_s_barrier(); asm volatile("" ::: "memory");
        if (t + A8_NST - 1 < ntiles) A8_DMA(t + A8_NST - 1, (t + A8_NST - 1) % A8_NST);
        const int tp = t - 4 * QB;
        if (tp >= 0 && 2 * tp > w) continue;
        const int so = (t % A8_NST) * A8_STAGE;
        const bool act1 = tp < 0 || 2 * tp + 1 <= w;
        f32x16 p0 = negm, p1 = negm;
        { const LAS unsigned char* kp = lds + so + kb0; v8i_t k0f[3], k1f[3];
#pragma unroll
          for (int c = 0; c < 3; ++c) k0f[c] = A8_LD32(kp + c * 64);
#pragma unroll
          for (int c = 0; c < 3; ++c) k1f[c] = A8_LD32(kp + 32 * A8_KROW + c * 64);
          __builtin_amdgcn_sched_barrier(0); __builtin_amdgcn_s_setprio(1);
#pragma unroll
          for (int c = 0; c < 3; ++c) p0 = __builtin_amdgcn_mfma_scale_f32_32x32x64_f8f6f4(k0f[c], qf8[c], p0, 0, 0, 0, S1, 0, SQ);
#pragma unroll
          for (int c = 0; c < 3; ++c) p1 = __builtin_amdgcn_mfma_scale_f32_32x32x64_f8f6f4(k1f[c], qf8[c], p1, 0, 0, 0, S1, 0, SQ);
          __builtin_amdgcn_s_setprio(0); }
        v8i_t vf[4];
        { const LAS unsigned char* vp = lds + so + vb0;
#pragma unroll
          for (int db = 0; db < 4; ++db) { const LAS unsigned char* q = vp + db * 32 * A8_VROW; vf[db] = __builtin_shufflevector(*(const LAS v4i_l*)q, *(const LAS v4i_l*)(q + 32), 0, 1, 2, 3, 4, 5, 6, 7); } }
        __builtin_amdgcn_sched_barrier(0);
        if (tp >= 0) {
            if (2 * tp == w) {
#pragma unroll
                for (int r = 0; r < 16; ++r) if (crow(r, hi) > r32) p0[r] = -__builtin_inff(); }
            if (!act1) {
#pragma unroll
                for (int r = 0; r < 16; ++r) p1[r] = -__builtin_inff(); }
            else if (2 * tp + 1 == w) {
#pragma unroll
                for (int r = 0; r < 16; ++r) if (crow(r, hi) > r32) p1[r] = -__builtin_inff(); }
        }
        float pm = max3f(p0[0], p1[0], p0[1]);
        pm = max3f(pm, p1[1], p0[2]);
#pragma unroll
        for (int r = 2; r < 15; ++r) pm = max3f(pm, p1[r], p0[r + 1]);
        pm = max3f(pm, p1[15], pm);
        pm = half_max(pm);
        if (!__all(pm <= 8.0f)) {
            const float d = fmaxf(pm, 0.f), alpha = __builtin_amdgcn_exp2f(-d);
#pragma unroll
            for (int r = 0; r < 16; ++r) { p0[r] -= d; p1[r] -= d; negm[r] -= d; }
            l *= alpha;
#pragma unroll
            for (int db = 0; db < 4; ++db)
#pragma unroll
                for (int r = 0; r < 16; ++r) o[db][r] *= alpha;
        }
#pragma unroll
        for (int r = 0; r < 16; ++r) { p0[r] = __builtin_amdgcn_exp2f(p0[r]); p1[r] = __builtin_amdgcn_exp2f(p1[r]); }
        { typedef float f32x2 __attribute__((ext_vector_type(2))); f32x2 s2 = {0.f, 0.f};
#pragma unroll
          for (int r = 0; r < 16; r += 2) { s2 += (f32x2){p0[r], p0[r + 1]}; s2 += (f32x2){p1[r], p1[r + 1]}; }
          l += half_sum(s2[0] + s2[1]); }
        v8i_t pb;
#define A8_PK(P, B_) do { const unsigned d0_ = pk4_fp8(P[0], P[1], P[2], P[3]), d1_ = pk4_fp8(P[4], P[5], P[6], P[7]), d2_ = pk4_fp8(P[8], P[9], P[10], P[11]), d3_ = pk4_fp8(P[12], P[13], P[14], P[15]); \
        auto r02_ = __builtin_amdgcn_permlane32_swap(d0_, d2_, false, false); auto r13_ = __builtin_amdgcn_permlane32_swap(d1_, d3_, false, false); \
        pb[B_ + 0] = (int)r02_[0]; pb[B_ + 1] = (int)r02_[1]; pb[B_ + 2] = (int)r13_[0]; pb[B_ + 3] = (int)r13_[1]; } while (0)
        A8_PK(p0, 0); A8_PK(p1, 4);
        __builtin_amdgcn_sched_barrier(0); __builtin_amdgcn_s_setprio(1);
#pragma unroll
        for (int db = 0; db < 4; ++db) o[db] = __builtin_amdgcn_mfma_scale_f32_32x32x64_f8f6f4(vf[db], pb, o[db], 0, 0, 0, S1, 0, S1);
        __builtin_amdgcn_s_setprio(0);
    }
#undef A8_PK
#undef A8_LD32
#undef A8_DMA
    const float inv = 16.0f / l;
    unsigned char* orow = F.ws + WS_CAT + (size_t)(b * SEQ + QB * 256 + w * 32 + r32) * DM + h * 128 + 4 * hi;
#pragma unroll
    for (int db = 0; db < 4; ++db)
#pragma unroll
        for (int g = 0; g < 4; ++g) *(unsigned*)(orow + db * 32 + 8 * g) = pk4_fp8(o[db][4 * g] * inv, o[db][4 * g + 1] * inv, o[db][4 * g + 2] * inv, o[db][4 * g + 3] * inv);
}
__device__ __forceinline__ void p11_attention(Frame& F) {
    const int xcd = F.vcu >> 5, j = F.vcu & 31;
    causal_wg_unit8(F, 3 * xcd + j % 3, 15 - j / 3);
    if (j >= 16) { const int v = 63 - j; causal_wg_unit8(F, 3 * xcd + v % 3, 15 - v / 3);
        mem_attn_unit(F, 1, ((xcd * 16 + (j - 16)) * 8 + F.wave)); }
    asm volatile("s_waitcnt vmcnt(0) lgkmcnt(0)" ::: "memory"); __builtin_amdgcn_s_barrier(); asm volatile("" ::: "memory");
}

__device__ __forceinline__ void p11_router(Frame& F) {
    const int lane = lane_now(), wg = blockIdx.x, tid = F.wave * 64 + lane;
    const bf16_t* X3 = WSP(bf16_t, WS_XB); const float* WR = WSP(float, WS_WR);
    int* tok_e = (int*)(F.ws + WS_META + MT_TOKE); float* tok_w = (float*)(F.ws + WS_META + MT_TOKW); float* tok_r = (float*)(F.ws + WS_META + MT_TOKR); int* cnt = (int*)(F.ws + WS_META + MT_CNT);
    LAS int* le = (LAS int*)F.lds;
    f32x4 v[4][8]; float r[4], l1[4], l2[4]; int i1[4], i2[4];
#pragma unroll
    for (int j = 0; j < 4; ++j) { const int t = wg * 32 + F.wave * 4 + j; const u32x2* xr = (const u32x2*)(X3 + (size_t)t * DM) + lane; float s = 0.f;
#pragma unroll
        for (int q = 0; q < 8; ++q) { const u32x2 w = xr[64 * q]; v[j][q] = (f32x4){bf_lo(w.x), bf_hi(w.x), bf_lo(w.y), bf_hi(w.y)}; s += (v[j][q][0] * v[j][q][0] + v[j][q][1] * v[j][q][1]) + (v[j][q][2] * v[j][q][2] + v[j][q][3] * v[j][q][3]); }
        r[j] = s; l1[j] = -__builtin_inff(); l2[j] = -__builtin_inff(); i1[j] = -1; i2[j] = -1; }
#pragma unroll
    for (int j = 0; j < 4; ++j) r[j] = wave_sum(r[j]);
#pragma unroll
    for (int j = 0; j < 4; ++j) r[j] = 1.0f * __builtin_amdgcn_rsqf(r[j] * (1.0f / 2048.0f) + EPS);
    f32x4 wn[8];
#pragma unroll
    for (int q = 0; q < 8; ++q) wn[q] = ((const f32x4*)WR + lane)[64 * q];
#pragma unroll 1
    for (int e = 0; e < 8; ++e) { f32x4 w[8]; float d[4];
#pragma unroll
        for (int q = 0; q < 8; ++q) w[q] = wn[q];
        { const f32x4* wr = (const f32x4*)(WR + (e < 7 ? e + 1 : 7) * DM) + lane;
#pragma unroll
          for (int q = 0; q < 8; ++q) wn[q] = wr[64 * q]; }
#pragma unroll
        for (int j = 0; j < 4; ++j) { d[j] = 0.f;
#pragma unroll
            for (int q = 0; q < 8; ++q) d[j] += (v[j][q][0] * w[q][0] + v[j][q][1] * w[q][1]) + (v[j][q][2] * w[q][2] + v[j][q][3] * w[q][3]); }
#pragma unroll
        for (int j = 0; j < 4; ++j) d[j] = wave_sum(d[j]);
#pragma unroll
        for (int j = 0; j < 4; ++j) { const float x = d[j] * r[j];
            if (x > l1[j]) { l2[j] = l1[j]; i2[j] = i1[j]; l1[j] = x; i1[j] = e; } else if (x > l2[j]) { l2[j] = x; i2[j] = e; } } }
#pragma unroll
    for (int j = 0; j < 4; ++j) { const int tl = F.wave * 4 + j, t = wg * 32 + tl;
        const float w1 = 1.0f / (1.0f + __expf(l2[j] - l1[j])), w2 = 1.0f - w1;
        if (lane == 0) { tok_e[2 * t] = i1[j]; tok_e[2 * t + 1] = i2[j]; tok_w[2 * t] = w1; tok_w[2 * t + 1] = w2; tok_r[t] = r[j]; le[2 * tl] = i1[j]; le[2 * tl + 1] = i2[j]; } }
    LDS_WAIT(); __syncthreads();
    if (tid < 8) { int c = 0; for (int i = 0; i < 64; ++i) c += (le[i] == tid) ? 1 : 0; cnt[wg * 8 + tid] = c; }
    __syncthreads();
}
__device__ __forceinline__ void p12_scatter(Frame& F) {
    const int lane = lane_now(), wg = blockIdx.x, tid = F.wave * 64 + lane;
    const int* tok_e = (const int*)(F.ws + WS_META + MT_TOKE); const float* tok_w = (const float*)(F.ws + WS_META + MT_TOKW); const float* tok_r = (const float*)(F.ws + WS_META + MT_TOKR); const int* cnt = (const int*)(F.ws + WS_META + MT_CNT);
    int* tok_pos = (int*)(F.ws + WS_META + MT_TOKPOS); int* mte = (int*)(F.ws + WS_META + MT_MTE); int* nmt = (int*)(F.ws + WS_META + MT_NMT);
    LAS int* L = (LAS int*)F.lds;
    if (tid < 16) L[tid] = 0;
    LDS_WAIT(); __syncthreads();
    { const int e = tid & 7, wq = tid >> 3; int c[4], tot = 0, mine = 0;
#pragma unroll
      for (int k = 0; k < 4; ++k) c[k] = cnt[(wq * 4 + k) * 8 + e];
#pragma unroll
      for (int k = 0; k < 4; ++k) { tot += c[k]; mine += (wq * 4 + k < wg) ? c[k] : 0; }
      __hip_atomic_fetch_add(L + e, tot, __ATOMIC_RELAXED, __HIP_MEMORY_SCOPE_WORKGROUP); __hip_atomic_fetch_add(L + 8 + e, mine, __ATOMIC_RELAXED, __HIP_MEMORY_SCOPE_WORKGROUP); }
    LDS_WAIT(); __syncthreads();
    if (tid == 0) { int seg = 0; for (int e = 0; e < 8; ++e) { L[16 + e] = seg + L[8 + e]; const int nt = (L[e] + 255) >> 8; if (wg == 0) for (int q = 0; q < nt; ++q) mte[(seg >> 8) + q] = e; seg += nt << 8; } if (wg == 0) nmt[0] = seg >> 8; }
    LDS_WAIT(); __syncthreads();
    if (F.wave == 0) { const int e = tok_e[wg * 64 + lane]; int pos = 0;
#pragma unroll
        for (int k = 0; k < 8; ++k) { const unsigned long long m = __ballot(e == k); if (e == k) pos = L[16 + k] + __popcll(m & ((1ull << lane) - 1ull)); }
        L[32 + lane] = pos; }
    LDS_WAIT(); __syncthreads();
    unsigned char* HS = F.ws + WS_HS;
    for (int i0 = F.wave; i0 < 64; i0 += 32) {
        u32x2 w[4][8]; float rr[4]; int pos[4];
#pragma unroll
        for (int k = 0; k < 4; ++k) { const int i = i0 + 8 * k, t = wg * 32 + (i >> 1); pos[k] = L[32 + i]; rr[k] = tok_r[t];
            const u32x2* src = (const u32x2*)(WSP(bf16_t, WS_XB) + (size_t)t * DM) + lane;
#pragma unroll
            for (int q = 0; q < 8; ++q) w[k][q] = src[64 * q]; }
#pragma unroll
        for (int k = 0; k < 4; ++k) { unsigned* dst = (unsigned*)(HS + (size_t)pos[k] * DM) + lane; const float r = rr[k] * QH;
#pragma unroll
            for (int q = 0; q < 8; ++q) dst[64 * q] = pk4_i8s(bf_lo(w[k][q].x), bf_hi(w[k][q].x), bf_lo(w[k][q].y), bf_hi(w[k][q].y), r);
            if (lane == 0) tok_pos[wg * 64 + i0 + 8 * k] = pos[k]; } }
    __syncthreads();
}
__device__ __forceinline__ void p15_combine(Frame& F) {
    const int gw = F.vcu * 8 + F.wave, NGW = F.G * 8, lane = lane_now();
    const int* tok_pos = (const int*)(F.ws + WS_META + MT_TOKPOS); const float* tok_w = (const float*)(F.ws + WS_META + MT_TOKW);
    const bf16_t* Y = WSP(bf16_t, WS_Y); const bf16_t* YP = WSP(bf16_t, WS_YP);
    for (int t = gw; t < NTOK; t += NGW) {
        f32x4* o = (f32x4*)(F.out + (size_t)t * DM) + lane; const u32x2* xs = (const u32x2*)(WSP(bf16_t, WS_XB) + (size_t)t * DM) + lane; f32x4 acc[8];
        const int p0 = tok_pos[2 * t], p1 = tok_pos[2 * t + 1]; const float g0 = tok_w[2 * t], g1 = tok_w[2 * t + 1];
        if (p0 < 16384 && p1 < 16384) {
            const u32x2* y0 = (const u32x2*)(Y + (size_t)p0 * DM) + lane; const u32x2* y1 = (const u32x2*)(Y + (size_t)p1 * DM) + lane; u32x2 wx[8], wa[8], wb[8];
#pragma unroll
            for (int q = 0; q < 8; ++q) { wx[q] = xs[64 * q]; wa[q] = y0[64 * q]; wb[q] = y1[64 * q]; }
#pragma unroll
            for (int q = 0; q < 8; ++q) o[64 * q] = (f32x4){bf_lo(wx[q].x), bf_hi(wx[q].x), bf_lo(wx[q].y), bf_hi(wx[q].y)} + (f32x4){bf_lo(wa[q].x), bf_hi(wa[q].x), bf_lo(wa[q].y), bf_hi(wa[q].y)} * g0
                                                   + (f32x4){bf_lo(wb[q].x), bf_hi(wb[q].x), bf_lo(wb[q].y), bf_hi(wb[q].y)} * g1;
            continue; }
#pragma unroll
        for (int q = 0; q < 8; ++q) { const u32x2 w = xs[64 * q]; acc[q] = (f32x4){bf_lo(w.x), bf_hi(w.x), bf_lo(w.y), bf_hi(w.y)}; }
        for (int s = 0; s < 2; ++s) { const int p = s ? p1 : p0; const float gwt = s ? g1 : g0;
            if (p < 16384) { const u32x2* y = (const u32x2*)(Y + (size_t)p * DM) + lane;
#pragma unroll
                for (int q = 0; q < 8; ++q) { const u32x2 w = y[64 * q]; acc[q] = acc[q] + (f32x4){bf_lo(w.x), bf_hi(w.x), bf_lo(w.y), bf_hi(w.y)} * gwt; } }
            else { f32x4 ys[8];
#pragma unroll
                for (int q = 0; q < 8; ++q) ys[q] = (f32x4){0.f, 0.f, 0.f, 0.f};
#pragma unroll
                for (int k0 = 0; k0 < 7; k0 += 4) { u32x2 wv[4][8];
#pragma unroll
                    for (int kk = 0; kk < 4; ++kk) if (k0 + kk < 7) { const u32x2* y = (const u32x2*)(YP + ((size_t)(k0 + kk) * 2048 + (p - 16384)) * DM) + lane;
#pragma unroll
                        for (int q = 0; q < 8; ++q) wv[kk][q] = y[64 * q]; }
#pragma unroll
                    for (int kk = 0; kk < 4; ++kk) if (k0 + kk < 7) {
#pragma unroll
                        for (int q = 0; q < 8; ++q) { const u32x2 w = wv[kk][q]; ys[q] = ys[q] + (f32x4){bf_lo(w.x), bf_hi(w.x), bf_lo(w.y), bf_hi(w.y)}; } } }
#pragma unroll
                for (int q = 0; q < 8; ++q) acc[q] = acc[q] + ys[q] * gwt; } }
#pragma unroll
        for (int q = 0; q < 8; ++q) o[64 * q] = acc[q]; }
}

constexpr int NPHASE = 17;
struct Args { const void* in[28]; float* out; unsigned char* ws; int ph_lo, ph_hi; };
__global__ void __launch_bounds__(512, 2) yoco_fwd(Args args) {
    extern __shared__ __attribute__((aligned(16))) unsigned char lds_raw[];
    Frame F;
    F.lds = (LAS unsigned char*)lds_raw;
    F.wave = __builtin_amdgcn_readfirstlane(threadIdx.x >> 6);
    F.G = gridDim.x; { const int bx = blockIdx.x; F.vcu = (F.G % 8 == 0) ? (bx % 8) * (F.G / 8) + bx / 8 : bx; }
    F.kp = (kptr_t)__builtin_amdgcn_kernarg_segment_ptr();
    F.out = args.out; F.ws = args.ws;
    for (int u = F.wave * 64 + lane_now(); u < (LDS_BYTES - LDSCTL_OFF) / 4; u += 512) ((LAS unsigned*)(F.lds + LDSCTL_OFF))[u] = 0u;
    __syncthreads();
    unsigned* ctl = (unsigned*)(F.ws + WS_CTL);
    XcdBarrier bar; bar.bar = ctl + CW_BAR; bar.x = 0; bar.st = nullptr; bar.wave = F.wave;
    if (!MK_SPLIT) bar = xcd_barrier_post(ctl + CW_BAR, (volatile LAS unsigned*)(F.lds + MISC_OFF) + 8, F.wave);
    const int lo = args.ph_lo, hi = args.ph_hi;
#define IN(k) (lo <= (k) && (k) < hi)
#define SEAM(k) do { if (!MK_SPLIT && IN((k) + 1)) xcd_barrier(bar); } while (0)
    LAS unsigned char* ring = F.lds;
    const int bx = blockIdx.x, G = F.G;
    using pg8::Gemm; using pg8::StaticOrder; using pg8::MoeOrder;

#define PHASE(k, ...) do { if (IN(k)) { { __VA_ARGS__ } if constexpr (((REPMASK) >> (k)) & 1) { if (!MK_SPLIT) xcd_barrier(bar); { __VA_ARGS__ } } SEAM(k); } } while (0)
    PHASE(0, p0_prologue(F););
    PHASE(1,
        { Gemm g{WSP(bf16_t, WS_XB), WSP(bf16_t, WS_W_IN0), DM, DM}; StaticOrder S; S.init(32, 20, G, bx);
          LAS float* rl = (LAS float*)(F.lds + RSTAB_OFF);
          { pg8::Unit u0; if (S.next(0, u0)) { const int t = F.wave * 64 + lane_now(); if (t < 256) rl[t] = WSP(float, WS_RS0)[u0.pm * 256 + t]; } }
          LDS_WAIT(); __syncthreads();
          pg8::EpiBf16Plain E{WSP(bf16_t, WS_U0), NIN0, rl};
          pg8::gemm_phase<pg8::EpiBf16Plain, StaticOrder, true, true>(ring, F.wave, g, S, E); }
        { Gemm g{WSP(bf16_t, WS_MEMN), WSP(bf16_t, WS_W_MK), DM, DM}; StaticOrder S; S.init(2, 4, G, (bx + 128) % G); EpiMemKFinal E{WSP(bf16_t, WS_MEMKF), inp(F, 8), (LAS float*)(F.lds + RSTAB_OFF + 1024)};
          pg8::gemm_phase<EpiMemKFinal, StaticOrder, true, true>(ring, F.wave, g, S, E); }
        { Gemm g{WSP(bf16_t, WS_W_MV), WSP(bf16_t, WS_MEMN), DM, DM}; StaticOrder S; S.init(4, 2, G, (bx + 120) % G); pg8::EpiBf16Plain E{WSP(bf16_t, WS_MEMVT), 512, nullptr};
          pg8::gemm_phase<pg8::EpiBf16Plain, StaticOrder, true, true>(ring, F.wave, g, S, E); });
    PHASE(2, p2_conv(F); mem_attn_unit(F, 0, (F.wave & 3) * 256 + F.vcu););
    PHASE(4,
        Gemm g{WSP(bf16_t, WS_CAT), WSP(bf16_t, WS_W_OUT0), DM, DM}; StaticOrder S; S.init(32, 8, G, bx);
        pg8::EpiStream E{WSP(bf16_t, WS_XB), WSP(float, WS_SSQ), F.ws + WS_XB8, QX1, 1.0f};
        pg8::gemm_phase<pg8::EpiStream, StaticOrder, false, true>(ring, F.wave, g, S, E););
    PHASE(5,
        Gemm g{WSP(bf16_t, WS_XB8), WSP(bf16_t, WS_W_GU0), DM / 2, DM / 2}; StaticOrder S; S.init(32, 56, G, bx);
        LAS float* rl = (LAS float*)(F.lds + RSTAB_OFF);
        { pg8::Unit u0; if (S.next(0, u0)) { const int t = F.wave * 64 + lane_now(); if (t < 256) { const float* q = WSP(float, WS_SSQ) + (size_t)(u0.pm * 256 + t) * 8; const f32x4 a = *(const f32x4*)q, b = *(const f32x4*)(q + 4);
              rl[t] = (1.0f / (QX1 * QWGU)) * __builtin_amdgcn_rsqf(((a[0] + a[1]) + (a[2] + a[3]) + (b[0] + b[1]) + (b[2] + b[3])) * (1.0f / 2048.0f) + EPS); } } }
        LDS_WAIT(); __syncthreads();
        pg8::EpiSwiGLU8<3> E{F.ws + WS_HID, DFF, nullptr, rl, 1.0f, QHID};
        pg8::gemm_phase<pg8::EpiSwiGLU8<3>, StaticOrder, true, true, false, true>(ring, F.wave, g, S, E););
    PHASE(6,
        Gemm g{WSP(bf16_t, WS_HID), WSP(bf16_t, WS_W_D0), DFF / 2, DFF / 2}; StaticOrder S; S.init(32, 8, G, bx);
        pg8::EpiStream E{WSP(bf16_t, WS_XB), WSP(float, WS_SSQ) + NTOK * 8, F.ws + WS_XB8, 0.f, 1.0f / (QHID * QWD)};
        pg8::gemm_phase<pg8::EpiStream, StaticOrder, false, true, false, true>(ring, F.wave, g, S, E););
    PHASE(7,
        Gemm g{WSP(bf16_t, WS_XB8), WSP(bf16_t, WS_W_1), DM / 2, DM / 2}; StaticOrder S; S.init(32, 6, G, bx);
        pg8::EpiL1In E{WSP(float, WS_SSQ) + NTOK * 8, WSP(bf16_t, WS_CKV), WSP(float, WS_KPE), WSP(float, WS_KSS), WSP(bf16_t, WS_CQ), WSP(float, WS_SSQQ), WSP(bf16_t, WS_QM), inp(F, 7) + 128, CMEM};
        pg8::gemm_phase<pg8::EpiL1In, StaticOrder, false, true, true>(ring, F.wave, g, S, E, 0x7f7f7f79););
    PHASE(8,
        { Gemm g{WSP(bf16_t, WS_CKV), WSP(bf16_t, WS_W_KN), 256, 256}; StaticOrder S; S.init(32, 6, G, bx); EpiKnFinal E{WSP(bf16_t, WS_KF), WSP(float, WS_KPE), WSP(float, WS_KSS), (const int*)inp(F, 2), inp(F, 20), (LAS float*)(F.lds + RSTAB_OFF + 1024)};
          pg8::gemm_phase<EpiKnFinal, StaticOrder, true, true>(ring, F.wave, g, S, E); }
        { Gemm g{WSP(bf16_t, WS_W_V), WSP(bf16_t, WS_CKV), 256, 256}; StaticOrder S; S.init(6, 32, G, (bx + 64) % G); EpiFp8Plain E{F.ws + WS_VT, NTOK};
          pg8::gemm_phase<EpiFp8Plain, StaticOrder, true, true>(ring, F.wave, g, S, E); }
        { Gemm g{WSP(bf16_t, WS_CQ), WSP(bf16_t, WS_W_QB), 512, 512}; StaticOrder S; S.init(32, 9, G, (bx + 128) % G); pg8::EpiBf16Plain E{WSP(bf16_t, WS_QRAW), 2304, nullptr};
          pg8::gemm_phase<pg8::EpiBf16Plain, StaticOrder, true, true>(ring, F.wave, g, S, E); });
    PHASE(10,
        p11_attention(F););
    PHASE(11,
        Gemm g{WSP(bf16_t, WS_CAT), WSP(bf16_t, WS_W_OUT1), DM / 2, DM / 2}; StaticOrder S; S.init(32, 8, G, bx);
        pg8::EpiStream E{WSP(bf16_t, WS_XB), WSP(float, WS_SSQ) + 2 * NTOK * 8, nullptr, 0.f, 1.0f};
        pg8::gemm_phase<pg8::EpiStream, StaticOrder, false, true, true>(ring, F.wave, g, S, E, 0x7f7f7b79););
    PHASE(12, p11_router(F););
    PHASE(13, p12_scatter(F););
    PHASE(14,
        const int* mte = (const int*)(F.ws + WS_META + MT_MTE); const int nmt = *(const int*)(F.ws + WS_META + MT_NMT);
        Gemm g{WSP(bf16_t, WS_HS), WSP(bf16_t, WS_W_MGU), DM / 2, DM / 2}; MoeOrder S; S.init(nmt, 56, G, bx); S.mte = mte; S.ntpe = 56;
        pg8::EpiSwiGLU8<2> E{F.ws + WS_HID2, DFF, nullptr, nullptr, 1.0f / (QH * QWGU), QHID};
        pg8::gemm_phase<pg8::EpiSwiGLU8<2>, MoeOrder, true, true, false, true>(ring, F.wave, g, S, E););
    PHASE(15,
        const int* mte = (const int*)(F.ws + WS_META + MT_MTE); const int nmt = *(const int*)(F.ws + WS_META + MT_NMT);
        { Gemm g{WSP(bf16_t, WS_HID2), WSP(bf16_t, WS_W_MD), DFF / 2, DFF / 2}; MoeOrder S; S.init(64, 8, G, bx); S.mte = mte; S.ntpe = 8;
          pg8::EpiMoeDown E{WSP(bf16_t, WS_Y), 1.0f / (QHID * QWD)};
          pg8::gemm_phase<pg8::EpiMoeDown, MoeOrder, true, true, false, true>(ring, F.wave, g, S, E); }
        { Gemm g{WSP(bf16_t, WS_HID2), WSP(bf16_t, WS_W_MD), 512, DFF / 2}; pg8::MoeTailOrder S{nmt - 64, G, bx, mte};
          pg8::EpiMoeDownPart E{WSP(bf16_t, WS_YP), 1.0f / (QHID * QWD)};
          pg8::gemm_phase<pg8::EpiMoeDownPart, pg8::MoeTailOrder, true, true, false, true>(ring, F.wave, g, S, E); });
    if (IN(16)) { p15_combine(F); }
#undef PHASE
#undef IN
#undef SEAM
}

extern "C" void kernel_launch(void* const* d_in, const int* in_sizes, int n_in, void* d_out, int out_size, void* d_ws, size_t ws_size, hipStream_t stream) {
    static int ready = 0;
    if (ready == 0) {
        ready = -1;
        if (n_in != 28 || in_sizes[0] != NTOK * DM || out_size != NTOK * DM || ws_size < WS_END) { fprintf(stderr, "kernel_launch: unexpected shapes (n_in %d, out %d, ws %zu < %zu)\n", n_in, out_size, ws_size, (size_t)WS_END); return; }
        if (hipFuncSetAttribute((const void*)yoco_fwd, hipFuncAttributeMaxDynamicSharedMemorySize, LDS_BYTES) != hipSuccess) { fprintf(stderr, "kernel_launch: hipFuncSetAttribute failed\n"); return; }
        int per_cu = 0; if (hipOccupancyMaxActiveBlocksPerMultiprocessor(&per_cu, (const void*)yoco_fwd, 512, LDS_BYTES) != hipSuccess || per_cu < 1) fprintf(stderr, "kernel_launch: occupancy query reports %d\n", per_cu);
        (void)hipGetLastError();
        ready = 1;
    }
    if (ready < 0) return;
    (void)hipMemsetAsync((char*)d_ws + WS_CTL, 0, CTL_ZERO_BYTES, stream);
    Args a{};
    for (int i = 0; i < 28; ++i) a.in[i] = d_in[i];
    a.out = (float*)d_out; a.ws = (unsigned char*)d_ws;
#if MK_SPLIT
    for (int p = 0; p < NPHASE; ++p) { a.ph_lo = p; a.ph_hi = p + 1; hipLaunchKernelGGL(yoco_fwd, dim3(256), dim3(512), LDS_BYTES, stream, a); }
#else
    a.ph_lo = 0; a.ph_hi = NPHASE;
    hipLaunchKernelGGL(yoco_fwd, dim3(256), dim3(512), LDS_BYTES, stream, a);
#endif
    const hipError_t le = hipPeekAtLastError();
    if (le != hipSuccess) fprintf(stderr, "kernel_launch: launch failed: %s\n", hipGetErrorName(le));
}
```
